# Optimizing an MI355X kernel written in HIP

```python
import jax, jax.numpy as jnp
from jax import lax
import numpy as np

D_MODEL = 2048
BATCH = 4
SEQ = 2048
DEPTH = 1
DEC_BATCH = 128
DEC_SEQ = 8
PAST_LEN = 16384
PAGE_SIZE = 128

D_MIX = D_MODEL
GDN_DK = 128
GDN_DV = 128
GDN_HEADS = (D_MIX // 2) // GDN_DV
GDN_QK = GDN_HEADS * GDN_DK
GDN_V = GDN_HEADS * GDN_DV
GDN_CONV_CH = 2 * GDN_QK + GDN_V
SSM_P = 64
SSM_N = 128
SSM_GROUPS = 2
SSM_DI = D_MIX - GDN_V
SSM_HEADS = SSM_DI // SSM_P
SSM_BC = SSM_GROUPS * SSM_N
SSM_CONV_CH = SSM_DI + 2 * SSM_BC
CONV_W = 4
CHUNK = 64
D_FF = -(-8 * D_MODEL // (3 * 256)) * 256
EPS = 1e-6
SPLITS = [GDN_CONV_CH, GDN_V, GDN_HEADS, GDN_HEADS, SSM_DI, SSM_CONV_CH, SSM_HEADS]
D_IN_PROJ = sum(SPLITS)

kernel_name = 'hybrid_gdn_ssd_parallel_heads_step'


def rmsnorm(x, w):
    x = x.astype(jnp.float32)
    return x * lax.rsqrt(jnp.mean(x * x, axis=-1, keepdims=True) + EPS) * w.astype(jnp.float32)


def l2norm(x):
    return x * lax.rsqrt(jnp.sum(x * x, axis=-1, keepdims=True) + EPS)


def causal_conv(x, buf, w, b):
    L = x.shape[1]
    xp = jnp.concatenate([buf.astype(jnp.float32), x], axis=1)
    out = sum(xp[:, i:i + L] * w[i].astype(jnp.float32) for i in range(CONV_W))
    if b is not None:
        out = out + b.astype(jnp.float32)
    return jax.nn.silu(out), xp[:, xp.shape[1] - (CONV_W - 1):]


def _chunk_len(L):
    return CHUNK if L >= CHUNK else L


def _chunks(t, c):
    B, L = t.shape[:2]
    n = -(-L // c)
    t = jnp.pad(t, [(0, 0), (0, n * c - L)] + [(0, 0)] * (t.ndim - 2))
    t = t.reshape((B, n, c) + t.shape[2:])
    return jnp.moveaxis(jnp.moveaxis(t, 3, 2), 1, 0)


def _unchunks(o, L):
    n, B, H, c, E = o.shape
    o = jnp.swapaxes(jnp.moveaxis(o, 0, 1), 2, 3).reshape(B, n * c, H, E)
    return o[:, :L]


def _decay(G, c):
    tril = jnp.tril(jnp.ones((c, c), bool))
    diff = G[..., :, None] - G[..., None, :]
    return jnp.exp(jnp.where(tril, diff, -jnp.inf))


def gated_delta_chunked(q, k, v, g, beta, S0):
    L = q.shape[1]
    dv = v.shape[-1]
    c = _chunk_len(L)
    qc, kc, vc, gc, bc = (_chunks(t, c) for t in (q, k, v, g, beta))
    G = jnp.cumsum(gc, axis=-1)
    decay = _decay(G, c)
    strict = jnp.tril(jnp.ones((c, c), bool), -1)
    kb = kc * bc[..., None]
    low = jnp.where(strict, jnp.einsum('nbhid,nbhjd->nbhij', kb, kc) * decay, 0.0)
    amat = low + jnp.eye(c, dtype=low.dtype)
    rhs = jnp.concatenate([vc * bc[..., None], kb * jnp.exp(G)[..., None]], axis=-1)
    sol = lax.linalg.triangular_solve(amat, rhs, left_side=True, lower=True, unit_diagonal=True)
    u, w = sol[..., :dv], sol[..., dv:]
    qk = jnp.einsum('nbhid,nbhjd->nbhij', qc, kc) * decay
    q_dec = qc * jnp.exp(G)[..., None]
    k_dec = kc * jnp.exp(G[..., -1:] - G)[..., None]
    g_last = jnp.exp(G[..., -1])

    def step(S, inp):
        u_i, w_i, qk_i, qd_i, kd_i, gl_i = inp
        v_new = u_i - jnp.einsum('bhcd,bhde->bhce', w_i, S)
        o = jnp.einsum('bhcd,bhde->bhce', qd_i, S) + jnp.einsum('bhij,bhje->bhie', qk_i, v_new)
        S = S * gl_i[..., None, None] + jnp.einsum('bhcd,bhce->bhde', kd_i, v_new)
        return S, o

    S, o = lax.scan(step, S0, (u, w, qk, q_dec, k_dec, g_last))
    return _unchunks(o, L), S


def ssd_chunked(x, dt, A, Bh, Ch, h0):
    L = x.shape[1]
    c = _chunk_len(L)
    xc, dtc, Bc, Cc = (_chunks(t, c) for t in (x, dt, Bh, Ch))
    Acum = jnp.cumsum(dtc * A[:, None], axis=-1)
    decay = _decay(Acum, c)
    xdt = xc * dtc[..., None]
    scores = jnp.einsum('nbhis,nbhjs->nbhij', Cc, Bc) * decay
    y_diag = jnp.einsum('nbhij,nbhjp->nbhip', scores, xdt)
    a_last = Acum[..., -1:]
    chunk_states = jnp.einsum('nbhjs,nbhjp->nbhps', Bc * jnp.exp(a_last - Acum)[..., None], xdt)
    c_dec = Cc * jnp.exp(Acum)[..., None]

    def step(h, inp):
        cd, st, al = inp
        y_off = jnp.einsum('bhis,bhps->bhip', cd, h)
        return h * al[..., None, None] + st, y_off

    h, y_off = lax.scan(step, h0, (c_dec, chunk_states, jnp.exp(a_last[..., 0])))
    return _unchunks(y_diag + y_off, L), h


def hybrid_layer(x, gdn_conv, gdn_S, ssm_conv, ssm_h, p):
    B, L, _ = x.shape
    h = rmsnorm(x, p['attn_norm_w'])
    proj = h @ p['w_in'].astype(jnp.float32)
    offs = np.cumsum(SPLITS)[:-1].tolist()
    qkv_raw, z_g, b_raw, a_raw, z_s, xbc_raw, dt_raw = jnp.split(proj, offs, axis=-1)

    qkv, gdn_conv_new = causal_conv(qkv_raw, gdn_conv, p['gdn_conv_w'], None)
    q, k, v = jnp.split(qkv, [GDN_QK, 2 * GDN_QK], axis=-1)
    q = l2norm(q.reshape(B, L, GDN_HEADS, GDN_DK)) * (GDN_DK ** -0.5)
    k = l2norm(k.reshape(B, L, GDN_HEADS, GDN_DK))
    v = v.reshape(B, L, GDN_HEADS, GDN_DV)
    beta = jax.nn.sigmoid(b_raw)
    g = -jnp.exp(p['gdn_A_log'].astype(jnp.float32)) * jax.nn.softplus(a_raw + p['gdn_dt_bias'].astype(jnp.float32))
    o, gdn_S_new = gated_delta_chunked(q, k, v, g, beta, gdn_S.astype(jnp.float32))
    o = rmsnorm(o, p['gdn_norm_w']) * jax.nn.silu(z_g.reshape(B, L, GDN_HEADS, GDN_DV))
    o = o.reshape(B, L, GDN_V)

    xbc, ssm_conv_new = causal_conv(xbc_raw, ssm_conv, p['ssm_conv_w'], p['ssm_conv_b'])
    xs, Bm, Cm = jnp.split(xbc, [SSM_DI, SSM_DI + SSM_BC], axis=-1)
    xs = xs.reshape(B, L, SSM_HEADS, SSM_P)
    rep = SSM_HEADS // SSM_GROUPS
    Bh = jnp.repeat(Bm.reshape(B, L, SSM_GROUPS, SSM_N), rep, axis=2)
    Ch = jnp.repeat(Cm.reshape(B, L, SSM_GROUPS, SSM_N), rep, axis=2)
    dt = jax.nn.softplus(dt_raw + p['ssm_dt_bias'].astype(jnp.float32))
    A = -jnp.exp(p['ssm_A_log'].astype(jnp.float32))
    y, ssm_h_new = ssd_chunked(xs, dt, A, Bh, Ch, ssm_h.astype(jnp.float32))
    y = y + p['ssm_D'].astype(jnp.float32)[:, None] * xs
    y = y.reshape(B, L, SSM_DI) * jax.nn.silu(z_s)
    gs = SSM_DI // SSM_GROUPS
    y = rmsnorm(y.reshape(B, L, SSM_GROUPS, gs), p['ssm_norm_w'].reshape(SSM_GROUPS, gs)).reshape(B, L, SSM_DI)

    mix = jnp.concatenate([o, y], axis=-1)
    x = x + mix @ p['w_out'].astype(jnp.float32)

    h2 = rmsnorm(x, p['ffn_norm_w'])
    ff = jax.nn.silu(h2 @ p['w_gate'].astype(jnp.float32)) * (h2 @ p['w_up'].astype(jnp.float32))
    x = x + ff @ p['w_down'].astype(jnp.float32)
    return x, (gdn_conv_new, gdn_S_new, ssm_conv_new, ssm_h_new)


def trunk(x, gdn_conv, gdn_S, ssm_conv, ssm_h, p, final_norm_w):
    h = x.astype(jnp.float32)
    outs = ([], [], [], [])
    for l in range(DEPTH):
        pl = {name: arr[l] for name, arr in p.items()}
        h, st = hybrid_layer(h, gdn_conv[l], gdn_S[l], ssm_conv[l], ssm_h[l], pl)
        for lst, s in zip(outs, st):
            lst.append(s.astype(x.dtype))
    y = rmsnorm(h, final_norm_w).astype(x.dtype)
    return y, [jnp.stack(lst, axis=0) for lst in outs]


def setup_inputs(seed: int = 0) -> dict:
    key = jax.random.key(seed)
    ks = jax.random.split(key, 32)
    f32 = jnp.float32
    nrm = lambda k, shape, s: jax.random.normal(k, shape, f32) * s

    def inv_softplus_dt(k, n):
        dt = jnp.exp(jax.random.uniform(k, (DEPTH, n), f32, float(np.log(1e-3)), float(np.log(1e-1))))
        return dt + jnp.log(-jnp.expm1(-dt))

    return {
        'x_prompt': nrm(ks[0], (BATCH, SEQ, D_MODEL), 1.0),
        'x_sample': nrm(ks[1], (DEC_BATCH, DEC_SEQ, D_MODEL), 1.0),
        'state_gdn_conv': nrm(ks[2], (DEPTH, DEC_BATCH, CONV_W - 1, GDN_CONV_CH), 1.0),
        'state_gdn': nrm(ks[3], (DEPTH, DEC_BATCH, GDN_HEADS, GDN_DK, GDN_DV), 0.05),
        'state_ssm_conv': nrm(ks[4], (DEPTH, DEC_BATCH, CONV_W - 1, SSM_CONV_CH), 1.0),
        'state_ssm': nrm(ks[5], (DEPTH, DEC_BATCH, SSM_HEADS, SSM_P, SSM_N), 0.1),
        'attn_norm_w': 1.0 + nrm(ks[6], (DEPTH, D_MODEL), 0.02),
        'w_in': nrm(ks[7], (DEPTH, D_MODEL, D_IN_PROJ), D_MODEL ** -0.5),
        'gdn_conv_w': nrm(ks[8], (DEPTH, CONV_W, GDN_CONV_CH), 0.5),
        'gdn_A_log': jnp.log(jax.random.uniform(ks[9], (DEPTH, GDN_HEADS), f32, 1.0, 16.0)),
        'gdn_dt_bias': inv_softplus_dt(ks[10], GDN_HEADS),
        'gdn_norm_w': 1.0 + nrm(ks[11], (DEPTH, GDN_DV), 0.02),
        'ssm_conv_w': nrm(ks[12], (DEPTH, CONV_W, SSM_CONV_CH), 0.5),
        'ssm_conv_b': nrm(ks[13], (DEPTH, SSM_CONV_CH), 0.02),
        'ssm_A_log': jnp.log(jax.random.uniform(ks[14], (DEPTH, SSM_HEADS), f32, 1.0, 16.0)),
        'ssm_dt_bias': inv_softplus_dt(ks[15], SSM_HEADS),
        'ssm_D': 1.0 + nrm(ks[16], (DEPTH, SSM_HEADS), 0.1),
        'ssm_norm_w': 1.0 + nrm(ks[17], (DEPTH, SSM_DI), 0.02),
        'w_out': nrm(ks[18], (DEPTH, D_MIX, D_MODEL), D_MIX ** -0.5),
        'ffn_norm_w': 1.0 + nrm(ks[19], (DEPTH, D_MODEL), 0.02),
        'w_gate': nrm(ks[20], (DEPTH, D_MODEL, D_FF), D_MODEL ** -0.5),
        'w_up': nrm(ks[21], (DEPTH, D_MODEL, D_FF), D_MODEL ** -0.5),
        'w_down': nrm(ks[22], (DEPTH, D_FF, D_MODEL), D_FF ** -0.5),
        'final_norm_w': 1.0 + nrm(ks[23], (D_MODEL,), 0.02),
    }


def reference(x_prompt, x_sample, state_gdn_conv, state_gdn, state_ssm_conv, state_ssm,
              attn_norm_w, w_in, gdn_conv_w, gdn_A_log, gdn_dt_bias, gdn_norm_w,
              ssm_conv_w, ssm_conv_b, ssm_A_log, ssm_dt_bias, ssm_D, ssm_norm_w,
              w_out, ffn_norm_w, w_gate, w_up, w_down, final_norm_w):
    p = dict(attn_norm_w=attn_norm_w, w_in=w_in, gdn_conv_w=gdn_conv_w, gdn_A_log=gdn_A_log,
             gdn_dt_bias=gdn_dt_bias, gdn_norm_w=gdn_norm_w, ssm_conv_w=ssm_conv_w,
             ssm_conv_b=ssm_conv_b, ssm_A_log=ssm_A_log, ssm_dt_bias=ssm_dt_bias, ssm_D=ssm_D,
             ssm_norm_w=ssm_norm_w, w_out=w_out, ffn_norm_w=ffn_norm_w, w_gate=w_gate,
             w_up=w_up, w_down=w_down)
    Bp = x_prompt.shape[0]
    dt_ = x_prompt.dtype
    z_gconv = jnp.zeros((DEPTH, Bp, CONV_W - 1, GDN_CONV_CH), dt_)
    z_gS = jnp.zeros((DEPTH, Bp, GDN_HEADS, GDN_DK, GDN_DV), dt_)
    z_sconv = jnp.zeros((DEPTH, Bp, CONV_W - 1, SSM_CONV_CH), dt_)
    z_sh = jnp.zeros((DEPTH, Bp, SSM_HEADS, SSM_P, SSM_N), dt_)
    y_prompt, st_p = trunk(x_prompt, z_gconv, z_gS, z_sconv, z_sh, p, final_norm_w)
    y_sample, st_s = trunk(x_sample, state_gdn_conv, state_gdn, state_ssm_conv, state_ssm, p, final_norm_w)
    return (y_prompt, y_sample, st_p[0], st_p[1], st_p[2], st_p[3], st_s[0], st_s[1], st_s[2], st_s[3])
```

```cpp
#include <hip/hip_runtime.h>
#include <hip/hip_cooperative_groups.h>
#include <cstdio>
namespace cg = cooperative_groups;
__device__ __forceinline__ int opaque_tid() { int t = threadIdx.x; asm volatile("" : "+v"(t)); return t; }
#ifndef DBG_SSD_SEQ
#define DBG_SSD_SEQ 0
#endif
#ifndef DBG_SUBSET
#define DBG_SUBSET(t) ((t) < 64)
#endif
namespace pg8 {
#define PG8_LAS __attribute__((address_space(3)))
typedef unsigned short bf16_t;
typedef short bf16x8 __attribute__((ext_vector_type(8)));
typedef float f32x4 __attribute__((ext_vector_type(4)));
typedef unsigned u32x4 __attribute__((ext_vector_type(4)));
constexpr int BM = 256, BK = 64, HALF = 128, HTB = HALF * BK * 2  , STAGE_BYTES = 8 * HTB, NXCD = 8, WGM = 8;

__host__ __device__ __forceinline__ int lds_byte(int r, int c) { const int st = (r >> 4) * 2 + (c >> 5), rr = r & 15, cc = c & 31, ob = rr * 64 + cc * 2; return st * 1024 + (ob ^ (((ob >> 9) & 1) << 5)); }
__host__ __device__ __forceinline__ void stage_rc(int b, int& R, int& C) { const int st = b / 1024, sb = b % 1024, swz = sb ^ (((sb >> 9) & 1) << 5); R = (st >> 1) * 16 + swz / 64; C = (st & 1) * 32 + (swz % 64) / 2; }
__host__ __device__ __forceinline__ int perm32(int rho) { const int n = rho >> 4, i = rho & 15; return 8 * (i >> 2) + 4 * n + (i & 3); }

struct Unit { int pm, pn; };
struct Gemm { const bf16_t* A; const bf16_t* Bt; int M, N, K; };

struct StaticOrder {
    int nM, nN, nwg, G, c;
    __host__ __device__ void init(int M, int N, int G_, int c_) { nM = M / BM; nN = N / BM; nwg = nM * nN; G = G_; c = c_; }
    __host__ __device__ bool next(int i, Unit& u) const {
        const long L = (long)i * G + c; if (L >= nwg) return false;
        int wgid = (int)L; { const int q = nwg / NXCD, r = nwg % NXCD, xcd = wgid % NXCD, off = wgid / NXCD; wgid = (xcd < r ? xcd * (q + 1) : r * (q + 1) + (xcd - r) * q) + off; }
        const int nig = WGM * nN, gid = wgid / nig, fm = gid * WGM, gsz = (nM - fm) < WGM ? (nM - fm) : WGM;
        u.pm = fm + ((wgid % nig) % gsz); u.pn = (wgid % nig) / gsz; return true;
    }
    __device__ __forceinline__ void a_ready(const Unit&) const {}
    __device__ __forceinline__ void done(const Unit&) const {}
};
typedef float f32x2cv __attribute__((ext_vector_type(2)));
typedef __bf16 bf16x2cv __attribute__((ext_vector_type(2)));
__device__ __forceinline__ unsigned cvt_pk_bf16(float lo, float hi) { f32x2cv v = {lo, hi}; bf16x2cv b = __builtin_convertvector(v, bf16x2cv); return __builtin_bit_cast(unsigned, b); }
template <class Epi, class Sched, bool STAMP = false>
__device__ __forceinline__ void gemm_phase(PG8_LAS unsigned char* lds, const Gemm g, const Sched& S, const Epi& E, unsigned long long* stamps) {
    const int tid = opaque_tid(), wid = __builtin_amdgcn_readfirstlane(tid >> 6), lane = tid & 63, wr = wid >> 2, wc = wid & 3, fr = lane & 15, fq = lane >> 4;
    const int K = g.K, nt = K / BK;
    int ts_lo = 0, ts_hi = 0, nts = 0; const unsigned long long rt_entry = STAMP ? (unsigned long long)wall_clock64() : 0ull;
#define PG8_STAMP() do { if (STAMP && wid == 0 && nts < 64) { const unsigned long long _c = (unsigned long long)clock64(); \
        ts_lo = (lane == nts) ? (int)(unsigned)_c : ts_lo; ts_hi = (lane == nts) ? (int)(unsigned)(_c >> 32) : ts_hi; ++nts; } } while (0)
    PG8_STAMP();
    unsigned voffA[2], voffB[2];
#pragma unroll
    for (int i = 0; i < 2; ++i) { int R, C; stage_rc(tid * 16 + i * 8192, R, C); const int Rb = Epi::PERM ? ((R & ~31) + perm32(R & 31)) : R;
        voffA[i] = (unsigned)(R * K + C) * 2u; voffB[i] = (unsigned)(Rb * K + C) * 2u; }
    const size_t kstep = (size_t)(BK * 2);
    const size_t hstep = (size_t)HALF * K * 2;
    const size_t tstep = 2 * hstep;
    const unsigned ldsw = (unsigned)wid * 1024u;
    const int aoff = lds_byte(wr * 64 + fr, fq * 8), boff = lds_byte(wc * 32 + fr, fq * 8);
#define PG8_SA(b, h) (((b) * 2 + (h)) * HTB)
#define PG8_SB(b, h) ((4 + (b) * 2 + (h)) * HTB)
#define PG8_STAGE(bufoff, gbase, voff) do { _Pragma("unroll") for (int _i = 0; _i < 2; ++_i) \
        __builtin_amdgcn_global_load_lds((const unsigned*)((const char*)(gbase) + (voff)[_i]), (PG8_LAS unsigned*)(lds + (bufoff) + ldsw + _i * 8192), 16, 0, 0); } while (0)
#define PG8_LDA(dst, b, h) do { _Pragma("unroll") for (int m = 0; m < 4; ++m) _Pragma("unroll") for (int k = 0; k < 2; ++k) dst[m][k] = *(const PG8_LAS bf16x8*)(lds + PG8_SA(b, h) + aoff + m * 2048 + k * 1024); } while (0)
#define PG8_LDB(dst, b, h) do { _Pragma("unroll") for (int n = 0; n < 2; ++n) _Pragma("unroll") for (int k = 0; k < 2; ++k) dst[n][k] = *(const PG8_LAS bf16x8*)(lds + PG8_SB(b, h) + boff + n * 2048 + k * 1024); } while (0)
#define PG8_MMA(ai, bj, At, Bt) do { __builtin_amdgcn_s_setprio(1); _Pragma("unroll") for (int m = 0; m < 4; ++m) _Pragma("unroll") for (int n = 0; n < 2; ++n) _Pragma("unroll") for (int k = 0; k < 2; ++k) \
        acc[ai][bj][m][n] = __builtin_amdgcn_mfma_f32_16x16x32_bf16(Bt[n][k], At[m][k], acc[ai][bj][m][n], 0, 0, 0); __builtin_amdgcn_s_setprio(0); } while (0)
#define PG8_WAIT_V(n) asm volatile("s_waitcnt vmcnt(" #n ")" ::: "memory")
#define PG8_WAIT_L(n) asm volatile("s_waitcnt lgkmcnt(" #n ")" ::: "memory")
#define PG8_BAR __builtin_amdgcn_s_barrier()
#define PG8_SCHED __builtin_amdgcn_sched_barrier(0)
    Unit cur, nxt; int ui = 0;
    if (!S.next(0, cur)) return;
    f32x4 acc[2][2][4][2];
#pragma unroll
    for (int a = 0; a < 2; ++a)
#pragma unroll
        for (int b = 0; b < 2; ++b)
#pragma unroll
            for (int m = 0; m < 4; ++m)
#pragma unroll
                for (int n = 0; n < 2; ++n) acc[a][b][m][n] = (f32x4){0.f, 0.f, 0.f, 0.f};
    bf16x8 At[4][2], B0[2][2], B1[2][2];
    const char* cA = (const char*)g.A + (size_t)cur.pm * tstep; const char* cB = (const char*)g.Bt + (size_t)cur.pn * tstep;
    S.a_ready(cur);
    PG8_STAGE(PG8_SB(0, 0), cB, voffB); PG8_STAGE(PG8_SA(0, 0), cA, voffA); PG8_STAGE(PG8_SB(0, 1), cB + hstep, voffB); PG8_STAGE(PG8_SA(0, 1), cA + hstep, voffA);
    if (wr == 1) PG8_BAR;
    PG8_WAIT_V(4); PG8_BAR;
    PG8_STAGE(PG8_SB(1, 0), cB + kstep, voffB); PG8_STAGE(PG8_SA(1, 0), cA + kstep, voffA); PG8_STAGE(PG8_SB(1, 1), cB + hstep + kstep, voffB);
    PG8_WAIT_V(6); PG8_BAR;
    PG8_STAMP();
    for (;;) {
        const bool has_next = S.next(ui + 1, nxt);
        const char* nA = has_next ? (const char*)g.A + (size_t)nxt.pm * tstep : cA; const char* nB = has_next ? (const char*)g.Bt + (size_t)nxt.pn * tstep : cB;
        for (int t = 0; t < nt; t += 2) {
            const bool last = (t == nt - 2);
            const char* a1 = cA + (size_t)(t + 1) * kstep;
            const char* a2 = last ? nA : cA + (size_t)(t + 2) * kstep; const char* b2 = last ? nB : cB + (size_t)(t + 2) * kstep;
            const char* a3 = a2 + kstep; const char* b3 = b2 + kstep;
            if (last && has_next) S.a_ready(nxt);
            PG8_LDB(B0, 0, 0); PG8_SCHED; PG8_LDA(At, 0, 0); PG8_STAGE(PG8_SA(1, 1), a1 + hstep, voffA);
            PG8_WAIT_L(8); PG8_BAR; PG8_WAIT_L(0); PG8_MMA(0, 0, At, B0); PG8_BAR; PG8_SCHED;
            PG8_LDB(B1, 0, 1); PG8_STAGE(PG8_SB(0, 0), b2, voffB);
            PG8_BAR; PG8_WAIT_L(0); PG8_MMA(0, 1, At, B1); PG8_BAR;
            PG8_LDA(At, 0, 1); PG8_STAGE(PG8_SA(0, 0), a2, voffA);
            PG8_BAR; PG8_WAIT_L(0); PG8_MMA(1, 0, At, B0); PG8_BAR; PG8_SCHED;
            PG8_STAGE(PG8_SB(0, 1), b2 + hstep, voffB);
            PG8_WAIT_V(6); PG8_BAR; PG8_MMA(1, 1, At, B1); PG8_BAR;
            PG8_LDB(B0, 1, 0); PG8_SCHED; PG8_LDA(At, 1, 0); PG8_STAGE(PG8_SA(0, 1), a2 + hstep, voffA);
            PG8_WAIT_L(8); PG8_BAR; PG8_WAIT_L(0); PG8_MMA(0, 0, At, B0); PG8_BAR; PG8_SCHED;
            PG8_LDB(B1, 1, 1); PG8_STAGE(PG8_SB(1, 0), b3, voffB);
            PG8_BAR; PG8_WAIT_L(0); PG8_MMA(0, 1, At, B1); PG8_BAR;
            PG8_LDA(At, 1, 1); PG8_STAGE(PG8_SA(1, 0), a3, voffA);
            PG8_BAR; PG8_WAIT_L(0); PG8_MMA(1, 0, At, B0); PG8_BAR; PG8_SCHED;
            PG8_STAGE(PG8_SB(1, 1), b3 + hstep, voffB);
            PG8_WAIT_V(6); PG8_BAR; PG8_MMA(1, 1, At, B1); PG8_BAR;
        }
        PG8_STAMP();
        if constexpr (!Epi::AFTER_DRAIN) { E(acc, cur, wr, wc, fr, fq); S.done(cur); }
        PG8_STAMP();
        if (!has_next) break;
#pragma unroll
        for (int a = 0; a < 2; ++a)
#pragma unroll
            for (int b = 0; b < 2; ++b)
#pragma unroll
                for (int m = 0; m < 4; ++m)
#pragma unroll
                    for (int n = 0; n < 2; ++n) acc[a][b][m][n] = (f32x4){0.f, 0.f, 0.f, 0.f};
        cur = nxt; cA = nA; cB = nB; ++ui;
    }
    PG8_WAIT_V(0);
    if (wr == 0) PG8_BAR;
    PG8_BAR;
    if constexpr (Epi::AFTER_DRAIN) { E.fused(acc, cur, wr, wc, fr, fq, lds, wid, lane); S.done(cur); }
    PG8_STAMP();
    if (STAMP && wid == 0) { stamps[lane] = lane < nts ? (((unsigned long long)(unsigned)ts_hi << 32) | (unsigned)ts_lo) : 0ull;
        if (lane == 62) stamps[62] = rt_entry; if (lane == 63) stamps[63] = (unsigned long long)wall_clock64(); }
#undef PG8_STAMP
#undef PG8_SA
#undef PG8_SB
#undef PG8_STAGE
#undef PG8_LDA
#undef PG8_LDB
#undef PG8_MMA
#undef PG8_WAIT_V
#undef PG8_WAIT_L
#undef PG8_BAR
#undef PG8_SCHED
}
}
using pg8::bf16_t; using pg8::bf16x8; using pg8::f32x4; using pg8::u32x4; using pg8::cvt_pk_bf16;
typedef unsigned u32x2 __attribute__((ext_vector_type(2)));
#define LAS __attribute__((address_space(3)))
#define MFMA16(a, b, c) __builtin_amdgcn_mfma_f32_16x16x32_bf16((a), (b), (c), 0, 0, 0)

constexpr int NTOK = 9216, NPR = 8192, NPROJ = 6656, NPROJ_GEMM = 6912, DMODEL = 2048, DFF = 5632;
constexpr float EPS = 1e-6f;
constexpr int PC_ZG = 3072, PC_ZS = 4096, PC_XBC = 5120;
constexpr size_t O_Y = 0;
constexpr size_t O_GCP = (size_t)NTOK * 2048;
constexpr size_t O_GSP = O_GCP + 4 * 3 * 3072;
constexpr size_t O_SCP = O_GSP + (size_t)4 * 8 * 128 * 128;
constexpr size_t O_SSP = O_SCP + 4 * 3 * 1536;
constexpr size_t O_GCS = O_SSP + (size_t)4 * 16 * 64 * 128;
constexpr size_t O_GSS = O_GCS + (size_t)128 * 3 * 3072;
constexpr size_t O_SCS = O_GSS + (size_t)128 * 8 * 128 * 128;
constexpr size_t O_SSS = O_SCS + (size_t)128 * 3 * 1536;
constexpr size_t OB_HB = O_GSS * 4;
constexpr size_t OB_WINT = OB_HB + (size_t)NTOK * 2048 * 2;
static_assert(OB_WINT + (size_t)NPROJ_GEMM * 2048 * 2 <= O_SCS * 4, "scratch overflows gdn_state_s");
constexpr size_t OB_GIA = O_SSS * 4;
constexpr size_t GIA_ITEM = 16384 + 16384 + 8192 + 16384;
static_assert(1024 * GIA_ITEM <= (size_t)128 * 16 * 64 * 128 * 4, "scratch overflows ssm_state_s");
constexpr size_t OFF_WOUT = 0;
constexpr size_t OFF_WGU = OFF_WOUT + (size_t)2048 * 2048 * 2;
constexpr size_t OFF_WDN = OFF_WGU + (size_t)11264 * 2048 * 2;
constexpr size_t OFF_PROJ = OFF_WDN + (size_t)2048 * 5632 * 2;
constexpr size_t OFF_MIX = OFF_PROJ + (size_t)NTOK * NPROJ * 2;
constexpr size_t OFF_X1B = OFF_MIX + (size_t)NTOK * 2048 * 2;
constexpr size_t OFF_FF = OFF_X1B + (size_t)NTOK * 2048 * 2;
constexpr size_t OFF_UT = OFF_FF + (size_t)NTOK * DFF * 2;
constexpr size_t OFF_YZ = OFF_UT + (size_t)1024 * 16384;
constexpr size_t OFF_GATES = OFF_YZ + (size_t)NPR * 1024 * 2;
constexpr size_t OFF_DT = OFF_GATES + (size_t)NTOK * 32 * 4;
constexpr size_t OFF_ACUM = OFF_DT + (size_t)NPR * 16 * 4;
constexpr size_t OFF_GL = OFF_ACUM + (size_t)NPR * 16 * 4;
constexpr size_t OFF_SS1 = OFF_GL + 1024 * 128;
constexpr size_t OFF_SS2 = OFF_SS1 + (size_t)NTOK * 32 * 4;
constexpr size_t OFF_CTR = OFF_SS2 + (size_t)NTOK * 32 * 4;
constexpr size_t WS_END = OFF_CTR + 256;

struct Params { const float* in[24]; float* out; unsigned char* ws; };
typedef const __attribute__((address_space(4))) Params CP;
__device__ __forceinline__ CP* get_params() { const __attribute__((address_space(4))) void* kp = (const __attribute__((address_space(4))) void*)__builtin_amdgcn_kernarg_segment_ptr(); asm volatile("" : "+s"(kp)); return (CP*)kp; }
enum { I_XP = 0, I_XS, I_SGC, I_SG, I_SSC, I_SS, I_ANW, I_WIN, I_GCW, I_GAL, I_GDB, I_GNW, I_SCW, I_SCB, I_SAL, I_SDB, I_SD, I_SNW, I_WOUT, I_FNW, I_WG, I_WU, I_WD, I_FINW };

__device__ __forceinline__ float bflo(unsigned w) { return __uint_as_float(w << 16); }
__device__ __forceinline__ float bfhi(unsigned w) { return __uint_as_float(w & 0xffff0000u); }
__device__ __forceinline__ float bf2f(bf16_t b) { return __uint_as_float(((unsigned)b) << 16); }
__device__ __forceinline__ bf16_t f2bf(float f) { return (bf16_t)(cvt_pk_bf16(f, 0.f) & 0xffffu); }
__device__ __forceinline__ void unpack8(const u32x4 v, float (&f)[8]) { f[0] = bflo(v.x); f[1] = bfhi(v.x); f[2] = bflo(v.y); f[3] = bfhi(v.y); f[4] = bflo(v.z); f[5] = bfhi(v.z); f[6] = bflo(v.w); f[7] = bfhi(v.w); }
__device__ __forceinline__ u32x4 pack8(const float (&f)[8]) { u32x4 o; o.x = cvt_pk_bf16(f[0], f[1]); o.y = cvt_pk_bf16(f[2], f[3]); o.z = cvt_pk_bf16(f[4], f[5]); o.w = cvt_pk_bf16(f[6], f[7]); return o; }
__device__ __forceinline__ u32x2 pack4(const f32x4 v) { u32x2 o; o.x = cvt_pk_bf16(v[0], v[1]); o.y = cvt_pk_bf16(v[2], v[3]); return o; }
__device__ __forceinline__ float siluf(float x) { return x / (1.f + __expf(-x)); }
__device__ __forceinline__ float sigmf(float x) { return 1.f / (1.f + __expf(-x)); }
__device__ __forceinline__ float softplusf(float x) { return fmaxf(x, 0.f) + log1pf(__expf(-fabsf(x))); }
__device__ __forceinline__ float wave_sum(float v) {
#pragma unroll
    for (int o = 1; o < 64; o <<= 1) v += __shfl_xor(v, o);
    return v;
}
__device__ __forceinline__ float wave_scan_incl(float v, int lane) {
#pragma unroll
    for (int o = 1; o < 64; o <<= 1) { const float t = __shfl_up(v, o); if (lane >= o) v += t; }
    return v;
}
__device__ __forceinline__ void ld8f(const float* p, float (&f)[8]) { const f32x4 a = *(const f32x4*)p, b = *(const f32x4*)(p + 4); f[0] = a[0]; f[1] = a[1]; f[2] = a[2]; f[3] = a[3]; f[4] = b[0]; f[5] = b[1]; f[6] = b[2]; f[7] = b[3]; }
__device__ __forceinline__ void ld8b(const bf16_t* p, float (&f)[8]) { const u32x4 v = *(const u32x4*)p; unpack8(v, f); }

__device__ __forceinline__ int win_src_col(int n) { if (n < 4096) return n; if (n < 6656) return n + 16; if (n < 6672) return n - 2560; if (n < 6688) return n; return -1; }

__device__ __forceinline__ void prep_tile(CP& p, LAS float* tile, int mat, int kt, int nt) {
    const int tid = opaque_tid(), n0 = nt * 64, k0 = kt * 64, nloc = (tid & 15) * 4, np = n0 + nloc;
    const float* src; int Nsrc, K, sc; bf16_t* dst; const float* ksc = nullptr;
    if (mat == 0) { src = p.in[I_WIN]; Nsrc = 6688; K = 2048; sc = win_src_col(np); dst = (bf16_t*)((unsigned char*)p.out + OB_WINT); }
    else if (mat == 1) { src = p.in[I_WOUT]; Nsrc = 2048; K = 2048; sc = np; dst = (bf16_t*)(p.ws + OFF_WOUT); }
    else if (mat == 2) { const int j = np >> 8, r = np & 255; src = (r < 128) ? p.in[I_WG] : p.in[I_WU]; Nsrc = DFF; K = 2048; sc = 128 * j + (r & 127); dst = (bf16_t*)(p.ws + OFF_WGU); ksc = p.in[I_FNW]; }
    else { src = p.in[I_WD]; Nsrc = 2048; K = DFF; sc = np; dst = (bf16_t*)(p.ws + OFF_WDN); }
#pragma unroll
    for (int hf = 0; hf < 2; ++hf) {
        const int k = (tid >> 4) + 32 * hf;
        f32x4 v = (f32x4){0.f, 0.f, 0.f, 0.f};
        if (sc >= 0) v = *(const f32x4*)(src + (size_t)(k0 + k) * Nsrc + sc);
        if (ksc) v = v * ksc[k0 + k];
        tile[k * 65 + nloc + 0] = v[0]; tile[k * 65 + nloc + 1] = v[1]; tile[k * 65 + nloc + 2] = v[2]; tile[k * 65 + nloc + 3] = v[3];
    }
    __syncthreads();
    { const int n = tid >> 3, c = tid & 7; float f[8];
#pragma unroll
      for (int i = 0; i < 8; ++i) f[i] = tile[(8 * c + i) * 65 + n];
      *(u32x4*)(dst + (size_t)(n0 + n) * K + k0 + 8 * c) = pack8(f); }
    __syncthreads();
}

__device__ __forceinline__ void phase_prep(CP& p, LAS unsigned char* lds) {
    const int tid = opaque_tid(), wv = tid >> 6, lane = tid & 63;
    { bf16_t* hb = (bf16_t*)((unsigned char*)p.out + OB_HB); const f32x4* wn = (const f32x4*)p.in[I_ANW];
      for (int row = blockIdx.x * 8 + wv; row < NTOK; row += gridDim.x * 8) {
          const float* xr = row < NPR ? p.in[I_XP] + (size_t)row * 2048 : p.in[I_XS] + (size_t)(row - NPR) * 2048;
          f32x4 v[8]; float s = 0.f;
#pragma unroll
          for (int j = 0; j < 8; ++j) { v[j] = ((const f32x4*)xr)[lane + 64 * j]; s += (v[j][0] * v[j][0] + v[j][1] * v[j][1]) + (v[j][2] * v[j][2] + v[j][3] * v[j][3]); }
          const float rinv = rsqrtf(wave_sum(s) * (1.f / 2048.f) + EPS);
          u32x2* o = (u32x2*)(hb + (size_t)row * 2048);
#pragma unroll
          for (int j = 0; j < 8; ++j) { const f32x4 w = wn[lane + 64 * j]; f32x4 y = v[j] * rinv * w; o[lane + 64 * j] = pack4(y); }
      } }
    { LAS float* tile = (LAS float*)lds;
      constexpr int T0 = 32 * 108, T1 = 32 * 32, T2 = 32 * 176, T3 = 88 * 32;
      for (int it = blockIdx.x; it < T0 + T1 + T2 + T3; it += gridDim.x) {
          int r = it;
          if (r < T0) { prep_tile(p, tile, 0, r / 108, r % 108); continue; } r -= T0;
          if (r < T1) { prep_tile(p, tile, 1, r / 32, r % 32); continue; } r -= T1;
          if (r < T2) { prep_tile(p, tile, 2, r / 176, r % 176); continue; } r -= T2;
          prep_tile(p, tile, 3, r / 32, r % 32);
      } }
}

struct EpiProj {
    static constexpr bool PERM = true, AFTER_DRAIN = false;
    bf16_t* O; float* gates;
    __device__ __forceinline__ void operator()(const f32x4 (&acc)[2][2][4][2], const pg8::Unit& u, int wr, int wc, int fr, int fq) const {
        const int row0 = u.pm * 256 + wr * 64 + fr, col0 = u.pn * 256 + wc * 32 + 8 * fq;
#pragma unroll
        for (int ai = 0; ai < 2; ++ai)
#pragma unroll
            for (int m = 0; m < 4; ++m) { const int row = row0 + ai * 128 + m * 16; bf16_t* rp = O + (size_t)row * NPROJ + col0;
                if (u.pn < 26) {
#pragma unroll
                for (int bj = 0; bj < 2; ++bj) { u32x4 w; const f32x4 v0 = acc[ai][bj][m][0], v1 = acc[ai][bj][m][1];
                    w.x = cvt_pk_bf16(v0[0], v0[1]); w.y = cvt_pk_bf16(v0[2], v0[3]); w.z = cvt_pk_bf16(v1[0], v1[1]); w.w = cvt_pk_bf16(v1[2], v1[3]);
                    *(u32x4*)(rp + bj * 128) = w; } }
                else if (wc == 0) { float* gp = gates + (size_t)row * 32 + 8 * fq; *(f32x4*)gp = acc[ai][0][m][0]; *(f32x4*)(gp + 4) = acc[ai][0][m][1]; } }
    }
};
struct EpiOut {
    static constexpr bool PERM = false, AFTER_DRAIN = false;
    const float* xp; const float* xs; float* out; bf16_t* x1b; float* ss;
    __device__ __forceinline__ void operator()(const f32x4 (&acc)[2][2][4][2], const pg8::Unit& u, int wr, int wc, int fr, int fq) const {
        const int row0 = u.pm * 256 + wr * 64 + fr, col0 = u.pn * 256 + wc * 32 + 4 * fq;
#pragma unroll
        for (int ai = 0; ai < 2; ++ai)
#pragma unroll
            for (int m = 0; m < 4; ++m) { const int row = row0 + ai * 128 + m * 16;
                const float* bp = (row < NPR ? xp + (size_t)row * 2048 : xs + (size_t)(row - NPR) * 2048) + col0;
                float* op = out + (size_t)row * 2048 + col0; bf16_t* hp = x1b + (size_t)row * 2048 + col0; float s = 0.f;
#pragma unroll
                for (int bj = 0; bj < 2; ++bj)
#pragma unroll
                    for (int n = 0; n < 2; ++n) { const f32x4 x1 = *(const f32x4*)(bp + bj * 128 + n * 16) + acc[ai][bj][m][n];
                        *(f32x4*)(op + bj * 128 + n * 16) = x1; *(u32x2*)(hp + bj * 128 + n * 16) = pack4(x1);
                        s += (x1[0] * x1[0] + x1[1] * x1[1]) + (x1[2] * x1[2] + x1[3] * x1[3]); }
                s += __shfl_xor(s, 16); s += __shfl_xor(s, 32);
                if (fq == 0) ss[((size_t)u.pn * NTOK + row) * 4 + wc] = s; }
    }
};
struct EpiGU {
    static constexpr bool PERM = true, AFTER_DRAIN = false;
    bf16_t* ff; const float* ss;
    __device__ __forceinline__ void operator()(const f32x4 (&acc)[2][2][4][2], const pg8::Unit& u, int wr, int wc, int fr, int fq) const {
        const int row0 = u.pm * 256 + wr * 64 + fr, col0 = u.pn * 128 + wc * 32 + 8 * fq;
#pragma unroll
        for (int ai = 0; ai < 2; ++ai)
#pragma unroll
            for (int m = 0; m < 4; ++m) { const int row = row0 + ai * 128 + m * 16;
                const f32x4 pa = *(const f32x4*)(ss + ((size_t)(2 * fq) * NTOK + row) * 4), pb = *(const f32x4*)(ss + ((size_t)(2 * fq + 1) * NTOK + row) * 4);
                float sq = ((pa[0] + pa[1]) + (pa[2] + pa[3])) + ((pb[0] + pb[1]) + (pb[2] + pb[3])); sq += __shfl_xor(sq, 16); sq += __shfl_xor(sq, 32);
                const float rinv = rsqrtf(sq * (1.f / 2048.f) + EPS); float f[8];
#pragma unroll
                for (int n = 0; n < 2; ++n)
#pragma unroll
                    for (int j = 0; j < 4; ++j) { const float g = acc[ai][0][m][n][j] * rinv, up = acc[ai][1][m][n][j] * rinv; f[4 * n + j] = siluf(g) * up; }
                *(u32x4*)(ff + (size_t)row * DFF + col0) = pack8(f); }
    }
};
struct EpiDown {
    static constexpr bool PERM = false, AFTER_DRAIN = false;
    float* out; float* ss;
    __device__ __forceinline__ void operator()(const f32x4 (&acc)[2][2][4][2], const pg8::Unit& u, int wr, int wc, int fr, int fq) const {
        const int row0 = u.pm * 256 + wr * 64 + fr, col0 = u.pn * 256 + wc * 32 + 4 * fq;
#pragma unroll
        for (int ai = 0; ai < 2; ++ai)
#pragma unroll
            for (int m = 0; m < 4; ++m) { const int row = row0 + ai * 128 + m * 16; float* op = out + (size_t)row * 2048 + col0; float s = 0.f;
#pragma unroll
                for (int bj = 0; bj < 2; ++bj)
#pragma unroll
                    for (int n = 0; n < 2; ++n) { const f32x4 x2 = *(const f32x4*)(op + bj * 128 + n * 16) + acc[ai][bj][m][n];
                        *(f32x4*)(op + bj * 128 + n * 16) = x2; s += (x2[0] * x2[0] + x2[1] * x2[1]) + (x2[2] * x2[2] + x2[3] * x2[3]); }
                s += __shfl_xor(s, 16); s += __shfl_xor(s, 32);
                if (fq == 0) ss[((size_t)u.pn * NTOK + row) * 4 + wc] = s; }
    }
};
__device__ __forceinline__ void conv8x8_prompt(const bf16_t* pc, int t0, const float* w, int ws, const float* bias, float (&out)[8][8]) {
    float w0[8], w1[8], w2[8], w3[8], bv[8], r0[8], r1[8], r2[8];
    ld8f(w, w0); ld8f(w + ws, w1); ld8f(w + 2 * ws, w2); ld8f(w + 3 * ws, w3);
    if (bias) ld8f(bias, bv); else {
#pragma unroll
        for (int c = 0; c < 8; ++c) bv[c] = 0.f; }
    if (t0 >= 3) { ld8b(pc + (size_t)(t0 - 3) * NPROJ, r0); ld8b(pc + (size_t)(t0 - 2) * NPROJ, r1); ld8b(pc + (size_t)(t0 - 1) * NPROJ, r2); }
    else {
#pragma unroll
        for (int c = 0; c < 8; ++c) { r0[c] = 0.f; r1[c] = 0.f; r2[c] = 0.f; } }
#pragma unroll
    for (int tt = 0; tt < 8; ++tt) { float cur[8]; ld8b(pc + (size_t)(t0 + tt) * NPROJ, cur);
#pragma unroll
        for (int c = 0; c < 8; ++c) { out[tt][c] = siluf(bv[c] + w0[c] * r0[c] + w1[c] * r1[c] + w2[c] * r2[c] + w3[c] * cur[c]); r0[c] = r1[c]; r1[c] = r2[c]; r2[c] = cur[c]; } }
}
__device__ __forceinline__ void conv1x8_sample(const bf16_t* pc, const float* st, int C, int t, const float* w, const float* bias, float (&o)[8], bool hist_ok = false) {
    float acc[8];
    if (bias) ld8f(bias, acc); else {
#pragma unroll
        for (int c = 0; c < 8; ++c) acc[c] = 0.f; }
#pragma unroll
    for (int i = 0; i < 4; ++i) { const int rr = t - 3 + i; float x[8], wi[8]; ld8f(w + i * C, wi);
        if (rr >= 0 || st == nullptr) { if (rr >= 0 || hist_ok) ld8b(pc + (long)rr * NPROJ, x); else {
#pragma unroll
                for (int c = 0; c < 8; ++c) x[c] = 0.f; } } else ld8f(st + (rr + 3) * C, x);
#pragma unroll
        for (int c = 0; c < 8; ++c) acc[c] += wi[c] * x[c]; }
#pragma unroll
    for (int c = 0; c < 8; ++c) o[c] = siluf(acc[c]);
}

__device__ __forceinline__ void gdn_chunk_item(CP& p, LAS unsigned char* lds, int item) {
    { unsigned lb_ = (unsigned)(size_t)lds; asm volatile("" : "+v"(lb_)); lds = (LAS unsigned char*)(size_t)lb_; }
    const int tid = opaque_tid(), wv = tid >> 6, lane = tid & 63, r = lane & 15, q = lane >> 4;
    const int n = item & 31, bh = item >> 5, h = bh & 7, b = bh >> 3, seqrow0 = b * 2048, t0c = n * 64;
    LAS bf16_t* qb = (LAS bf16_t*)lds; LAS bf16_t* kb = (LAS bf16_t*)(lds + 17408);
    LAS float* vs = (LAS float*)(lds + 34816); LAS float* Am = (LAS float*)(lds + 68608);
    LAS float* Gs = (LAS float*)(lds + 86016); LAS float* bs = Gs + 64;
    const bf16_t* proj = (const bf16_t*)(p.ws + OFF_PROJ); const float* gates = (const float*)(p.ws + OFF_GATES);
    unsigned char* gi = (unsigned char*)p.out + OB_GIA + (size_t)item * GIA_ITEM;
    bf16_t* Wg = (bf16_t*)gi; bf16_t* QDg = (bf16_t*)(gi + 16384); bf16_t* QKg = (bf16_t*)(gi + 32768); bf16_t* KDTg = (bf16_t*)(gi + 40960);
    bf16_t* UTg = (bf16_t*)(p.ws + OFF_UT + (size_t)item * 16384);
    if (tid < 384) {
        const int part = tid >> 7, seg = (tid >> 4) & 7, cgi = tid & 15, ch = part * 1024 + h * 128 + cgi * 8;
        float o[8][8];
        conv8x8_prompt(proj + (size_t)seqrow0 * NPROJ + ch, t0c + seg * 8, p.in[I_GCW] + ch, 3072, nullptr, o);
        if (part < 2) {
            LAS bf16_t* dstb = part == 0 ? qb : kb; const float extra = part == 0 ? 0.08838834764831845f : 1.f;
#pragma unroll
            for (int tt = 0; tt < 8; ++tt) { float ss = 0.f;
#pragma unroll
                for (int c = 0; c < 8; ++c) ss += o[tt][c] * o[tt][c];
                ss += __shfl_xor(ss, 1); ss += __shfl_xor(ss, 2); ss += __shfl_xor(ss, 4); ss += __shfl_xor(ss, 8);
                const float sc = rsqrtf(ss + EPS) * extra; float f[8];
#pragma unroll
                for (int c = 0; c < 8; ++c) f[c] = o[tt][c] * sc;
                *(LAS u32x4*)(dstb + (seg * 8 + tt) * 136 + cgi * 8) = pack8(f); }
        } else {
#pragma unroll
            for (int tt = 0; tt < 8; ++tt) { LAS float* vp = vs + (seg * 8 + tt) * 132 + cgi * 8;
                *(LAS f32x4*)vp = (f32x4){o[tt][0], o[tt][1], o[tt][2], o[tt][3]}; *(LAS f32x4*)(vp + 4) = (f32x4){o[tt][4], o[tt][5], o[tt][6], o[tt][7]}; }
        }
    } else if (wv == 6) {
        const int row = seqrow0 + t0c + lane;
        const float a_raw = gates[(size_t)row * 32 + 8 + h], b_raw = gates[(size_t)row * 32 + h];
        const float g = -__expf(p.in[I_GAL][h]) * softplusf(a_raw + p.in[I_GDB][h]);
        Gs[lane] = wave_scan_incl(g, lane); bs[lane] = sigmf(b_raw);
    }
    __syncthreads();
    {
        const int it = wv & 3, jh = wv >> 2;
        bf16x8 ki[4], qi[4];
#pragma unroll
        for (int k = 0; k < 4; ++k) { ki[k] = *(LAS bf16x8*)(kb + (16 * it + r) * 136 + 32 * k + 8 * q); qi[k] = *(LAS bf16x8*)(qb + (16 * it + r) * 136 + 32 * k + 8 * q); }
#pragma unroll
        for (int jj = 0; jj < 2; ++jj) { const int jt = 2 * jh + jj;
            f32x4 dkk = (f32x4){0.f, 0.f, 0.f, 0.f}, dT = (f32x4){0.f, 0.f, 0.f, 0.f};
#pragma unroll
            for (int k = 0; k < 4; ++k) { const bf16x8 kj = *(LAS bf16x8*)(kb + (16 * jt + r) * 136 + 32 * k + 8 * q); dkk = MFMA16(ki[k], kj, dkk); dT = MFMA16(kj, qi[k], dT); }
            const int jc = 16 * jt + r; const float Gj = Gs[jc];
#pragma unroll
            for (int e = 0; e < 4; ++e) { const int i = 16 * it + 4 * q + e; const float v = bs[i] * dkk[e] * __expf(fminf(Gs[i] - Gj, 0.f)); Am[i * 68 + jc] = (jc < i) ? v : 0.f; }
            const int ic = 16 * it + r; const float Gi = Gs[ic]; f32x4 tv;
#pragma unroll
            for (int e = 0; e < 4; ++e) { const int j = 16 * jt + 4 * q + e; const float v = dT[e] * __expf(fminf(Gi - Gs[j], 0.f)); tv[e] = (j <= ic) ? v : 0.f; }
            *(u32x2*)(QKg + ic * 64 + 16 * jt + 4 * q) = pack4(tv); }
    }
    __syncthreads();
    if (tid < 256) {
        const int c = tid; float x[64];
        if (c < 128) {
#pragma unroll
            for (int i = 0; i < 64; ++i) x[i] = bs[i] * vs[i * 132 + c];
        } else {
#pragma unroll
            for (int i = 0; i < 64; ++i) x[i] = bs[i] * __expf(Gs[i]) * bf2f(kb[i * 136 + (c - 128)]);
        }
#pragma unroll
        for (int i = 1; i < 64; ++i) { float a = x[i];
#pragma unroll
            for (int j4 = 0; j4 <= (i - 1) / 4; ++j4) { const f32x4 am = *(LAS f32x4*)(Am + i * 68 + 4 * j4);
                a -= am[0] * x[4 * j4]; a -= am[1] * x[4 * j4 + 1]; a -= am[2] * x[4 * j4 + 2]; a -= am[3] * x[4 * j4 + 3]; }
            x[i] = a; }
        if (c < 128) {
#pragma unroll
            for (int k = 0; k < 8; ++k) { float f[8];
#pragma unroll
                for (int e = 0; e < 8; ++e) f[e] = x[8 * k + e];
                *(u32x4*)(UTg + c * 64 + 8 * k) = pack8(f); }
        } else {
#pragma unroll
            for (int i = 0; i < 64; ++i) Wg[i * 128 + (c - 128)] = f2bf(x[i]);
        }
    } else {
        const int t = tid - 256;
        { const int i = t >> 2, ds = (t & 3) * 32; const float eg = __expf(Gs[i]);
#pragma unroll
          for (int v = 0; v < 4; ++v) { float f[8]; unpack8(*(LAS u32x4*)(qb + i * 136 + ds + 8 * v), f);
#pragma unroll
              for (int e = 0; e < 8; ++e) f[e] *= eg;
              *(u32x4*)(QDg + i * 128 + ds + 8 * v) = pack8(f); } }
        { const int d = t & 127, jh = t >> 7; const float Gl = Gs[63];
#pragma unroll
          for (int v = 0; v < 4; ++v) { float f[8];
#pragma unroll
              for (int e = 0; e < 8; ++e) { const int j = jh * 32 + 8 * v + e; f[e] = bf2f(kb[j * 136 + d]) * __expf(Gl - Gs[j]); }
              *(u32x4*)(KDTg + d * 64 + jh * 32 + 8 * v) = pack8(f); } }
        if (t == 0) ((float*)(p.ws + OFF_GL))[item * 32] = __expf(Gs[63]);
    }
    __syncthreads();
}

__device__ __forceinline__ void phase2(CP& p, LAS unsigned char* lds) {
    const int tid = opaque_tid(), wv = tid >> 6, lane = tid & 63;
    for (int item = blockIdx.x; item < 1024; item += gridDim.x) gdn_chunk_item(p, lds, item);
    const float* gates = (const float*)(p.ws + OFF_GATES);
    { float* DT = (float*)(p.ws + OFF_DT); float* AC = (float*)(p.ws + OFF_ACUM);
      for (int job = blockIdx.x * 8 + wv; job < 2048; job += gridDim.x * 8) { const int head = job & 15, row = (job >> 4) * 64 + lane;
          const float dt = softplusf(gates[(size_t)row * 32 + 16 + head] + p.in[I_SDB][head]);
          const float a = -__expf(p.in[I_SAL][head]) * dt;
          DT[head * NPR + row] = dt; AC[head * NPR + row] = wave_scan_incl(a, lane); } }
    { const bf16_t* proj = (const bf16_t*)(p.ws + OFF_PROJ);
      for (int idx = blockIdx.x * 512 + tid; idx < 132 * 3 * 576; idx += gridDim.x * 512) {
          const int cg8 = idx % 576, i = (idx / 576) % 3, bb = idx / (576 * 3);
          const int row = bb < 4 ? bb * 2048 + 2045 + i : NPR + (bb - 4) * 8 + 5 + i;
          float f[8]; float* o;
          if (cg8 < 384) { ld8b(proj + (size_t)row * NPROJ + cg8 * 8, f); o = p.out + (bb < 4 ? O_GCP + (size_t)(bb * 3 + i) * 3072 : O_GCS + (size_t)((bb - 4) * 3 + i) * 3072) + cg8 * 8; }
          else { const int c = (cg8 - 384) * 8; ld8b(proj + (size_t)row * NPROJ + PC_XBC + c, f); o = p.out + (bb < 4 ? O_SCP + (size_t)(bb * 3 + i) * 1536 : O_SCS + (size_t)((bb - 4) * 3 + i) * 1536) + c; }
          *(f32x4*)o = (f32x4){f[0], f[1], f[2], f[3]}; *(f32x4*)(o + 4) = (f32x4){f[4], f[5], f[6], f[7]}; } }
}

__device__ __forceinline__ void gdn_scan_item(CP& p, LAS unsigned char* lds, int bh) {
    { unsigned lb_ = (unsigned)(size_t)lds; asm volatile("" : "+v"(lb_)); lds = (LAS unsigned char*)(size_t)lb_; }
    const int tid = opaque_tid(), wv = tid >> 6, lane = tid & 63, r = lane & 15, q = lane >> 4;
    const int b = bh >> 3, h = bh & 7, ti = wv & 3, eh = wv >> 2;
    LAS bf16_t* St = (LAS bf16_t*)lds; LAS bf16_t* vnT = (LAS bf16_t*)(lds + 34816); LAS float* ssqp = (LAS float*)(lds + 34816 + 18432);
    const bf16_t* proj = (const bf16_t*)(p.ws + OFF_PROJ); bf16_t* mix = (bf16_t*)(p.ws + OFF_MIX);
    const float* GL = (const float*)(p.ws + OFF_GL); const float* gnw = p.in[I_GNW];
    f32x4 Sacc[2][4];
#pragma unroll
    for (int a = 0; a < 2; ++a)
#pragma unroll
        for (int e = 0; e < 4; ++e) Sacc[a][e] = (f32x4){0.f, 0.f, 0.f, 0.f};
    for (int i = tid; i < 34816 / 16; i += 512) ((LAS u32x4*)lds)[i] = (u32x4){0u, 0u, 0u, 0u};
    __syncthreads();
    for (int n = 0; n < 32; ++n) {
        const int item = bh * 32 + n;
        const unsigned char* gi = (const unsigned char*)p.out + OB_GIA + (size_t)item * GIA_ITEM;
        const bf16_t* Wg = (const bf16_t*)gi; const bf16_t* QDg = (const bf16_t*)(gi + 16384); const bf16_t* UTg = (const bf16_t*)(p.ws + OFF_UT + (size_t)item * 16384);
        const bf16_t* QKg = (const bf16_t*)(gi + 32768); const bf16_t* KDTg = (const bf16_t*)(gi + 40960);
        bf16x8 wA[4], qA[4];
#pragma unroll
        for (int k = 0; k < 4; ++k) { wA[k] = *(const bf16x8*)(Wg + (16 * ti + r) * 128 + 32 * k + 8 * q); qA[k] = *(const bf16x8*)(QDg + (16 * ti + r) * 128 + 32 * k + 8 * q); }
        f32x4 accq[4];
#pragma unroll
        for (int et = 0; et < 4; ++et) { const int E = 4 * eh + et; f32x4 accw = (f32x4){0.f, 0.f, 0.f, 0.f}; accq[et] = (f32x4){0.f, 0.f, 0.f, 0.f};
#pragma unroll
            for (int k = 0; k < 4; ++k) { const bf16x8 sf = *(LAS bf16x8*)(St + (16 * E + r) * 136 + 32 * k + 8 * q); accw = MFMA16(wA[k], sf, accw); accq[et] = MFMA16(qA[k], sf, accq[et]); }
            const u32x2 uw = *(const u32x2*)(UTg + (16 * E + r) * 64 + 16 * ti + 4 * q); const f32x4 u = (f32x4){bflo(uw.x), bfhi(uw.x), bflo(uw.y), bfhi(uw.y)};
            *(LAS u32x2*)(vnT + (16 * E + r) * 72 + 16 * ti + 4 * q) = pack4(u - accw); }
        __syncthreads();
        bf16x8 qkA[2], kA[2][2];
#pragma unroll
        for (int k2 = 0; k2 < 2; ++k2) { qkA[k2] = *(const bf16x8*)(QKg + (16 * ti + r) * 64 + 32 * k2 + 8 * q);
#pragma unroll
            for (int dd = 0; dd < 2; ++dd) kA[dd][k2] = *(const bf16x8*)(KDTg + (16 * (2 * ti + dd) + r) * 64 + 32 * k2 + 8 * q); }
        const float gl = GL[item * 32];
#pragma unroll
        for (int et = 0; et < 4; ++et) { const int E = 4 * eh + et; bf16x8 bv[2];
#pragma unroll
            for (int k2 = 0; k2 < 2; ++k2) bv[k2] = *(LAS bf16x8*)(vnT + (16 * E + r) * 72 + 32 * k2 + 8 * q);
#pragma unroll
            for (int k2 = 0; k2 < 2; ++k2) accq[et] = MFMA16(qkA[k2], bv[k2], accq[et]);
#pragma unroll
            for (int dd = 0; dd < 2; ++dd) { Sacc[dd][et] = Sacc[dd][et] * gl;
#pragma unroll
                for (int k2 = 0; k2 < 2; ++k2) Sacc[dd][et] = MFMA16(kA[dd][k2], bv[k2], Sacc[dd][et]);
                *(LAS u32x2*)(St + (16 * E + r) * 136 + 16 * (2 * ti + dd) + 4 * q) = pack4(Sacc[dd][et]); } }
        float s4[4];
#pragma unroll
        for (int j = 0; j < 4; ++j) { float s = 0.f;
#pragma unroll
            for (int et = 0; et < 4; ++et) s += accq[et][j] * accq[et][j];
            s += __shfl_xor(s, 1); s += __shfl_xor(s, 2); s += __shfl_xor(s, 4); s += __shfl_xor(s, 8); s4[j] = s; }
        if (r == 0) {
#pragma unroll
            for (int j = 0; j < 4; ++j) ssqp[eh * 64 + 16 * ti + 4 * q + j] = s4[j]; }
        __syncthreads();
#pragma unroll
        for (int j = 0; j < 4; ++j) { const int i = 16 * ti + 4 * q + j; const float rinv = rsqrtf((ssqp[i] + ssqp[64 + i]) * (1.f / 128.f) + EPS);
            const size_t row = (size_t)b * 2048 + n * 64 + i;
#pragma unroll
            for (int et = 0; et < 4; ++et) { const int e = 16 * (4 * eh + et) + r; const float zg = bf2f(proj[row * NPROJ + PC_ZG + h * 128 + e]);
                mix[row * 2048 + h * 128 + e] = f2bf(accq[et][j] * rinv * gnw[e] * siluf(zg)); } }
    }
    float* so = p.out + O_GSP + (size_t)bh * 128 * 128;
#pragma unroll
    for (int dd = 0; dd < 2; ++dd)
#pragma unroll
        for (int et = 0; et < 4; ++et)
#pragma unroll
            for (int j = 0; j < 4; ++j) so[(16 * (2 * ti + dd) + 4 * q + j) * 128 + 16 * (4 * eh + et) + r] = Sacc[dd][et][j];
    __syncthreads();
}

__device__ __forceinline__ void ssd_scan_item(CP& p, LAS unsigned char* lds, int bhd) {
    { unsigned lb_ = (unsigned)(size_t)lds; asm volatile("" : "+v"(lb_)); lds = (LAS unsigned char*)(size_t)lb_; }
    const int tid = opaque_tid(), wv = tid >> 6, lane = tid & 63, r = lane & 15, q = lane >> 4;
    const int b = bhd >> 4, head = bhd & 15, g = head >> 3, it = wv & 3, jh = wv >> 2;
    LAS bf16_t* Cb = (LAS bf16_t*)lds; LAS bf16_t* Bb = (LAS bf16_t*)(lds + 17408); LAS bf16_t* BdT = (LAS bf16_t*)(lds + 34816);
    LAS bf16_t* xdtT = (LAS bf16_t*)(lds + 53248); LAS bf16_t* sc = (LAS bf16_t*)(lds + 62464); LAS bf16_t* hb = (LAS bf16_t*)(lds + 71680);
    LAS float* xs = (LAS float*)(lds + 89088); LAS float* acs = (LAS float*)(lds + 105728);
    const bf16_t* proj = (const bf16_t*)(p.ws + OFF_PROJ); const float* DT = (const float*)(p.ws + OFF_DT); const float* AC = (const float*)(p.ws + OFF_ACUM);
    bf16_t* YZ = (bf16_t*)(p.ws + OFF_YZ); const float Dh = p.in[I_SD][head];
    f32x4 hacc[4];
#pragma unroll
    for (int e = 0; e < 4; ++e) hacc[e] = (f32x4){0.f, 0.f, 0.f, 0.f};
    for (int i = tid; i < 17408 / 16; i += 512) ((LAS u32x4*)(lds + 71680))[i] = (u32x4){0u, 0u, 0u, 0u};
    __syncthreads();
    for (int n = 0; n < 32; ++n) {
        const int r0 = b * 2048 + n * 64;
        if ((n & 1) == 0) {
            bf16_t* hst = (bf16_t*)(p.ws + OFF_YZ) + ((size_t)(bhd * 16 + (n >> 1)) * 64) * 128;
            for (int i = tid; i < 1024; i += 512) { const int p_ = i >> 4, sg = i & 15; *(u32x4*)(hst + p_ * 128 + sg * 8) = *(LAS u32x4*)(hb + p_ * 136 + sg * 8); } }
        if (tid < 320) {
            const int seg = tid / 40, cgi = tid % 40; float o[8][8];
            const int ch = cgi < 8 ? head * 64 + cgi * 8 : (cgi < 24 ? 1024 + g * 128 + (cgi - 8) * 8 : 1280 + g * 128 + (cgi - 24) * 8);
            conv8x8_prompt(proj + (size_t)b * 2048 * NPROJ + PC_XBC + ch, n * 64 + seg * 8, p.in[I_SCW] + ch, 1536, p.in[I_SCB] + ch, o);
            if (cgi < 8) { const int p0 = cgi * 8; float dtv[8];
#pragma unroll
                for (int tt = 0; tt < 8; ++tt) dtv[tt] = DT[head * NPR + r0 + seg * 8 + tt];
#pragma unroll
                for (int tt = 0; tt < 8; ++tt)
#pragma unroll
                    for (int c = 0; c < 8; ++c) xs[(seg * 8 + tt) * 65 + p0 + c] = o[tt][c];
#pragma unroll
                for (int c = 0; c < 8; ++c) { float f[8];
#pragma unroll
                    for (int tt = 0; tt < 8; ++tt) f[tt] = o[tt][c] * dtv[tt];
                    *(LAS u32x4*)(xdtT + (p0 + c) * 72 + seg * 8) = pack8(f); }
            } else if (cgi < 24) { const int s0 = (cgi - 8) * 8; float dec[8]; const float alast = AC[head * NPR + r0 + 63];
#pragma unroll
                for (int tt = 0; tt < 8; ++tt) dec[tt] = __expf(alast - AC[head * NPR + r0 + seg * 8 + tt]);
#pragma unroll
                for (int tt = 0; tt < 8; ++tt) *(LAS u32x4*)(Bb + (seg * 8 + tt) * 136 + s0) = pack8(o[tt]);
#pragma unroll
                for (int c = 0; c < 8; ++c) { float f[8];
#pragma unroll
                    for (int tt = 0; tt < 8; ++tt) f[tt] = o[tt][c] * dec[tt];
                    *(LAS u32x4*)(BdT + (s0 + c) * 72 + seg * 8) = pack8(f); }
            } else { const int s0 = (cgi - 24) * 8;
#pragma unroll
                for (int tt = 0; tt < 8; ++tt) *(LAS u32x4*)(Cb + (seg * 8 + tt) * 136 + s0) = pack8(o[tt]); }
        } else if (wv == 5) { acs[lane] = AC[head * NPR + r0 + lane]; }
        __syncthreads();
        bf16x8 cf[4]; f32x4 yacc[2];
#pragma unroll
        for (int k = 0; k < 4; ++k) cf[k] = *(LAS bf16x8*)(Cb + (16 * it + r) * 136 + 32 * k + 8 * q);
#pragma unroll
        for (int jj = 0; jj < 2; ++jj) { const int jt = 2 * jh + jj;
            f32x4 d = (f32x4){0.f, 0.f, 0.f, 0.f}, y = (f32x4){0.f, 0.f, 0.f, 0.f};
#pragma unroll
            for (int k = 0; k < 4; ++k) { const bf16x8 bf = *(LAS bf16x8*)(Bb + (16 * jt + r) * 136 + 32 * k + 8 * q); d = MFMA16(bf, cf[k], d);
                const bf16x8 hf = *(LAS bf16x8*)(hb + (16 * jt + r) * 136 + 32 * k + 8 * q); y = MFMA16(cf[k], hf, y); }
            const int ic = 16 * it + r; const float ai = acs[ic]; f32x4 tv;
#pragma unroll
            for (int e = 0; e < 4; ++e) { const int j = 16 * jt + 4 * q + e; const float v = d[e] * __expf(fminf(ai - acs[j], 0.f)); tv[e] = (j <= ic) ? v : 0.f; }
            *(LAS u32x2*)(sc + ic * 72 + 16 * jt + 4 * q) = pack4(tv);
#pragma unroll
            for (int e = 0; e < 4; ++e) y[e] *= __expf(acs[16 * it + 4 * q + e]);
            yacc[jj] = y; }
        __syncthreads();
        { bf16x8 sf[2], bdf[2];
#pragma unroll
          for (int k2 = 0; k2 < 2; ++k2) { sf[k2] = *(LAS bf16x8*)(sc + (16 * it + r) * 72 + 32 * k2 + 8 * q); bdf[k2] = *(LAS bf16x8*)(BdT + (16 * wv + r) * 72 + 32 * k2 + 8 * q); }
          const float al = __expf(acs[63]);
#pragma unroll
          for (int pt = 0; pt < 4; ++pt) { bf16x8 xf[2];
#pragma unroll
              for (int k2 = 0; k2 < 2; ++k2) xf[k2] = *(LAS bf16x8*)(xdtT + (16 * pt + r) * 72 + 32 * k2 + 8 * q);
              hacc[pt] = hacc[pt] * al;
#pragma unroll
              for (int k2 = 0; k2 < 2; ++k2) hacc[pt] = MFMA16(bdf[k2], xf[k2], hacc[pt]);
              *(LAS u32x2*)(hb + (16 * pt + r) * 136 + 16 * wv + 4 * q) = pack4(hacc[pt]);
              if ((pt >> 1) == jh) {
#pragma unroll
                  for (int k2 = 0; k2 < 2; ++k2) yacc[pt & 1] = MFMA16(sf[k2], xf[k2], yacc[pt & 1]); } } }
#pragma unroll
        for (int jj = 0; jj < 2; ++jj) { const int pc = 16 * (2 * jh + jj) + r;
#pragma unroll
            for (int e = 0; e < 4; ++e) { const int i = 16 * it + 4 * q + e; const size_t row = (size_t)r0 + i;
                const float y = yacc[jj][e] + Dh * xs[i * 65 + pc]; const float z = bf2f(proj[row * NPROJ + PC_ZS + head * 64 + pc]);
                if (DBG_SSD_SEQ == 4 && DBG_SUBSET((int)(row & 2047))) YZ[row * 1024 + head * 64 + pc] = f2bf(y * siluf(z)); } }
        __syncthreads();
    }
    float* so = p.out + O_SSP + (size_t)bhd * 64 * 128;
#pragma unroll
    for (int pt = 0; pt < 4; ++pt) *(f32x4*)(so + (16 * pt + r) * 128 + 16 * wv + 4 * q) = hacc[pt];
}
__device__ __forceinline__ void ssd_sample_item(CP& p, LAS unsigned char* lds, int bg) {
    { unsigned lb_ = (unsigned)(size_t)lds; asm volatile("" : "+v"(lb_)); lds = (LAS unsigned char*)(size_t)lb_; }
    const int tid = opaque_tid(), wv = tid >> 6, lane = tid & 63;
    const int b = bg >> 1, g = bg & 1, r0 = NPR + b * 8;
    LAS float* xs = (LAS float*)lds; LAS float* Bs = (LAS float*)(lds + 16384); LAS float* Cs = (LAS float*)(lds + 20480);
    LAS float* dts = (LAS float*)(lds + 24576); LAS float* dAs = (LAS float*)(lds + 24832); LAS float* yzs = (LAS float*)(lds + 25088);
    const bf16_t* proj = (const bf16_t*)(p.ws + OFF_PROJ); const float* gates = (const float*)(p.ws + OFF_GATES); bf16_t* mix = (bf16_t*)(p.ws + OFF_MIX);
    const int pp = tid >> 3, nq = tid & 7;
    const float* sin = p.in[I_SS] + ((size_t)(b * 16 + g * 8) * 64 + pp) * 128 + nq * 16;
    float* sout = p.out + O_SSS + ((size_t)(b * 16 + g * 8) * 64 + pp) * 128 + nq * 16;
    f32x4 hn[4];
#pragma unroll
    for (int v = 0; v < 4; ++v) hn[v] = *(const f32x4*)(sin + 4 * v);
    for (int idx = tid; idx < 768; idx += 512) { const int t = idx / 96, cgi = idx % 96; float o[8];
        const int ch = cgi < 64 ? g * 512 + cgi * 8 : (cgi < 80 ? 1024 + g * 128 + (cgi - 64) * 8 : 1280 + g * 128 + (cgi - 80) * 8);
        conv1x8_sample(proj + (size_t)r0 * NPROJ + PC_XBC + ch, p.in[I_SSC] + (size_t)b * 3 * 1536 + ch, 1536, t, p.in[I_SCW] + ch, p.in[I_SCB] + ch, o);
        LAS float* dst = cgi < 64 ? xs + t * 512 + cgi * 8 : (cgi < 80 ? Bs + t * 128 + (cgi - 64) * 8 : Cs + t * 128 + (cgi - 80) * 8);
        *(LAS f32x4*)dst = (f32x4){o[0], o[1], o[2], o[3]}; *(LAS f32x4*)(dst + 4) = (f32x4){o[4], o[5], o[6], o[7]}; }
    if (tid < 64) { const int t = tid >> 3, hh = tid & 7, head = g * 8 + hh;
        const float dt = softplusf(gates[(size_t)(r0 + t) * 32 + 16 + head] + p.in[I_SDB][head]);
        dts[t * 8 + hh] = dt; dAs[t * 8 + hh] = __expf(-__expf(p.in[I_SAL][head]) * dt); }
    __syncthreads();
    for (int hh = 0; hh < 8; ++hh) { const int head = g * 8 + hh;
        float hr[16];
#pragma unroll
        for (int v = 0; v < 4; ++v) { hr[4 * v] = hn[v][0]; hr[4 * v + 1] = hn[v][1]; hr[4 * v + 2] = hn[v][2]; hr[4 * v + 3] = hn[v][3]; }
        if (hh < 7) {
#pragma unroll
            for (int v = 0; v < 4; ++v) hn[v] = *(const f32x4*)(sin + (size_t)(hh + 1) * 64 * 128 + 4 * v); }
        const float Dh = p.in[I_SD][head];
#pragma unroll
        for (int t = 0; t < 8; ++t) { const float dA = dAs[t * 8 + hh], xv = xs[t * 512 + hh * 64 + pp], dtx = dts[t * 8 + hh] * xv; float yp = 0.f;
#pragma unroll
            for (int v = 0; v < 4; ++v) { const f32x4 bv = *(LAS f32x4*)(Bs + t * 128 + nq * 16 + 4 * v), cv = *(LAS f32x4*)(Cs + t * 128 + nq * 16 + 4 * v);
#pragma unroll
                for (int e = 0; e < 4; ++e) { hr[4 * v + e] = dA * hr[4 * v + e] + dtx * bv[e]; yp += hr[4 * v + e] * cv[e]; } }
            yp += __shfl_xor(yp, 1); yp += __shfl_xor(yp, 2); yp += __shfl_xor(yp, 4);
            if (nq == 0) { const float y = yp + Dh * xv; const float z = bf2f(proj[(size_t)(r0 + t) * NPROJ + PC_ZS + head * 64 + pp]); yzs[t * 512 + hh * 64 + pp] = y * siluf(z); } }
#pragma unroll
        for (int v = 0; v < 4; ++v) *(f32x4*)(sout + (size_t)hh * 64 * 128 + 4 * v) = (f32x4){hr[4 * v], hr[4 * v + 1], hr[4 * v + 2], hr[4 * v + 3]};
    }
    __syncthreads();
    { const int t = wv; float f[8]; float ss = 0.f;
      const f32x4 a = *(LAS f32x4*)(yzs + t * 512 + lane * 8), c = *(LAS f32x4*)(yzs + t * 512 + lane * 8 + 4);
      f[0] = a[0]; f[1] = a[1]; f[2] = a[2]; f[3] = a[3]; f[4] = c[0]; f[5] = c[1]; f[6] = c[2]; f[7] = c[3];
#pragma unroll
      for (int e = 0; e < 8; ++e) ss += f[e] * f[e];
      const float rinv = rsqrtf(wave_sum(ss) * (1.f / 512.f) + EPS); float w[8]; ld8f(p.in[I_SNW] + g * 512 + lane * 8, w);
#pragma unroll
      for (int e = 0; e < 8; ++e) f[e] *= rinv * w[e];
      *(u32x4*)(mix + (size_t)(r0 + t) * 2048 + 1024 + g * 512 + lane * 8) = pack8(f); }
    __syncthreads();
}

__device__ __forceinline__ void ssd_prompt_par_item(CP& p, LAS unsigned char* lds, int item) {
    { unsigned lb_ = (unsigned)(size_t)lds; asm volatile("" : "+v"(lb_)); lds = (LAS unsigned char*)(size_t)lb_; }
    const int tid = opaque_tid(), wv = tid >> 6, lane = tid & 63;
    const int c128 = item & 15, g = (item >> 4) & 1, b = item >> 5;
    LAS float* xs = (LAS float*)lds; LAS float* Bs = (LAS float*)(lds + 16384); LAS float* Cs = (LAS float*)(lds + 20480);
    LAS float* dts = (LAS float*)(lds + 24576); LAS float* dAs = (LAS float*)(lds + 24832); LAS float* yzs = (LAS float*)(lds + 25088);
    const bf16_t* proj = (const bf16_t*)(p.ws + OFF_PROJ); const float* gates = (const float*)(p.ws + OFF_GATES); bf16_t* mix = (bf16_t*)(p.ws + OFF_MIX);
    const int pp = tid >> 3, nq = tid & 7;
    float hr[8][16];
#pragma unroll
    for (int hh = 0; hh < 8; ++hh) { const bf16_t* hs = (const bf16_t*)(p.ws + OFF_YZ) + (((size_t)((b * 16 + g * 8 + hh) * 16 + c128) * 64) + pp) * 128 + nq * 16;
        float f0[8], f1[8]; ld8b(hs, f0); ld8b(hs + 8, f1);
#pragma unroll
        for (int e = 0; e < 8; ++e) { hr[hh][e] = f0[e]; hr[hh][8 + e] = f1[e]; } }
    for (int w8 = 0; w8 < 16; ++w8) { const int r0 = b * 2048 + c128 * 128 + w8 * 8;
    for (int idx = tid; idx < 768; idx += 512) { const int t = idx / 96, cgi = idx % 96; float o[8];
        const int ch = cgi < 64 ? g * 512 + cgi * 8 : (cgi < 80 ? 1024 + g * 128 + (cgi - 64) * 8 : 1280 + g * 128 + (cgi - 80) * 8);
        conv1x8_sample(proj + (size_t)r0 * NPROJ + PC_XBC + ch, nullptr, 1536, t, p.in[I_SCW] + ch, p.in[I_SCB] + ch, o, (c128 | w8) != 0);
        LAS float* dst = cgi < 64 ? xs + t * 512 + cgi * 8 : (cgi < 80 ? Bs + t * 128 + (cgi - 64) * 8 : Cs + t * 128 + (cgi - 80) * 8);
        *(LAS f32x4*)dst = (f32x4){o[0], o[1], o[2], o[3]}; *(LAS f32x4*)(dst + 4) = (f32x4){o[4], o[5], o[6], o[7]}; }
    if (tid < 64) { const int t = tid >> 3, hh = tid & 7, head = g * 8 + hh;
        const float dt = softplusf(gates[(size_t)(r0 + t) * 32 + 16 + head] + p.in[I_SDB][head]);
        dts[t * 8 + hh] = dt; dAs[t * 8 + hh] = __expf(-__expf(p.in[I_SAL][head]) * dt); }
    __syncthreads();
#pragma unroll
    for (int hh = 0; hh < 8; ++hh) { const int head = g * 8 + hh;
        const float Dh = p.in[I_SD][head];
#pragma unroll
        for (int t = 0; t < 8; ++t) { const float dA = dAs[t * 8 + hh], xv = xs[t * 512 + hh * 64 + pp], dtx = dts[t * 8 + hh] * xv; float yp = 0.f;
#pragma unroll
            for (int v = 0; v < 4; ++v) { const f32x4 bv = *(LAS f32x4*)(Bs + t * 128 + nq * 16 + 4 * v), cv = *(LAS f32x4*)(Cs + t * 128 + nq * 16 + 4 * v);
#pragma unroll
                for (int e = 0; e < 4; ++e) { hr[hh][4 * v + e] = dA * hr[hh][4 * v + e] + dtx * bv[e]; yp += hr[hh][4 * v + e] * cv[e]; } }
            yp += __shfl_xor(yp, 1); yp += __shfl_xor(yp, 2); yp += __shfl_xor(yp, 4);
            if (nq == 0) { const float y = yp + Dh * xv; const float z = bf2f(proj[(size_t)(r0 + t) * NPROJ + PC_ZS + head * 64 + pp]); yzs[t * 512 + hh * 64 + pp] = y * siluf(z); } }
    }
    __syncthreads();
    { const int t = wv; float f[8]; float ss = 0.f;
      const f32x4 a = *(LAS f32x4*)(yzs + t * 512 + lane * 8), c = *(LAS f32x4*)(yzs + t * 512 + lane * 8 + 4);
      f[0] = a[0]; f[1] = a[1]; f[2] = a[2]; f[3] = a[3]; f[4] = c[0]; f[5] = c[1]; f[6] = c[2]; f[7] = c[3];
#pragma unroll
      for (int e = 0; e < 8; ++e) ss += f[e] * f[e];
      const float rinv = rsqrtf(wave_sum(ss) * (1.f / 512.f) + EPS); float w[8]; ld8f(p.in[I_SNW] + g * 512 + lane * 8, w);
#pragma unroll
      for (int e = 0; e < 8; ++e) f[e] *= rinv * w[e];
      *(u32x4*)(mix + (size_t)(r0 + t) * 2048 + 1024 + g * 512 + lane * 8) = pack8(f); }
    __syncthreads();
    }
}


__device__ __forceinline__ void ssd_prompt_seq_item(CP& p, LAS unsigned char* lds, int bg) {
    { unsigned lb_ = (unsigned)(size_t)lds; asm volatile("" : "+v"(lb_)); lds = (LAS unsigned char*)(size_t)lb_; }
    const int tid = opaque_tid(), wv = tid >> 6, lane = tid & 63;
    const int b = bg >> 1, g = bg & 1;
    LAS float* xs = (LAS float*)lds; LAS float* Bs = (LAS float*)(lds + 16384); LAS float* Cs = (LAS float*)(lds + 20480);
    LAS float* dts = (LAS float*)(lds + 24576); LAS float* dAs = (LAS float*)(lds + 24832); LAS float* yzs = (LAS float*)(lds + 25088);
    const bf16_t* proj = (const bf16_t*)(p.ws + OFF_PROJ); const float* gates = (const float*)(p.ws + OFF_GATES); bf16_t* mix = (bf16_t*)(p.ws + OFF_MIX);
    const int pp = tid >> 3, nq = tid & 7;
    float* carry_ = (DBG_SSD_SEQ == 2 || DBG_SSD_SEQ == 4) ? (float*)(p.ws + OFF_FF) : p.out + O_SSP;
    const float* sin = carry_ + ((size_t)(b * 16 + g * 8) * 64 + pp) * 128 + nq * 16;
    float* sout = carry_ + ((size_t)(b * 16 + g * 8) * 64 + pp) * 128 + nq * 16;
    for (int w8 = 0; w8 < 256; ++w8) { const int r0 = b * 2048 + w8 * 8;
    f32x4 hn[4];
#pragma unroll
    for (int v = 0; v < 4; ++v) hn[v] = w8 ? *(const f32x4*)(sin + 4 * v) : (f32x4){0.f, 0.f, 0.f, 0.f};
    for (int idx = tid; idx < 768; idx += 512) { const int t = idx / 96, cgi = idx % 96; float o[8];
        const int ch = cgi < 64 ? g * 512 + cgi * 8 : (cgi < 80 ? 1024 + g * 128 + (cgi - 64) * 8 : 1280 + g * 128 + (cgi - 80) * 8);
        conv1x8_sample(proj + (size_t)r0 * NPROJ + PC_XBC + ch, nullptr, 1536, t, p.in[I_SCW] + ch, p.in[I_SCB] + ch, o, w8 > 0);
        LAS float* dst = cgi < 64 ? xs + t * 512 + cgi * 8 : (cgi < 80 ? Bs + t * 128 + (cgi - 64) * 8 : Cs + t * 128 + (cgi - 80) * 8);
        *(LAS f32x4*)dst = (f32x4){o[0], o[1], o[2], o[3]}; *(LAS f32x4*)(dst + 4) = (f32x4){o[4], o[5], o[6], o[7]}; }
    if (tid < 64) { const int t = tid >> 3, hh = tid & 7, head = g * 8 + hh;
        const float dt = softplusf(gates[(size_t)(r0 + t) * 32 + 16 + head] + p.in[I_SDB][head]);
        dts[t * 8 + hh] = dt; dAs[t * 8 + hh] = __expf(-__expf(p.in[I_SAL][head]) * dt); }
    __syncthreads();
    for (int hh = 0; hh < 8; ++hh) { const int head = g * 8 + hh;
        float hr[16];
#pragma unroll
        for (int v = 0; v < 4; ++v) { hr[4 * v] = hn[v][0]; hr[4 * v + 1] = hn[v][1]; hr[4 * v + 2] = hn[v][2]; hr[4 * v + 3] = hn[v][3]; }
        if (hh < 7) {
#pragma unroll
            for (int v = 0; v < 4; ++v) hn[v] = w8 ? *(const f32x4*)(sin + (size_t)(hh + 1) * 64 * 128 + 4 * v) : (f32x4){0.f, 0.f, 0.f, 0.f}; }
        const float Dh = p.in[I_SD][head];
#pragma unroll
        for (int t = 0; t < 8; ++t) { const float dA = dAs[t * 8 + hh], xv = xs[t * 512 + hh * 64 + pp], dtx = dts[t * 8 + hh] * xv; float yp = 0.f;
#pragma unroll
            for (int v = 0; v < 4; ++v) { const f32x4 bv = *(LAS f32x4*)(Bs + t * 128 + nq * 16 + 4 * v), cv = *(LAS f32x4*)(Cs + t * 128 + nq * 16 + 4 * v);
#pragma unroll
                for (int e = 0; e < 4; ++e) { hr[4 * v + e] = dA * hr[4 * v + e] + dtx * bv[e]; yp += hr[4 * v + e] * cv[e]; } }
            yp += __shfl_xor(yp, 1); yp += __shfl_xor(yp, 2); yp += __shfl_xor(yp, 4);
            if (nq == 0) { const float y = yp + Dh * xv; const float z = bf2f(proj[(size_t)(r0 + t) * NPROJ + PC_ZS + head * 64 + pp]); yzs[t * 512 + hh * 64 + pp] = y * siluf(z); } }
#pragma unroll
        for (int v = 0; v < 4; ++v) *(f32x4*)(sout + (size_t)hh * 64 * 128 + 4 * v) = (f32x4){hr[4 * v], hr[4 * v + 1], hr[4 * v + 2], hr[4 * v + 3]};
    }
    __syncthreads();
    { const int t = wv; float f[8]; float ss = 0.f;
      const f32x4 a = *(LAS f32x4*)(yzs + t * 512 + lane * 8), c = *(LAS f32x4*)(yzs + t * 512 + lane * 8 + 4);
      f[0] = a[0]; f[1] = a[1]; f[2] = a[2]; f[3] = a[3]; f[4] = c[0]; f[5] = c[1]; f[6] = c[2]; f[7] = c[3];
#pragma unroll
      for (int e = 0; e < 8; ++e) ss += f[e] * f[e];
      const float rinv = rsqrtf(wave_sum(ss) * (1.f / 512.f) + EPS); float w[8]; ld8f(p.in[I_SNW] + g * 512 + lane * 8, w);
#pragma unroll
      for (int e = 0; e < 8; ++e) f[e] *= rinv * w[e];
      if (DBG_SSD_SEQ >= 3) { if (DBG_SSD_SEQ == 3 || !DBG_SUBSET((r0 + t) & 2047)) { float f2[8]; f2[0] = a[0]; f2[1] = a[1]; f2[2] = a[2]; f2[3] = a[3]; f2[4] = c[0]; f2[5] = c[1]; f2[6] = c[2]; f2[7] = c[3];
          *(u32x4*)((bf16_t*)(p.ws + OFF_YZ) + (size_t)(r0 + t) * 1024 + g * 512 + lane * 8) = pack8(f2); } }
      else *(u32x4*)(mix + (size_t)(r0 + t) * 2048 + 1024 + g * 512 + lane * 8) = pack8(f); }
    __syncthreads();
    }
}


__device__ __forceinline__ void gdn_sample_item(CP& p, LAS unsigned char* lds, int bh) {
    { unsigned lb_ = (unsigned)(size_t)lds; asm volatile("" : "+v"(lb_)); lds = (LAS unsigned char*)(size_t)lb_; }
    const int tid = opaque_tid(), wv = tid >> 6, lane = tid & 63;
    const int b = bh >> 3, h = bh & 7, r0 = NPR + b * 8;
    LAS float* qs = (LAS float*)lds; LAS float* ks = (LAS float*)(lds + 4096); LAS float* vs = (LAS float*)(lds + 8192);
    LAS float* as = (LAS float*)(lds + 12288); LAS float* bs = as + 8; LAS float* part = (LAS float*)(lds + 12544); LAS float* opart = (LAS float*)(lds + 16640);
    const bf16_t* proj = (const bf16_t*)(p.ws + OFF_PROJ); const float* gates = (const float*)(p.ws + OFF_GATES); bf16_t* mix = (bf16_t*)(p.ws + OFF_MIX);
    const int e = tid & 127, dq = tid >> 7;
    const float* sin = p.in[I_SG] + ((size_t)bh * 128 + dq * 32) * 128 + e;
    float* sout = p.out + O_GSS + ((size_t)bh * 128 + dq * 32) * 128 + e;
    float S[32];
#pragma unroll
    for (int d = 0; d < 32; ++d) S[d] = sin[d * 128];
    if (tid < 384) { const int part_ = tid >> 7, t = (tid >> 4) & 7, cgi = tid & 15, ch = part_ * 1024 + h * 128 + cgi * 8; float o[8];
        conv1x8_sample(proj + (size_t)r0 * NPROJ + ch, p.in[I_SGC] + (size_t)b * 3 * 3072 + ch, 3072, t, p.in[I_GCW] + ch, nullptr, o);
        if (part_ < 2) { float ss = 0.f;
#pragma unroll
            for (int c = 0; c < 8; ++c) ss += o[c] * o[c];
            ss += __shfl_xor(ss, 1); ss += __shfl_xor(ss, 2); ss += __shfl_xor(ss, 4); ss += __shfl_xor(ss, 8);
            const float sc = rsqrtf(ss + EPS) * (part_ == 0 ? 0.08838834764831845f : 1.f);
#pragma unroll
            for (int c = 0; c < 8; ++c) o[c] *= sc; }
        LAS float* dst = (part_ == 0 ? qs : (part_ == 1 ? ks : vs)) + t * 128 + cgi * 8;
        *(LAS f32x4*)dst = (f32x4){o[0], o[1], o[2], o[3]}; *(LAS f32x4*)(dst + 4) = (f32x4){o[4], o[5], o[6], o[7]};
    } else if (tid < 392) { const int t = tid - 384;
        const float gg = -__expf(p.in[I_GAL][h]) * softplusf(gates[(size_t)(r0 + t) * 32 + 8 + h] + p.in[I_GDB][h]);
        as[t] = __expf(gg); bs[t] = sigmf(gates[(size_t)(r0 + t) * 32 + h]); }
    __syncthreads();
    float op[8];
#pragma unroll
    for (int t = 0; t < 8; ++t) { float kp = 0.f;
#pragma unroll
        for (int v = 0; v < 8; ++v) { const f32x4 kv = *(LAS f32x4*)(ks + t * 128 + dq * 32 + 4 * v); kp += kv[0] * S[4 * v] + kv[1] * S[4 * v + 1] + kv[2] * S[4 * v + 2] + kv[3] * S[4 * v + 3]; }
        part[(t & 1) * 512 + dq * 128 + e] = kp;
        __syncthreads();
        const float kd = (part[(t & 1) * 512 + e] + part[(t & 1) * 512 + 128 + e]) + (part[(t & 1) * 512 + 256 + e] + part[(t & 1) * 512 + 384 + e]);
        const float a = as[t], coef = bs[t] * (vs[t * 128 + e] - a * kd); float oq = 0.f;
#pragma unroll
        for (int v = 0; v < 8; ++v) { const f32x4 kv = *(LAS f32x4*)(ks + t * 128 + dq * 32 + 4 * v), qv = *(LAS f32x4*)(qs + t * 128 + dq * 32 + 4 * v);
#pragma unroll
            for (int c = 0; c < 4; ++c) { S[4 * v + c] = a * S[4 * v + c] + kv[c] * coef; oq += qv[c] * S[4 * v + c]; } }
        op[t] = oq; }
#pragma unroll
    for (int t = 0; t < 8; ++t) opart[(dq * 8 + t) * 128 + e] = op[t];
#pragma unroll
    for (int d = 0; d < 32; ++d) sout[d * 128] = S[d];
    __syncthreads();
    { const int t = wv; float o2[2]; float ss = 0.f;
#pragma unroll
      for (int k = 0; k < 2; ++k) { const int ee = lane + 64 * k; o2[k] = (opart[(0 * 8 + t) * 128 + ee] + opart[(1 * 8 + t) * 128 + ee]) + (opart[(2 * 8 + t) * 128 + ee] + opart[(3 * 8 + t) * 128 + ee]); ss += o2[k] * o2[k]; }
      const float rinv = rsqrtf(wave_sum(ss) * (1.f / 128.f) + EPS);
#pragma unroll
      for (int k = 0; k < 2; ++k) { const int ee = lane + 64 * k; const float zg = bf2f(proj[(size_t)(r0 + t) * NPROJ + PC_ZG + h * 128 + ee]);
          mix[(size_t)(r0 + t) * 2048 + h * 128 + ee] = f2bf(o2[k] * rinv * p.in[I_GNW][ee] * siluf(zg)); } }
    __syncthreads();
}

__device__ __forceinline__ void gdn_prompt_seq_item(CP& p, LAS unsigned char* lds, int bh) {
    { unsigned lb_ = (unsigned)(size_t)lds; asm volatile("" : "+v"(lb_)); lds = (LAS unsigned char*)(size_t)lb_; }
    const int tid = opaque_tid(), wv = tid >> 6, lane = tid & 63;
    const int b = bh >> 3, h = bh & 7;
    LAS float* qs = (LAS float*)lds; LAS float* ks = (LAS float*)(lds + 4096); LAS float* vs = (LAS float*)(lds + 8192);
    LAS float* as = (LAS float*)(lds + 12288); LAS float* bs = as + 8; LAS float* part = (LAS float*)(lds + 12544); LAS float* opart = (LAS float*)(lds + 16640);
    const bf16_t* proj = (const bf16_t*)(p.ws + OFF_PROJ); const float* gates = (const float*)(p.ws + OFF_GATES); bf16_t* mix = (bf16_t*)(p.ws + OFF_MIX);
    const int e = tid & 127, dq = tid >> 7;
    float* sout = p.out + O_GSP + ((size_t)bh * 128 + dq * 32) * 128 + e;
    float S[32];
#pragma unroll
    for (int d = 0; d < 32; ++d) S[d] = 0.f;
    for (int w8 = 0; w8 < 256; ++w8) { const int r0 = b * 2048 + w8 * 8;
    if (tid < 384) { const int part_ = tid >> 7, t = (tid >> 4) & 7, cgi = tid & 15, ch = part_ * 1024 + h * 128 + cgi * 8; float o[8];
        conv1x8_sample(proj + (size_t)r0 * NPROJ + ch, nullptr, 3072, t, p.in[I_GCW] + ch, nullptr, o, w8 > 0);
        if (part_ < 2) { float ss = 0.f;
#pragma unroll
            for (int c = 0; c < 8; ++c) ss += o[c] * o[c];
            ss += __shfl_xor(ss, 1); ss += __shfl_xor(ss, 2); ss += __shfl_xor(ss, 4); ss += __shfl_xor(ss, 8);
            const float sc = rsqrtf(ss + EPS) * (part_ == 0 ? 0.08838834764831845f : 1.f);
#pragma unroll
            for (int c = 0; c < 8; ++c) o[c] *= sc; }
        LAS float* dst = (part_ == 0 ? qs : (part_ == 1 ? ks : vs)) + t * 128 + cgi * 8;
        *(LAS f32x4*)dst = (f32x4){o[0], o[1], o[2], o[3]}; *(LAS f32x4*)(dst + 4) = (f32x4){o[4], o[5], o[6], o[7]};
    } else if (tid < 392) { const int t = tid - 384;
        const float gg = -__expf(p.in[I_GAL][h]) * softplusf(gates[(size_t)(r0 + t) * 32 + 8 + h] + p.in[I_GDB][h]);
        as[t] = __expf(gg); bs[t] = sigmf(gates[(size_t)(r0 + t) * 32 + h]); }
    __syncthreads();
    float op[8];
#pragma unroll
    for (int t = 0; t < 8; ++t) { float kp = 0.f;
#pragma unroll
        for (int v = 0; v < 8; ++v) { const f32x4 kv = *(LAS f32x4*)(ks + t * 128 + dq * 32 + 4 * v); kp += kv[0] * S[4 * v] + kv[1] * S[4 * v + 1] + kv[2] * S[4 * v + 2] + kv[3] * S[4 * v + 3]; }
        part[(t & 1) * 512 + dq * 128 + e] = kp;
        __syncthreads();
        const float kd = (part[(t & 1) * 512 + e] + part[(t & 1) * 512 + 128 + e]) + (part[(t & 1) * 512 + 256 + e] + part[(t & 1) * 512 + 384 + e]);
        const float a = as[t], coef = bs[t] * (vs[t * 128 + e] - a * kd); float oq = 0.f;
#pragma unroll
        for (int v = 0; v < 8; ++v) { const f32x4 kv = *(LAS f32x4*)(ks + t * 128 + dq * 32 + 4 * v), qv = *(LAS f32x4*)(qs + t * 128 + dq * 32 + 4 * v);
#pragma unroll
            for (int c = 0; c < 4; ++c) { S[4 * v + c] = a * S[4 * v + c] + kv[c] * coef; oq += qv[c] * S[4 * v + c]; } }
        op[t] = oq; }
#pragma unroll
    for (int t = 0; t < 8; ++t) opart[(dq * 8 + t) * 128 + e] = op[t];
    __syncthreads();
    { const int t = wv; float o2[2]; float ss = 0.f;
#pragma unroll
      for (int k = 0; k < 2; ++k) { const int ee = lane + 64 * k; o2[k] = (opart[(0 * 8 + t) * 128 + ee] + opart[(1 * 8 + t) * 128 + ee]) + (opart[(2 * 8 + t) * 128 + ee] + opart[(3 * 8 + t) * 128 + ee]); ss += o2[k] * o2[k]; }
      const float rinv = rsqrtf(wave_sum(ss) * (1.f / 128.f) + EPS);
#pragma unroll
      for (int k = 0; k < 2; ++k) { const int ee = lane + 64 * k; const float zg = bf2f(proj[(size_t)(r0 + t) * NPROJ + PC_ZG + h * 128 + ee]);
          mix[(size_t)(r0 + t) * 2048 + h * 128 + ee] = f2bf(o2[k] * rinv * p.in[I_GNW][ee] * siluf(zg)); } }
    __syncthreads();
    }
#pragma unroll
    for (int d = 0; d < 32; ++d) sout[d * 128] = S[d];
}


#ifndef ITEMMASK
#define ITEMMASK 15
#endif

template <int KIND> __device__ __forceinline__ void phase3_loop(CP& p, LAS unsigned char* lds, int nitems) {
    unsigned* ctr = (unsigned*)(p.ws + OFF_CTR) + KIND;
    LAS int* sitem = (LAS int*)(lds + 130048);
    for (;;) {
        if (threadIdx.x == 0) *sitem = (int)atomicAdd(ctr, 1u);
        __syncthreads();
        const int item = *sitem;
        __syncthreads();
        if (item >= nitems) break;
        if (KIND == 0) gdn_scan_item(p, lds, item);
        if (KIND == 1) ssd_scan_item(p, lds, item);
        if (KIND == 2) ssd_sample_item(p, lds, item);
        if (KIND == 3) gdn_sample_item(p, lds, item);
        if (KIND == 4) gdn_prompt_seq_item(p, lds, item);
        if (KIND == 5) ssd_prompt_seq_item(p, lds, item);
        if (KIND == 6) ssd_prompt_par_item(p, lds, item);
    }
}
__device__ __forceinline__ void phase3(LAS unsigned char* lds) {
#ifdef DBG_GDN_SEQ
    { CP& p = *get_params(); phase3_loop<4>(p, lds, 32); }
#else
    if (ITEMMASK & 1) { CP& p = *get_params(); phase3_loop<0>(p, lds, 32); }
#endif
#if DBG_SSD_SEQ
    { CP& p = *get_params(); phase3_loop<5>(p, lds, 8); }
    if (DBG_SSD_SEQ == 2 || DBG_SSD_SEQ == 4) { CP& p = *get_params(); phase3_loop<1>(p, lds, 64); }
#else
    if (ITEMMASK & 2) { CP& p = *get_params(); phase3_loop<1>(p, lds, 64); }
#endif
    if (ITEMMASK & 8) { CP& p = *get_params(); phase3_loop<3>(p, lds, 1024); }
}

__device__ __forceinline__ void phase4(LAS unsigned char* lds) {
#if !DBG_SSD_SEQ
    { CP& p = *get_params(); phase3_loop<6>(p, lds, 128); }
#endif
    { CP& p = *get_params(); phase3_loop<2>(p, lds, 256); }
    CP& p = *get_params();
    const int tid_ = opaque_tid(), wv = tid_ >> 6, lane = tid_ & 63;
    const bf16_t* YZ = (const bf16_t*)(p.ws + OFF_YZ); bf16_t* mix = (bf16_t*)(p.ws + OFF_MIX);
#if DBG_SSD_SEQ >= 3
    for (int job = blockIdx.x * 8 + wv; job < NPR * 2; job += gridDim.x * 8) { const int row = job >> 1, g = job & 1; float f[8], w[8]; float ss = 0.f;
        ld8b(YZ + (size_t)row * 1024 + g * 512 + lane * 8, f);
#pragma unroll
        for (int e = 0; e < 8; ++e) ss += f[e] * f[e];
        const float rinv = rsqrtf(wave_sum(ss) * (1.f / 512.f) + EPS); ld8f(p.in[I_SNW] + g * 512 + lane * 8, w);
#pragma unroll
        for (int e = 0; e < 8; ++e) f[e] *= rinv * w[e];
        *(u32x4*)(mix + (size_t)row * 2048 + 1024 + g * 512 + lane * 8) = pack8(f); }
#endif
}
__device__ __forceinline__ void phase_final(CP& p) {
    const int tid_ = opaque_tid(), wv = tid_ >> 6, lane = tid_ & 63;
    const float* ss = (const float*)(p.ws + OFF_SS2); const f32x4* wn = (const f32x4*)p.in[I_FINW];
    for (int row = blockIdx.x * 8 + wv; row < NTOK; row += gridDim.x * 8) { const float rinv = rsqrtf(wave_sum(lane < 32 ? ss[((size_t)(lane >> 2) * NTOK + row) * 4 + (lane & 3)] : 0.f) * (1.f / 2048.f) + EPS);
        f32x4* xr = (f32x4*)(p.out + (size_t)row * 2048);
#ifndef DBG_SCALE_S
#define DBG_SCALE_S 1.0f
#endif
#ifndef DBG_SCALE_P
#define DBG_SCALE_P 1.0f
#endif
        const float dsc = row < NPR ? DBG_SCALE_P : DBG_SCALE_S;
#pragma unroll
        for (int j = 0; j < 8; ++j) { const f32x4 v = xr[lane + 64 * j]; xr[lane + 64 * j] = v * (rinv * dsc) * wn[lane + 64 * j]; } }
}

#ifndef SKIPMASK
#define SKIPMASK 0
#endif
#define GSYNC() do { __builtin_amdgcn_fence(__ATOMIC_RELEASE, "agent"); grid.sync(); __builtin_amdgcn_fence(__ATOMIC_ACQUIRE, "agent"); asm volatile("s_waitcnt vmcnt(0)" ::: "memory"); } while (0)
#ifndef MAXPHASE
#define MAXPHASE 99
#endif
__global__ __launch_bounds__(512, 2) void mega(Params p_unused) {
    extern __shared__ __attribute__((aligned(16))) unsigned char shm[];
    LAS unsigned char* lds = (LAS unsigned char*)shm;
    cg::grid_group grid = cg::this_grid();
    pg8::StaticOrder S;
#if !((SKIPMASK >> 0) & 1)
    { CP& p = *get_params(); phase_prep(p, lds); }
#endif
    GSYNC();
#if !((SKIPMASK >> 1) & 1)
    { CP& p = *get_params(); pg8::Gemm g{(const bf16_t*)((const unsigned char*)p.out + OB_HB), (const bf16_t*)((const unsigned char*)p.out + OB_WINT), NTOK, NPROJ_GEMM, 2048}; S.init(g.M, g.N, (int)gridDim.x, (int)blockIdx.x);
      EpiProj E{(bf16_t*)(p.ws + OFF_PROJ), (float*)(p.ws + OFF_GATES)}; pg8::gemm_phase<EpiProj, pg8::StaticOrder, false>(lds, g, S, E, nullptr); }
#endif
    GSYNC();
    if (MAXPHASE < 2) return;
#if !((SKIPMASK >> 2) & 1)
    { CP& p = *get_params(); phase2(p, lds); }
#endif
    GSYNC();
    if (MAXPHASE < 3) return;
#if !((SKIPMASK >> 3) & 1)
    phase3(lds);
#endif
    GSYNC();
    if (MAXPHASE < 4) return;
#if !((SKIPMASK >> 4) & 1)
    phase4(lds);
#endif
    GSYNC();
#ifdef DBG_DUMP_MIX
    { CP& p = *get_params(); const bf16_t* src = (const bf16_t*)(p.ws + (DBG_DUMP_MIX == 1 ? OFF_MIX : OFF_PROJ)); const int ld = DBG_DUMP_MIX == 1 ? 2048 : NPROJ; const int c0 = DBG_DUMP_MIX == 1 ? 0 : (DBG_DUMP_MIX - 2) * 2048;
      for (size_t i = (size_t)blockIdx.x * 512 + threadIdx.x; i < (size_t)NTOK * 2048; i += (size_t)gridDim.x * 512) { const size_t r = i >> 11, c = i & 2047; float v = bf2f(src[r * ld + c0 + c]);
#ifdef DBG_Q
          { const int qd = (r >= NPR ? 2 : 0) + (c >= 1024 ? 1 : 0); if (qd != DBG_Q) v = 0.f; }
#endif
#if DBG_DUMP_MIX == 10
          v = ((const float*)(p.ws + OFF_GATES))[r * 32 + (c & 31)];
#endif
#if DBG_DUMP_MIX == 11
          v = (r < NPR) ? ((const float*)(p.ws + OFF_DT))[(c & 15) * NPR + r] + ((const float*)(p.ws + OFF_ACUM))[(c & 15) * NPR + r] : 0.f;
#endif
#if DBG_DUMP_MIX == 9
          v = (r < NPR && c < 1024) ? bf2f(((const bf16_t*)(p.ws + OFF_YZ))[r * 1024 + c]) : 0.f;
#endif
          p.out[i] = v; } }
    return;
#endif
#if !((SKIPMASK >> 5) & 1)
    { CP& p = *get_params(); pg8::Gemm g{(const bf16_t*)(p.ws + OFF_MIX), (const bf16_t*)(p.ws + OFF_WOUT), NTOK, 2048, 2048}; S.init(g.M, g.N, (int)gridDim.x, (int)blockIdx.x);
      EpiOut E{p.in[I_XP], p.in[I_XS], p.out, (bf16_t*)(p.ws + OFF_X1B), (float*)(p.ws + OFF_SS1)}; pg8::gemm_phase<EpiOut, pg8::StaticOrder, false>(lds, g, S, E, nullptr); }
#endif
    GSYNC();
    if (MAXPHASE < 6) return;
#if !((SKIPMASK >> 6) & 1)
    { CP& p = *get_params(); pg8::Gemm g{(const bf16_t*)(p.ws + OFF_X1B), (const bf16_t*)(p.ws + OFF_WGU), NTOK, 2 * DFF, 2048}; S.init(g.M, g.N, (int)gridDim.x, (int)blockIdx.x);
      EpiGU E{(bf16_t*)(p.ws + OFF_FF), (const float*)(p.ws + OFF_SS1)}; pg8::gemm_phase<EpiGU, pg8::StaticOrder, false>(lds, g, S, E, nullptr); }
#endif
    GSYNC();
    if (MAXPHASE < 7) return;
#if !((SKIPMASK >> 7) & 1)
    { CP& p = *get_params(); pg8::Gemm g{(const bf16_t*)(p.ws + OFF_FF), (const bf16_t*)(p.ws + OFF_WDN), NTOK, 2048, DFF}; S.init(g.M, g.N, (int)gridDim.x, (int)blockIdx.x);
      EpiDown E{p.out, (float*)(p.ws + OFF_SS2)}; pg8::gemm_phase<EpiDown, pg8::StaticOrder, false>(lds, g, S, E, nullptr); }
#endif
    GSYNC();
    if (MAXPHASE < 8) return;
#if !((SKIPMASK >> 8) & 1)
    { CP& p = *get_params(); phase_final(p); }
#endif
}

extern "C" void kernel_launch(void* const* d_in, const int* in_sizes, int n_in, void* d_out, int out_size, void* d_ws, size_t ws_size, hipStream_t stream) {
    constexpr size_t kDynLds = 131072;
    static int grid_blocks = 0;
    if (!grid_blocks) {
        int dev = 0, cus = 0, per_cu = 0;
        hipGetDevice(&dev);
        hipDeviceGetAttribute(&cus, hipDeviceAttributeMultiprocessorCount, dev);
        hipFuncSetAttribute((const void*)mega, hipFuncAttributeMaxDynamicSharedMemorySize, (int)kDynLds);
        hipOccupancyMaxActiveBlocksPerMultiprocessor(&per_cu, (const void*)mega, 512, kDynLds);
        if (per_cu < 1) { fprintf(stderr, "occupancy query returned %d\n", per_cu); per_cu = 1; }
        grid_blocks = cus * (per_cu > 1 ? 1 : per_cu);
        if (ws_size < WS_END) fprintf(stderr, "workspace too small: %zu < %zu\n", ws_size, (size_t)WS_END);
    }
    Params p{};
    for (int i = 0; i < 24; ++i) p.in[i] = (const float*)d_in[i];
    p.out = (float*)d_out; p.ws = (unsigned char*)d_ws;
    hipMemsetAsync((char*)d_ws + OFF_CTR, 0, 256, stream);
    void* args[] = {&p};
    hipError_t e = hipLaunchCooperativeKernel((const void*)mega, dim3(grid_blocks), dim3(512), args, kDynLds, stream);
    if (e != hipSuccess) fprintf(stderr, "cooperative launch failed: %s (grid %d)\n", hipGetErrorString(e), grid_blocks);
}
```

```cpp
#include <hip/hip_runtime.h>
#include <hip/hip_cooperative_groups.h>
#include <cstdio>
namespace cg = cooperative_groups;
__device__ __forceinline__ int opaque_tid() { int t = threadIdx.x; asm volatile("" : "+v"(t)); return t; }
#ifndef DBG_SSD_SEQ
#define DBG_SSD_SEQ 0
#endif
#ifndef DBG_SUBSET
#define DBG_SUBSET(t) ((t) < 64)
#endif
typedef float f32x2p __attribute__((ext_vector_type(2)));
template <int CTRL> __device__ __forceinline__ float dppf(float v) { return __builtin_bit_cast(float, __builtin_amdgcn_update_dpp(0, __builtin_bit_cast(int, v), CTRL, 0xf, 0xf, true)); }
__device__ __forceinline__ float sum8_dpp(float v) { v += dppf<0xB1>(v); v += dppf<0x4E>(v); v += dppf<0x141>(v); return v; }
#define LDS_BARRIER() do { asm volatile("s_waitcnt lgkmcnt(0)" ::: "memory"); __builtin_amdgcn_s_barrier(); asm volatile("" ::: "memory"); } while (0)
__device__ __forceinline__ float sum16_dpp(float v) { v += dppf<0xB1>(v); v += dppf<0x4E>(v); v += dppf<0x141>(v); v += dppf<0x140>(v); return v; }
namespace pg8 {
#define PG8_LAS __attribute__((address_space(3)))
typedef unsigned short bf16_t;
typedef short bf16x8 __attribute__((ext_vector_type(8)));
typedef float f32x4 __attribute__((ext_vector_type(4)));
typedef unsigned u32x4 __attribute__((ext_vector_type(4)));
constexpr int BM = 256, BK = 64, HALF = 128, HTB = HALF * BK * 2  , STAGE_BYTES = 8 * HTB, NXCD = 8, WGM = 8;

__host__ __device__ __forceinline__ int lds_byte(int r, int c) { const int st = (r >> 4) * 2 + (c >> 5), rr = r & 15, cc = c & 31, ob = rr * 64 + cc * 2; return st * 1024 + (ob ^ (((ob >> 9) & 1) << 5)); }
__host__ __device__ __forceinline__ void stage_rc(int b, int& R, int& C) { const int st = b / 1024, sb = b % 1024, swz = sb ^ (((sb >> 9) & 1) << 5); R = (st >> 1) * 16 + swz / 64; C = (st & 1) * 32 + (swz % 64) / 2; }
__host__ __device__ __forceinline__ int perm32(int rho) { const int n = rho >> 4, i = rho & 15; return 8 * (i >> 2) + 4 * n + (i & 3); }

struct Unit { int pm, pn; };
struct Gemm { const bf16_t* A; const bf16_t* Bt; int M, N, K; };

struct StaticOrder {
    int nM, nN, nwg, G, c;
    __host__ __device__ void init(int M, int N, int G_, int c_) { nM = M / BM; nN = N / BM; nwg = nM * nN; G = G_; c = c_; }
    __host__ __device__ bool next(int i, Unit& u) const {
        const long L = (long)i * G + c; if (L >= nwg) return false;
        int wgid = (int)L; { const int q = nwg / NXCD, r = nwg % NXCD, xcd = wgid % NXCD, off = wgid / NXCD; wgid = (xcd < r ? xcd * (q + 1) : r * (q + 1) + (xcd - r) * q) + off; }
        const int nig = WGM * nN, gid = wgid / nig, fm = gid * WGM, gsz = (nM - fm) < WGM ? (nM - fm) : WGM;
        u.pm = fm + ((wgid % nig) % gsz); u.pn = (wgid % nig) / gsz; return true;
    }
    __device__ __forceinline__ void a_ready(const Unit&) const {}
    __device__ __forceinline__ void done(const Unit&) const {}
};
typedef float f32x2cv __attribute__((ext_vector_type(2)));
typedef __bf16 bf16x2cv __attribute__((ext_vector_type(2)));
__device__ __forceinline__ unsigned cvt_pk_bf16(float lo, float hi) { f32x2cv v = {lo, hi}; bf16x2cv b = __builtin_convertvector(v, bf16x2cv); return __builtin_bit_cast(unsigned, b); }
template <class Epi, class Sched, bool STAMP = false>
__device__ __forceinline__ void gemm_phase(PG8_LAS unsigned char* lds, const Gemm g, const Sched& S, const Epi& E, unsigned long long* stamps) {
    const int tid = opaque_tid(), wid = __builtin_amdgcn_readfirstlane(tid >> 6), lane = tid & 63, wr = wid >> 2, wc = wid & 3, fr = lane & 15, fq = lane >> 4;
    const int K = g.K, nt = K / BK;
    int ts_lo = 0, ts_hi = 0, nts = 0; const unsigned long long rt_entry = STAMP ? (unsigned long long)wall_clock64() : 0ull;
#define PG8_STAMP() do { if (STAMP && wid == 0 && nts < 64) { const unsigned long long _c = (unsigned long long)clock64(); \
        ts_lo = (lane == nts) ? (int)(unsigned)_c : ts_lo; ts_hi = (lane == nts) ? (int)(unsigned)(_c >> 32) : ts_hi; ++nts; } } while (0)
    PG8_STAMP();
    unsigned voffA[2], voffB[2];
#pragma unroll
    for (int i = 0; i < 2; ++i) { int R, C; stage_rc(tid * 16 + i * 8192, R, C); const int Rb = Epi::PERM ? ((R & ~31) + perm32(R & 31)) : R;
        voffA[i] = (unsigned)(R * K + C) * 2u; voffB[i] = (unsigned)(Rb * K + C) * 2u; }
    const size_t kstep = (size_t)(BK * 2);
    const size_t hstep = (size_t)HALF * K * 2;
    const size_t tstep = 2 * hstep;
    const unsigned ldsw = (unsigned)wid * 1024u;
    const int aoff = lds_byte(wr * 64 + fr, fq * 8), boff = lds_byte(wc * 32 + fr, fq * 8);
#define PG8_SA(b, h) (((b) * 2 + (h)) * HTB)
#define PG8_SB(b, h) ((4 + (b) * 2 + (h)) * HTB)
#define PG8_STAGE(bufoff, gbase, voff) do { _Pragma("unroll") for (int _i = 0; _i < 2; ++_i) \
        __builtin_amdgcn_global_load_lds((const unsigned*)((const char*)(gbase) + (voff)[_i]), (PG8_LAS unsigned*)(lds + (bufoff) + ldsw + _i * 8192), 16, 0, 0); } while (0)
#define PG8_LDA(dst, b, h) do { _Pragma("unroll") for (int m = 0; m < 4; ++m) _Pragma("unroll") for (int k = 0; k < 2; ++k) dst[m][k] = *(const PG8_LAS bf16x8*)(lds + PG8_SA(b, h) + aoff + m * 2048 + k * 1024); } while (0)
#define PG8_LDB(dst, b, h) do { _Pragma("unroll") for (int n = 0; n < 2; ++n) _Pragma("unroll") for (int k = 0; k < 2; ++k) dst[n][k] = *(const PG8_LAS bf16x8*)(lds + PG8_SB(b, h) + boff + n * 2048 + k * 1024); } while (0)
#define PG8_MMA(ai, bj, At, Bt) do { __builtin_amdgcn_s_setprio(1); _Pragma("unroll") for (int m = 0; m < 4; ++m) _Pragma("unroll") for (int n = 0; n < 2; ++n) _Pragma("unroll") for (int k = 0; k < 2; ++k) \
        acc[ai][bj][m][n] = __builtin_amdgcn_mfma_f32_16x16x32_bf16(Bt[n][k], At[m][k], acc[ai][bj][m][n], 0, 0, 0); __builtin_amdgcn_s_setprio(0); } while (0)
#define PG8_WAIT_V(n) asm volatile("s_waitcnt vmcnt(" #n ")" ::: "memory")
#define PG8_WAIT_L(n) asm volatile("s_waitcnt lgkmcnt(" #n ")" ::: "memory")
#define PG8_BAR __builtin_amdgcn_s_barrier()
#define PG8_SCHED __builtin_amdgcn_sched_barrier(0)
    Unit cur, nxt; int ui = 0;
    if (!S.next(0, cur)) return;
    f32x4 acc[2][2][4][2];
#pragma unroll
    for (int a = 0; a < 2; ++a)
#pragma unroll
        for (int b = 0; b < 2; ++b)
#pragma unroll
            for (int m = 0; m < 4; ++m)
#pragma unroll
                for (int n = 0; n < 2; ++n) acc[a][b][m][n] = (f32x4){0.f, 0.f, 0.f, 0.f};
    bf16x8 At[4][2], B0[2][2], B1[2][2];
    const char* cA = (const char*)g.A + (size_t)cur.pm * tstep; const char* cB = (const char*)g.Bt + (size_t)cur.pn * tstep;
    S.a_ready(cur);
    PG8_STAGE(PG8_SB(0, 0), cB, voffB); PG8_STAGE(PG8_SA(0, 0), cA, voffA); PG8_STAGE(PG8_SB(0, 1), cB + hstep, voffB); PG8_STAGE(PG8_SA(0, 1), cA + hstep, voffA);
    if (wr == 1) PG8_BAR;
    PG8_WAIT_V(4); PG8_BAR;
    PG8_STAGE(PG8_SB(1, 0), cB + kstep, voffB); PG8_STAGE(PG8_SA(1, 0), cA + kstep, voffA); PG8_STAGE(PG8_SB(1, 1), cB + hstep + kstep, voffB);
    PG8_WAIT_V(6); PG8_BAR;
    PG8_STAMP();
    for (;;) {
        const bool has_next = S.next(ui + 1, nxt);
        const char* nA = has_next ? (const char*)g.A + (size_t)nxt.pm * tstep : cA; const char* nB = has_next ? (const char*)g.Bt + (size_t)nxt.pn * tstep : cB;
        for (int t = 0; t < nt; t += 2) {
            const bool last = (t == nt - 2);
            const char* a1 = cA + (size_t)(t + 1) * kstep;
            const char* a2 = last ? nA : cA + (size_t)(t + 2) * kstep; const char* b2 = last ? nB : cB + (size_t)(t + 2) * kstep;
            const char* a3 = a2 + kstep; const char* b3 = b2 + kstep;
            if (last && has_next) S.a_ready(nxt);
            PG8_LDB(B0, 0, 0); PG8_SCHED; PG8_LDA(At, 0, 0); PG8_STAGE(PG8_SA(1, 1), a1 + hstep, voffA);
            PG8_WAIT_L(8); PG8_BAR; PG8_WAIT_L(0); PG8_MMA(0, 0, At, B0); PG8_BAR; PG8_SCHED;
            PG8_LDB(B1, 0, 1); PG8_STAGE(PG8_SB(0, 0), b2, voffB);
            PG8_BAR; PG8_WAIT_L(0); PG8_MMA(0, 1, At, B1); PG8_BAR;
            PG8_LDA(At, 0, 1); PG8_STAGE(PG8_SA(0, 0), a2, voffA);
            PG8_BAR; PG8_WAIT_L(0); PG8_MMA(1, 0, At, B0); PG8_BAR; PG8_SCHED;
            PG8_STAGE(PG8_SB(0, 1), b2 + hstep, voffB);
            PG8_WAIT_V(6); PG8_BAR; PG8_MMA(1, 1, At, B1); PG8_BAR;
            PG8_LDB(B0, 1, 0); PG8_SCHED; PG8_LDA(At, 1, 0); PG8_STAGE(PG8_SA(0, 1), a2 + hstep, voffA);
            PG8_WAIT_L(8); PG8_BAR; PG8_WAIT_L(0); PG8_MMA(0, 0, At, B0); PG8_BAR; PG8_SCHED;
            PG8_LDB(B1, 1, 1); PG8_STAGE(PG8_SB(1, 0), b3, voffB);
            PG8_BAR; PG8_WAIT_L(0); PG8_MMA(0, 1, At, B1); PG8_BAR;
            PG8_LDA(At, 1, 1); PG8_STAGE(PG8_SA(1, 0), a3, voffA);
            PG8_BAR; PG8_WAIT_L(0); PG8_MMA(1, 0, At, B0); PG8_BAR; PG8_SCHED;
            PG8_STAGE(PG8_SB(1, 1), b3 + hstep, voffB);
            PG8_WAIT_V(6); PG8_BAR; PG8_MMA(1, 1, At, B1); PG8_BAR;
        }
        PG8_STAMP();
        if constexpr (!Epi::AFTER_DRAIN) { E(acc, cur, wr, wc, fr, fq); S.done(cur); }
        PG8_STAMP();
        if (!has_next) break;
#pragma unroll
        for (int a = 0; a < 2; ++a)
#pragma unroll
            for (int b = 0; b < 2; ++b)
#pragma unroll
                for (int m = 0; m < 4; ++m)
#pragma unroll
                    for (int n = 0; n < 2; ++n) acc[a][b][m][n] = (f32x4){0.f, 0.f, 0.f, 0.f};
        cur = nxt; cA = nA; cB = nB; ++ui;
    }
    PG8_WAIT_V(0);
    if (wr == 0) PG8_BAR;
    PG8_BAR;
    if constexpr (Epi::AFTER_DRAIN) { E.fused(acc, cur, wr, wc, fr, fq, lds, wid, lane); S.done(cur); }
    PG8_STAMP();
    if (STAMP && wid == 0) { stamps[lane] = lane < nts ? (((unsigned long long)(unsigned)ts_hi << 32) | (unsigned)ts_lo) : 0ull;
        if (lane == 62) stamps[62] = rt_entry; if (lane == 63) stamps[63] = (unsigned long long)wall_clock64(); }
#undef PG8_STAMP
#undef PG8_SA
#undef PG8_SB
#undef PG8_STAGE
#undef PG8_LDA
#undef PG8_LDB
#undef PG8_MMA
#undef PG8_WAIT_V
#undef PG8_WAIT_L
#undef PG8_BAR
#undef PG8_SCHED
}
}
using pg8::bf16_t; using pg8::bf16x8; using pg8::f32x4; using pg8::u32x4; using pg8::cvt_pk_bf16;
typedef unsigned u32x2 __attribute__((ext_vector_type(2)));
#define LAS __attribute__((address_space(3)))
#define MFMA16(a, b, c) __builtin_amdgcn_mfma_f32_16x16x32_bf16((a), (b), (c), 0, 0, 0)

constexpr int NTOK = 9216, NPR = 8192, NPROJ = 6656, NPROJ_GEMM = 6912, DMODEL = 2048, DFF = 5632;
constexpr float EPS = 1e-6f;
constexpr int PC_ZG = 3072, PC_ZS = 4096, PC_XBC = 5120;
constexpr size_t O_Y = 0;
constexpr size_t O_GCP = (size_t)NTOK * 2048;
constexpr size_t O_GSP = O_GCP + 4 * 3 * 3072;
constexpr size_t O_SCP = O_GSP + (size_t)4 * 8 * 128 * 128;
constexpr size_t O_SSP = O_SCP + 4 * 3 * 1536;
constexpr size_t O_GCS = O_SSP + (size_t)4 * 16 * 64 * 128;
constexpr size_t O_GSS = O_GCS + (size_t)128 * 3 * 3072;
constexpr size_t O_SCS = O_GSS + (size_t)128 * 8 * 128 * 128;
constexpr size_t O_SSS = O_SCS + (size_t)128 * 3 * 1536;
constexpr size_t OB_HB = O_GSS * 4;
constexpr size_t OB_WINT = OB_HB + (size_t)NTOK * 2048 * 2;
static_assert(OB_WINT + (size_t)NPROJ_GEMM * 2048 * 2 <= O_SCS * 4, "scratch overflows gdn_state_s");
constexpr size_t OB_GIA = O_SSS * 4;
constexpr size_t GIA_ITEM = 16384 + 16384 + 8192 + 16384;
constexpr size_t OB_UT0 = OB_GIA + 1024 * GIA_ITEM;
static_assert(OB_UT0 + (size_t)512 * 16384 <= O_SSS * 4 + (size_t)128 * 16 * 64 * 128 * 4, "scratch overflows ssm_state_s");
constexpr size_t OFF_WOUT = 0;
constexpr size_t OFF_WGU = OFF_WOUT + (size_t)2048 * 2048 * 2;
constexpr size_t OFF_WDN = OFF_WGU + (size_t)11264 * 2048 * 2;
constexpr size_t OFF_PROJ = OFF_WDN + (size_t)2048 * 5632 * 2;
constexpr size_t OFF_MIX = OFF_PROJ + (size_t)NTOK * NPROJ * 2;
constexpr size_t OFF_X1B = OFF_MIX + (size_t)NTOK * 2048 * 2;
constexpr size_t OFF_FF = OFF_X1B + (size_t)NTOK * 2048 * 2;
constexpr size_t OFF_UT = OFF_FF + (size_t)NTOK * DFF * 2;
constexpr size_t OFF_YZ = OFF_UT + (size_t)512 * 16384;
constexpr size_t OFF_GATES = OFF_YZ + (size_t)64 * 32 * 16384;
constexpr size_t OFF_DT = OFF_GATES + (size_t)NTOK * 32 * 4;
constexpr size_t OFF_ACUM = OFF_DT + (size_t)NPR * 16 * 4;
constexpr size_t OFF_GL = OFF_ACUM + (size_t)NPR * 16 * 4;
constexpr size_t OFF_SS1 = OFF_GL + 1024 * 128;
constexpr size_t OFF_SS2 = OFF_SS1 + (size_t)NTOK * 32 * 4;
constexpr size_t OFF_CTR = OFF_SS2 + (size_t)NTOK * 32 * 4;
constexpr size_t WS_END = OFF_CTR + 256;
constexpr size_t OFF_X2B = OFF_MIX;

__device__ __forceinline__ size_t ut_off_ws(int item) { return OFF_UT + (size_t)(item - 512) * 16384; }
struct Params { const float* in[24]; float* out; unsigned char* ws; };
typedef const __attribute__((address_space(4))) Params CP;
__device__ __forceinline__ CP* get_params() { const __attribute__((address_space(4))) void* kp = (const __attribute__((address_space(4))) void*)__builtin_amdgcn_kernarg_segment_ptr(); asm volatile("" : "+s"(kp)); return (CP*)kp; }
enum { I_XP = 0, I_XS, I_SGC, I_SG, I_SSC, I_SS, I_ANW, I_WIN, I_GCW, I_GAL, I_GDB, I_GNW, I_SCW, I_SCB, I_SAL, I_SDB, I_SD, I_SNW, I_WOUT, I_FNW, I_WG, I_WU, I_WD, I_FINW };

__device__ __forceinline__ float bflo(unsigned w) { return __uint_as_float(w << 16); }
__device__ __forceinline__ float bfhi(unsigned w) { return __uint_as_float(w & 0xffff0000u); }
__device__ __forceinline__ float bf2f(bf16_t b) { return __uint_as_float(((unsigned)b) << 16); }
__device__ __forceinline__ bf16_t f2bf(float f) { return (bf16_t)(cvt_pk_bf16(f, 0.f) & 0xffffu); }
__device__ __forceinline__ void unpack8(const u32x4 v, float (&f)[8]) { f[0] = bflo(v.x); f[1] = bfhi(v.x); f[2] = bflo(v.y); f[3] = bfhi(v.y); f[4] = bflo(v.z); f[5] = bfhi(v.z); f[6] = bflo(v.w); f[7] = bfhi(v.w); }
__device__ __forceinline__ u32x4 pack8(const float (&f)[8]) { u32x4 o; o.x = cvt_pk_bf16(f[0], f[1]); o.y = cvt_pk_bf16(f[2], f[3]); o.z = cvt_pk_bf16(f[4], f[5]); o.w = cvt_pk_bf16(f[6], f[7]); return o; }
__device__ __forceinline__ u32x2 pack4(const f32x4 v) { u32x2 o; o.x = cvt_pk_bf16(v[0], v[1]); o.y = cvt_pk_bf16(v[2], v[3]); return o; }
__device__ __forceinline__ float siluf(float x) { return x / (1.f + __expf(-x)); }
__device__ __forceinline__ float sigmf(float x) { return 1.f / (1.f + __expf(-x)); }
__device__ __forceinline__ float softplusf(float x) { return fmaxf(x, 0.f) + log1pf(__expf(-fabsf(x))); }
__device__ __forceinline__ float wave_sum(float v) {
    v = sum16_dpp(v); v += __shfl_xor(v, 16); v += __shfl_xor(v, 32);
    return v;
}
__device__ __forceinline__ float wave_scan_incl(float v, int lane) {
#pragma unroll
    for (int o = 1; o < 64; o <<= 1) { const float t = __shfl_up(v, o); if (lane >= o) v += t; }
    return v;
}
__device__ __forceinline__ void ld8f(const float* p, float (&f)[8]) { const f32x4 a = *(const f32x4*)p, b = *(const f32x4*)(p + 4); f[0] = a[0]; f[1] = a[1]; f[2] = a[2]; f[3] = a[3]; f[4] = b[0]; f[5] = b[1]; f[6] = b[2]; f[7] = b[3]; }
__device__ __forceinline__ void ld8b(const bf16_t* p, float (&f)[8]) { const u32x4 v = *(const u32x4*)p; unpack8(v, f); }

__device__ __forceinline__ int win_src_col(int n) { if (n < 4096) return n; if (n < 6656) return n + 16; if (n < 6672) return n - 2560; if (n < 6688) return n; return -1; }

struct PrepTile { const float* src; bf16_t* dst; const float* ksc; int Nsrc, K, k0, n0, sc; };
__device__ __forceinline__ PrepTile prep_decode(CP& p, int it, int tid) {
    constexpr int T0 = 16 * 54, T1 = 16 * 16, T2 = 16 * 88;
    PrepTile d; d.ksc = nullptr; int r = it, kt, nt;
    if (r < T0) { kt = r / 54; nt = r % 54; d.src = p.in[I_WIN]; d.Nsrc = 6688; d.K = 2048; d.dst = (bf16_t*)((unsigned char*)p.out + OB_WINT); d.sc = win_src_col(nt * 128 + (tid & 31) * 4); }
    else if ((r -= T0) < T1) { kt = r / 16; nt = r % 16; d.src = p.in[I_WOUT]; d.Nsrc = 2048; d.K = 2048; d.dst = (bf16_t*)(p.ws + OFF_WOUT); d.sc = nt * 128 + (tid & 31) * 4; }
    else if ((r -= T1) < T2) { kt = r / 88; nt = r % 88; const int np = nt * 128 + (tid & 31) * 4, j = np >> 8, rr = np & 255; d.src = (rr < 128) ? p.in[I_WG] : p.in[I_WU]; d.Nsrc = DFF; d.K = 2048;
        d.dst = (bf16_t*)(p.ws + OFF_WGU); d.sc = 128 * j + (rr & 127); d.ksc = p.in[I_FNW]; }
    else { r -= T2; kt = r / 16; nt = r % 16; d.src = p.in[I_WD]; d.Nsrc = 2048; d.K = DFF; d.dst = (bf16_t*)(p.ws + OFF_WDN); d.sc = nt * 128 + (tid & 31) * 4; }
    d.k0 = kt * 128; d.n0 = nt * 128; return d;
}
__device__ __forceinline__ void prep_load(const PrepTile& d, int tid, f32x4 (&v)[8]) {
    const int kr = tid >> 5;
#pragma unroll
    for (int i = 0; i < 8; ++i) { const int k = d.k0 + kr + 16 * i; f32x4 x = (f32x4){0.f, 0.f, 0.f, 0.f};
        if (d.sc >= 0) x = *(const f32x4*)(d.src + (size_t)k * d.Nsrc + d.sc);
        if (d.ksc) x = x * d.ksc[k];
        v[i] = x; }
}

__device__ __forceinline__ void phase_prep(CP& p, LAS unsigned char* lds) {
    const int tid = opaque_tid(), wv = tid >> 6, lane = tid & 63;
    { bf16_t* hb = (bf16_t*)((unsigned char*)p.out + OB_HB); const f32x4* wn = (const f32x4*)p.in[I_ANW];
      for (int row = blockIdx.x * 8 + wv; row < NTOK; row += gridDim.x * 8) {
          const float* xr = row < NPR ? p.in[I_XP] + (size_t)row * 2048 : p.in[I_XS] + (size_t)(row - NPR) * 2048;
          f32x4 v[8]; float s = 0.f;
#pragma unroll
          for (int j = 0; j < 8; ++j) { v[j] = ((const f32x4*)xr)[lane + 64 * j]; s += (v[j][0] * v[j][0] + v[j][1] * v[j][1]) + (v[j][2] * v[j][2] + v[j][3] * v[j][3]); }
          const float rinv = rsqrtf(wave_sum(s) * (1.f / 2048.f) + EPS);
          u32x2* o = (u32x2*)(hb + (size_t)row * 2048);
#pragma unroll
          for (int j = 0; j < 8; ++j) { const f32x4 w = wn[lane + 64 * j]; f32x4 y = v[j] * rinv * w; o[lane + 64 * j] = pack4(y); }
      } }
    { LAS float* tile = (LAS float*)lds;
      constexpr int NT = 16 * 54 + 16 * 16 + 16 * 88 + 44 * 16;
      int it = blockIdx.x; f32x4 v[8]; PrepTile d;
      if (it < NT) { d = prep_decode(p, it, tid); prep_load(d, tid, v); }
      while (it < NT) {
          { const int kr = tid >> 5, nl = (tid & 31) * 4;
#pragma unroll
            for (int i = 0; i < 8; ++i) { LAS float* tp = tile + (kr + 16 * i) * 129 + nl; tp[0] = v[i][0]; tp[1] = v[i][1]; tp[2] = v[i][2]; tp[3] = v[i][3]; } }
          __syncthreads();
          const PrepTile cur = d; const int nx = it + gridDim.x;
          if (nx < NT) { d = prep_decode(p, nx, tid); prep_load(d, tid, v); }
#pragma unroll
          for (int j = 0; j < 4; ++j) { const int id = tid + 512 * j, n = id >> 4, c = id & 15; float f[8];
#pragma unroll
              for (int e = 0; e < 8; ++e) f[e] = tile[(8 * c + e) * 129 + n];
              *(u32x4*)(cur.dst + (size_t)(cur.n0 + n) * cur.K + cur.k0 + 8 * c) = pack8(f); }
          __syncthreads();
          it = nx;
      } }
}

struct EpiProj {
    static constexpr bool PERM = true, AFTER_DRAIN = false;
    bf16_t* O; float* gates;
    __device__ __forceinline__ void operator()(const f32x4 (&acc)[2][2][4][2], const pg8::Unit& u, int wr, int wc, int fr, int fq) const {
        const int row0 = u.pm * 256 + wr * 64 + fr, col0 = u.pn * 256 + wc * 32 + 8 * fq;
#pragma unroll
        for (int ai = 0; ai < 2; ++ai)
#pragma unroll
            for (int m = 0; m < 4; ++m) { const int row = row0 + ai * 128 + m * 16; bf16_t* rp = O + (size_t)row * NPROJ + col0;
                if (u.pn < 26) {
#pragma unroll
                for (int bj = 0; bj < 2; ++bj) { u32x4 w; const f32x4 v0 = acc[ai][bj][m][0], v1 = acc[ai][bj][m][1];
                    w.x = cvt_pk_bf16(v0[0], v0[1]); w.y = cvt_pk_bf16(v0[2], v0[3]); w.z = cvt_pk_bf16(v1[0], v1[1]); w.w = cvt_pk_bf16(v1[2], v1[3]);
                    *(u32x4*)(rp + bj * 128) = w; } }
                else if (wc == 0) { float* gp = gates + (size_t)row * 32 + 8 * fq; *(f32x4*)gp = acc[ai][0][m][0]; *(f32x4*)(gp + 4) = acc[ai][0][m][1]; } }
    }
};
struct EpiOut {
    static constexpr bool PERM = false, AFTER_DRAIN = false;
    const float* xp; const float* xs; float* out; bf16_t* x1b; float* ss;
    __device__ __forceinline__ void operator()(const f32x4 (&acc)[2][2][4][2], const pg8::Unit& u, int wr, int wc, int fr, int fq) const {
        const int row0 = u.pm * 256 + wr * 64 + fr, col0 = u.pn * 256 + wc * 32 + 4 * fq;
#pragma unroll
        for (int ai = 0; ai < 2; ++ai)
#pragma unroll
            for (int m = 0; m < 4; ++m) { const int row = row0 + ai * 128 + m * 16;
                const float* bp = (row < NPR ? xp + (size_t)row * 2048 : xs + (size_t)(row - NPR) * 2048) + col0;
                bf16_t* hp = x1b + (size_t)row * 2048 + col0; float s = 0.f;
#pragma unroll
                for (int bj = 0; bj < 2; ++bj)
#pragma unroll
                    for (int n = 0; n < 2; ++n) { const f32x4 x1 = *(const f32x4*)(bp + bj * 128 + n * 16) + acc[ai][bj][m][n];
                        *(u32x2*)(hp + bj * 128 + n * 16) = pack4(x1);
                        s += (x1[0] * x1[0] + x1[1] * x1[1]) + (x1[2] * x1[2] + x1[3] * x1[3]); }
                s += __shfl_xor(s, 16); s += __shfl_xor(s, 32);
                if (fq == 0) ss[((size_t)u.pn * NTOK + row) * 4 + wc] = s; }
    }
};
struct EpiGU {
    static constexpr bool PERM = true, AFTER_DRAIN = false;
    bf16_t* ff; const float* ss;
    __device__ __forceinline__ void operator()(const f32x4 (&acc)[2][2][4][2], const pg8::Unit& u, int wr, int wc, int fr, int fq) const {
        const int row0 = u.pm * 256 + wr * 64 + fr, col0 = u.pn * 128 + wc * 32 + 8 * fq;
#pragma unroll
        for (int ai = 0; ai < 2; ++ai)
#pragma unroll
            for (int m = 0; m < 4; ++m) { const int row = row0 + ai * 128 + m * 16;
                const f32x4 pa = *(const f32x4*)(ss + ((size_t)(2 * fq) * NTOK + row) * 4), pb = *(const f32x4*)(ss + ((size_t)(2 * fq + 1) * NTOK + row) * 4);
                float sq = ((pa[0] + pa[1]) + (pa[2] + pa[3])) + ((pb[0] + pb[1]) + (pb[2] + pb[3])); sq += __shfl_xor(sq, 16); sq += __shfl_xor(sq, 32);
                const float rinv = rsqrtf(sq * (1.f / 2048.f) + EPS); float f[8];
#pragma unroll
                for (int n = 0; n < 2; ++n)
#pragma unroll
                    for (int j = 0; j < 4; ++j) { const float g = acc[ai][0][m][n][j] * rinv, up = acc[ai][1][m][n][j] * rinv; f[4 * n + j] = siluf(g) * up; }
                *(u32x4*)(ff + (size_t)row * DFF + col0) = pack8(f); }
    }
};
struct EpiDown {
    static constexpr bool PERM = false, AFTER_DRAIN = false;
    bf16_t* out; float* ss; const bf16_t* x1b;
    __device__ __forceinline__ void operator()(const f32x4 (&acc)[2][2][4][2], const pg8::Unit& u, int wr, int wc, int fr, int fq) const {
        const int row0 = u.pm * 256 + wr * 64 + fr, col0 = u.pn * 256 + wc * 32 + 4 * fq;
#pragma unroll
        for (int ai = 0; ai < 2; ++ai)
#pragma unroll
            for (int m = 0; m < 4; ++m) { const int row = row0 + ai * 128 + m * 16; bf16_t* op = out + (size_t)row * 2048 + col0; const bf16_t* hp = x1b + (size_t)row * 2048 + col0; float s = 0.f;
#pragma unroll
                for (int bj = 0; bj < 2; ++bj)
#pragma unroll
                    for (int n = 0; n < 2; ++n) { const u32x2 hw = *(const u32x2*)(hp + bj * 128 + n * 16); const f32x4 x2 = (f32x4){bflo(hw.x), bfhi(hw.x), bflo(hw.y), bfhi(hw.y)} + acc[ai][bj][m][n];
                        *(u32x2*)(op + bj * 128 + n * 16) = pack4(x2); s += (x2[0] * x2[0] + x2[1] * x2[1]) + (x2[2] * x2[2] + x2[3] * x2[3]); }
                s += __shfl_xor(s, 16); s += __shfl_xor(s, 32);
                if (fq == 0) ss[((size_t)u.pn * NTOK + row) * 4 + wc] = s; }
    }
};
__device__ __forceinline__ void conv8x8_prompt(const bf16_t* pc, int t0, const float* w, int ws, const float* bias, float (&out)[8][8]) {
    float w0[8], w1[8], w2[8], w3[8], bv[8], r0[8], r1[8], r2[8];
    ld8f(w, w0); ld8f(w + ws, w1); ld8f(w + 2 * ws, w2); ld8f(w + 3 * ws, w3);
    if (bias) ld8f(bias, bv); else {
#pragma unroll
        for (int c = 0; c < 8; ++c) bv[c] = 0.f; }
    if (t0 >= 3) { ld8b(pc + (size_t)(t0 - 3) * NPROJ, r0); ld8b(pc + (size_t)(t0 - 2) * NPROJ, r1); ld8b(pc + (size_t)(t0 - 1) * NPROJ, r2); }
    else {
#pragma unroll
        for (int c = 0; c < 8; ++c) { r0[c] = 0.f; r1[c] = 0.f; r2[c] = 0.f; } }
#pragma unroll
    for (int tt = 0; tt < 8; ++tt) { float cur[8]; ld8b(pc + (size_t)(t0 + tt) * NPROJ, cur);
#pragma unroll
        for (int c = 0; c < 8; ++c) { out[tt][c] = siluf(bv[c] + w0[c] * r0[c] + w1[c] * r1[c] + w2[c] * r2[c] + w3[c] * cur[c]); r0[c] = r1[c]; r1[c] = r2[c]; r2[c] = cur[c]; } }
}
__device__ __forceinline__ void conv1x8_sample(const bf16_t* pc, const float* st, int C, int t, const float* w, const float* bias, float (&o)[8], bool hist_ok = false) {
    float acc[8];
    if (bias) ld8f(bias, acc); else {
#pragma unroll
        for (int c = 0; c < 8; ++c) acc[c] = 0.f; }
#pragma unroll
    for (int i = 0; i < 4; ++i) { const int rr = t - 3 + i; float x[8], wi[8]; ld8f(w + i * C, wi);
        if (rr >= 0 || st == nullptr) { if (rr >= 0 || hist_ok) ld8b(pc + (long)rr * NPROJ, x); else {
#pragma unroll
                for (int c = 0; c < 8; ++c) x[c] = 0.f; } } else ld8f(st + (rr + 3) * C, x);
#pragma unroll
        for (int c = 0; c < 8; ++c) acc[c] += wi[c] * x[c]; }
#pragma unroll
    for (int c = 0; c < 8; ++c) o[c] = siluf(acc[c]);
}

__device__ __forceinline__ void gdn_chunk_item(CP& p, LAS unsigned char* lds, int item) {
    { unsigned lb_ = (unsigned)(size_t)lds; asm volatile("" : "+v"(lb_)); lds = (LAS unsigned char*)(size_t)lb_; }
    const int tid = opaque_tid(), wv = tid >> 6, lane = tid & 63, r = lane & 15, q = lane >> 4;
    const int n = item & 31, bh = item >> 5, h = bh & 7, b = bh >> 3, seqrow0 = b * 2048, t0c = n * 64;
    LAS bf16_t* qb = (LAS bf16_t*)lds; LAS bf16_t* kb = (LAS bf16_t*)(lds + 17408);
    LAS float* vs = (LAS float*)(lds + 34816); LAS float* Am = (LAS float*)(lds + 68608);
    LAS float* Gs = (LAS float*)(lds + 86016); LAS float* bs = Gs + 64;
    const bf16_t* proj = (const bf16_t*)(p.ws + OFF_PROJ); const float* gates = (const float*)(p.ws + OFF_GATES);
    unsigned char* gi = (unsigned char*)p.out + OB_GIA + (size_t)item * GIA_ITEM;
    bf16_t* Wg = (bf16_t*)gi; bf16_t* QDg = (bf16_t*)(gi + 16384); bf16_t* QKg = (bf16_t*)(gi + 32768); bf16_t* KDTg = (bf16_t*)(gi + 40960);
    bf16_t* UTg = item < 512 ? (bf16_t*)((unsigned char*)p.out + OB_UT0 + (size_t)item * 16384) : (bf16_t*)(p.ws + ut_off_ws(item));
    if (tid < 384) {
        const int part = tid >> 7, seg = (tid >> 4) & 7, cgi = tid & 15, ch = part * 1024 + h * 128 + cgi * 8;
        float o[8][8];
        conv8x8_prompt(proj + (size_t)seqrow0 * NPROJ + ch, t0c + seg * 8, p.in[I_GCW] + ch, 3072, nullptr, o);
        if (part < 2) {
            LAS bf16_t* dstb = part == 0 ? qb : kb; const float extra = part == 0 ? 0.08838834764831845f : 1.f;
#pragma unroll
            for (int tt = 0; tt < 8; ++tt) { float ss = 0.f;
#pragma unroll
                for (int c = 0; c < 8; ++c) ss += o[tt][c] * o[tt][c];
                ss = sum16_dpp(ss);
                const float sc = rsqrtf(ss + EPS) * extra; float f[8];
#pragma unroll
                for (int c = 0; c < 8; ++c) f[c] = o[tt][c] * sc;
                *(LAS u32x4*)(dstb + (seg * 8 + tt) * 136 + cgi * 8) = pack8(f); }
        } else {
#pragma unroll
            for (int tt = 0; tt < 8; ++tt) { LAS float* vp = vs + (seg * 8 + tt) * 132 + cgi * 8;
                *(LAS f32x4*)vp = (f32x4){o[tt][0], o[tt][1], o[tt][2], o[tt][3]}; *(LAS f32x4*)(vp + 4) = (f32x4){o[tt][4], o[tt][5], o[tt][6], o[tt][7]}; }
        }
    } else if (wv == 6) {
        const int row = seqrow0 + t0c + lane;
        const float a_raw = gates[(size_t)row * 32 + 8 + h], b_raw = gates[(size_t)row * 32 + h];
        const float g = -__expf(p.in[I_GAL][h]) * softplusf(a_raw + p.in[I_GDB][h]);
        Gs[lane] = wave_scan_incl(g, lane); bs[lane] = sigmf(b_raw);
    }
    __syncthreads();
    {
        const int it = wv & 3, jh = wv >> 2;
        bf16x8 ki[4], qi[4];
#pragma unroll
        for (int k = 0; k < 4; ++k) { ki[k] = *(LAS bf16x8*)(kb + (16 * it + r) * 136 + 32 * k + 8 * q); qi[k] = *(LAS bf16x8*)(qb + (16 * it + r) * 136 + 32 * k + 8 * q); }
#pragma unroll
        for (int jj = 0; jj < 2; ++jj) { const int jt = 2 * jh + jj;
            f32x4 dkk = (f32x4){0.f, 0.f, 0.f, 0.f}, dT = (f32x4){0.f, 0.f, 0.f, 0.f};
#pragma unroll
            for (int k = 0; k < 4; ++k) { const bf16x8 kj = *(LAS bf16x8*)(kb + (16 * jt + r) * 136 + 32 * k + 8 * q); dkk = MFMA16(ki[k], kj, dkk); dT = MFMA16(kj, qi[k], dT); }
            const int jc = 16 * jt + r; const float Gj = Gs[jc];
#pragma unroll
            for (int e = 0; e < 4; ++e) { const int i = 16 * it + 4 * q + e; const float v = bs[i] * dkk[e] * __expf(fminf(Gs[i] - Gj, 0.f)); Am[i * 68 + jc] = (jc < i) ? v : 0.f; }
            const int ic = 16 * it + r; const float Gi = Gs[ic]; f32x4 tv;
#pragma unroll
            for (int e = 0; e < 4; ++e) { const int j = 16 * jt + 4 * q + e; const float v = dT[e] * __expf(fminf(Gi - Gs[j], 0.f)); tv[e] = (j <= ic) ? v : 0.f; }
            *(u32x2*)(QKg + ic * 64 + 16 * jt + 4 * q) = pack4(tv); }
    }
    __syncthreads();
    if (tid < 256) {
        const int c = tid; float x[64];
        if (c < 128) {
#pragma unroll
            for (int i = 0; i < 64; ++i) x[i] = bs[i] * vs[i * 132 + c];
        } else {
#pragma unroll
            for (int i = 0; i < 64; ++i) x[i] = bs[i] * __expf(Gs[i]) * bf2f(kb[i * 136 + (c - 128)]);
        }
#pragma unroll
        for (int i = 1; i < 64; ++i) { float a = x[i];
#pragma unroll
            for (int j4 = 0; j4 <= (i - 1) / 4; ++j4) { const f32x4 am = *(LAS f32x4*)(Am + i * 68 + 4 * j4);
                a -= am[0] * x[4 * j4]; a -= am[1] * x[4 * j4 + 1]; a -= am[2] * x[4 * j4 + 2]; a -= am[3] * x[4 * j4 + 3]; }
            x[i] = a; }
        if (c < 128) {
#pragma unroll
            for (int k = 0; k < 8; ++k) { float f[8];
#pragma unroll
                for (int e = 0; e < 8; ++e) f[e] = x[8 * k + e];
                *(u32x4*)(UTg + c * 64 + 8 * k) = pack8(f); }
        } else {
#pragma unroll
            for (int i = 0; i < 64; ++i) Wg[i * 128 + (c - 128)] = f2bf(x[i]);
        }
    } else {
        const int t = tid - 256;
        { const int i = t >> 2, ds = (t & 3) * 32; const float eg = __expf(Gs[i]);
#pragma unroll
          for (int v = 0; v < 4; ++v) { float f[8]; unpack8(*(LAS u32x4*)(qb + i * 136 + ds + 8 * v), f);
#pragma unroll
              for (int e = 0; e < 8; ++e) f[e] *= eg;
              *(u32x4*)(QDg + i * 128 + ds + 8 * v) = pack8(f); } }
        { const int d = t & 127, jh = t >> 7; const float Gl = Gs[63];
#pragma unroll
          for (int v = 0; v < 4; ++v) { float f[8];
#pragma unroll
              for (int e = 0; e < 8; ++e) { const int j = jh * 32 + 8 * v + e; f[e] = bf2f(kb[j * 136 + d]) * __expf(Gl - Gs[j]); }
              *(u32x4*)(KDTg + d * 64 + jh * 32 + 8 * v) = pack8(f); } }
        if (t == 0) ((float*)(p.ws + OFF_GL))[item * 32] = __expf(Gs[63]);
    }
    __syncthreads();
}

__device__ __forceinline__ void phase2(CP& p, LAS unsigned char* lds) {
    const int tid = opaque_tid(), wv = tid >> 6, lane = tid & 63;
    for (int item = blockIdx.x; item < 1024; item += gridDim.x) gdn_chunk_item(p, lds, item);
    const float* gates = (const float*)(p.ws + OFF_GATES);
    { float* DT = (float*)(p.ws + OFF_DT); float* AC = (float*)(p.ws + OFF_ACUM);
      for (int job = blockIdx.x * 8 + wv; job < 2048; job += gridDim.x * 8) { const int head = job & 15, row = (job >> 4) * 64 + lane;
          const float dt = softplusf(gates[(size_t)row * 32 + 16 + head] + p.in[I_SDB][head]);
          const float a = -__expf(p.in[I_SAL][head]) * dt;
          DT[head * NPR + row] = dt; AC[head * NPR + row] = wave_scan_incl(a, lane); } }
    { const bf16_t* proj = (const bf16_t*)(p.ws + OFF_PROJ);
      for (int idx = blockIdx.x * 512 + tid; idx < 132 * 3 * 576; idx += gridDim.x * 512) {
          const int cg8 = idx % 576, i = (idx / 576) % 3, bb = idx / (576 * 3);
          const int row = bb < 4 ? bb * 2048 + 2045 + i : NPR + (bb - 4) * 8 + 5 + i;
          float f[8]; float* o;
          if (cg8 < 384) { ld8b(proj + (size_t)row * NPROJ + cg8 * 8, f); o = p.out + (bb < 4 ? O_GCP + (size_t)(bb * 3 + i) * 3072 : O_GCS + (size_t)((bb - 4) * 3 + i) * 3072) + cg8 * 8; }
          else { const int c = (cg8 - 384) * 8; ld8b(proj + (size_t)row * NPROJ + PC_XBC + c, f); o = p.out + (bb < 4 ? O_SCP + (size_t)(bb * 3 + i) * 1536 : O_SCS + (size_t)((bb - 4) * 3 + i) * 1536) + c; }
          *(f32x4*)o = (f32x4){f[0], f[1], f[2], f[3]}; *(f32x4*)(o + 4) = (f32x4){f[4], f[5], f[6], f[7]}; } }
}

struct GdnOps { bf16x8 wA[4], qA[4]; u32x2 uw[4]; bf16x8 qkA[2], kA[2][2]; float gl; };
__device__ __forceinline__ void gdn_load_ops(CP& p, int item, int ti, int eh, int r, int q, GdnOps& o) {
    const unsigned char* gi = (const unsigned char*)p.out + OB_GIA + (size_t)item * GIA_ITEM;
    const bf16_t* Wg = (const bf16_t*)gi; const bf16_t* QDg = (const bf16_t*)(gi + 16384); const bf16_t* UTg = item < 512 ? (const bf16_t*)((const unsigned char*)p.out + OB_UT0 + (size_t)item * 16384) : (const bf16_t*)(p.ws + ut_off_ws(item));
    const bf16_t* QKg = (const bf16_t*)(gi + 32768); const bf16_t* KDTg = (const bf16_t*)(gi + 40960);
#pragma unroll
    for (int k = 0; k < 4; ++k) { o.wA[k] = *(const bf16x8*)(Wg + (16 * ti + r) * 128 + 32 * k + 8 * q); o.qA[k] = *(const bf16x8*)(QDg + (16 * ti + r) * 128 + 32 * k + 8 * q); }
#pragma unroll
    for (int et = 0; et < 4; ++et) o.uw[et] = *(const u32x2*)(UTg + (16 * (4 * eh + et) + r) * 64 + 16 * ti + 4 * q);
#pragma unroll
    for (int k2 = 0; k2 < 2; ++k2) { o.qkA[k2] = *(const bf16x8*)(QKg + (16 * ti + r) * 64 + 32 * k2 + 8 * q);
#pragma unroll
        for (int dd = 0; dd < 2; ++dd) o.kA[dd][k2] = *(const bf16x8*)(KDTg + (16 * (2 * ti + dd) + r) * 64 + 32 * k2 + 8 * q); }
    o.gl = ((const float*)(p.ws + OFF_GL))[item * 32];
}
__device__ __forceinline__ void gdn_scan_item(CP& p, LAS unsigned char* lds, int bh) {
    { unsigned lb_ = (unsigned)(size_t)lds; asm volatile("" : "+v"(lb_)); lds = (LAS unsigned char*)(size_t)lb_; }
    const int tid = opaque_tid(), wv = tid >> 6, lane = tid & 63, r = lane & 15, q = lane >> 4;
    const int b = bh >> 3, h = bh & 7, ti = wv & 3, eh = wv >> 2;
    LAS bf16_t* St = (LAS bf16_t*)lds; LAS bf16_t* vnT = (LAS bf16_t*)(lds + 34816); LAS float* ssqp = (LAS float*)(lds + 34816 + 18432);
    const bf16_t* proj = (const bf16_t*)(p.ws + OFF_PROJ); bf16_t* mix = (bf16_t*)(p.ws + OFF_MIX);
    const float* gnw = p.in[I_GNW];
    f32x4 Sacc[2][4];
#pragma unroll
    for (int a = 0; a < 2; ++a)
#pragma unroll
        for (int e = 0; e < 4; ++e) Sacc[a][e] = (f32x4){0.f, 0.f, 0.f, 0.f};
    for (int i = tid; i < 34816 / 16; i += 512) ((LAS u32x4*)lds)[i] = (u32x4){0u, 0u, 0u, 0u};
    GdnOps cur; gdn_load_ops(p, bh * 32, ti, eh, r, q, cur);
    __syncthreads();
    for (int n = 0; n < 32; ++n) {
        GdnOps nxt; gdn_load_ops(p, bh * 32 + (n + 1 < 32 ? n + 1 : n), ti, eh, r, q, nxt);
        bf16_t zr[4][4];
#pragma unroll
        for (int j = 0; j < 4; ++j)
#pragma unroll
            for (int et = 0; et < 4; ++et) zr[j][et] = proj[((size_t)b * 2048 + n * 64 + 16 * ti + 4 * q + j) * NPROJ + PC_ZG + h * 128 + 16 * (4 * eh + et) + r];
        f32x4 accq[4];
#pragma unroll
        for (int et = 0; et < 4; ++et) { const int E = 4 * eh + et; f32x4 accw = (f32x4){0.f, 0.f, 0.f, 0.f}; accq[et] = (f32x4){0.f, 0.f, 0.f, 0.f};
#pragma unroll
            for (int k = 0; k < 4; ++k) { const bf16x8 sf = *(LAS bf16x8*)(St + (16 * E + r) * 136 + 32 * k + 8 * q); accw = MFMA16(cur.wA[k], sf, accw); accq[et] = MFMA16(cur.qA[k], sf, accq[et]); }
            const u32x2 uw = cur.uw[et]; const f32x4 u = (f32x4){bflo(uw.x), bfhi(uw.x), bflo(uw.y), bfhi(uw.y)};
            *(LAS u32x2*)(vnT + (16 * E + r) * 72 + 16 * ti + 4 * q) = pack4(u - accw); }
        LDS_BARRIER();
        const float gl = cur.gl;
#pragma unroll
        for (int et = 0; et < 4; ++et) { const int E = 4 * eh + et; bf16x8 bv[2];
#pragma unroll
            for (int k2 = 0; k2 < 2; ++k2) bv[k2] = *(LAS bf16x8*)(vnT + (16 * E + r) * 72 + 32 * k2 + 8 * q);
#pragma unroll
            for (int k2 = 0; k2 < 2; ++k2) accq[et] = MFMA16(cur.qkA[k2], bv[k2], accq[et]);
#pragma unroll
            for (int dd = 0; dd < 2; ++dd) { Sacc[dd][et] = Sacc[dd][et] * gl;
#pragma unroll
                for (int k2 = 0; k2 < 2; ++k2) Sacc[dd][et] = MFMA16(cur.kA[dd][k2], bv[k2], Sacc[dd][et]);
                *(LAS u32x2*)(St + (16 * E + r) * 136 + 16 * (2 * ti + dd) + 4 * q) = pack4(Sacc[dd][et]); } }
        float s4[4];
#pragma unroll
        for (int j = 0; j < 4; ++j) { float s = 0.f;
#pragma unroll
            for (int et = 0; et < 4; ++et) s += accq[et][j] * accq[et][j];
            s = sum16_dpp(s); s4[j] = s; }
        if (r == 0) {
#pragma unroll
            for (int j = 0; j < 4; ++j) ssqp[eh * 64 + 16 * ti + 4 * q + j] = s4[j]; }
        LDS_BARRIER();
#pragma unroll
        for (int j = 0; j < 4; ++j) { const int i = 16 * ti + 4 * q + j; const float rinv = rsqrtf((ssqp[i] + ssqp[64 + i]) * (1.f / 128.f) + EPS);
            const size_t row = (size_t)b * 2048 + n * 64 + i;
#pragma unroll
            for (int et = 0; et < 4; ++et) { const int e = 16 * (4 * eh + et) + r;
                mix[row * 2048 + h * 128 + e] = f2bf(accq[et][j] * rinv * gnw[e] * siluf(bf2f(zr[j][et]))); } }
        cur = nxt;
    }
    float* so = p.out + O_GSP + (size_t)bh * 128 * 128;
#pragma unroll
    for (int dd = 0; dd < 2; ++dd)
#pragma unroll
        for (int et = 0; et < 4; ++et)
#pragma unroll
            for (int j = 0; j < 4; ++j) so[(16 * (2 * ti + dd) + 4 * q + j) * 128 + 16 * (4 * eh + et) + r] = Sacc[dd][et][j];
    __syncthreads();
}

__device__ __forceinline__ void ssd_load_rows(const bf16_t* pc, int t0, const float* aux, const float* acl, u32x4 (&rr)[11], float (&dd)[8], float& al) {
#pragma unroll
    for (int i = 0; i < 11; ++i) { const int t = t0 - 3 + i; rr[i] = (t >= 0) ? *(const u32x4*)(pc + (size_t)t * NPROJ) : (u32x4){0u, 0u, 0u, 0u}; }
#pragma unroll
    for (int tt = 0; tt < 8; ++tt) dd[tt] = aux[tt];
    al = *acl;
}
__device__ __forceinline__ void ssd_scan_item(CP& p, LAS unsigned char* lds, int bhd) {
    { unsigned lb_ = (unsigned)(size_t)lds; asm volatile("" : "+v"(lb_)); lds = (LAS unsigned char*)(size_t)lb_; }
    const int tid = opaque_tid(), wv = tid >> 6, lane = tid & 63, r = lane & 15, q = lane >> 4;
    const int b = bhd >> 4, head = bhd & 15, g = head >> 3;
    LAS bf16_t* BdT = (LAS bf16_t*)(lds + 34816); LAS bf16_t* xdtT = (LAS bf16_t*)(lds + 53248); LAS bf16_t* hb = (LAS bf16_t*)(lds + 71680);
    const bf16_t* proj = (const bf16_t*)(p.ws + OFF_PROJ); const float* DT = (const float*)(p.ws + OFF_DT); const float* AC = (const float*)(p.ws + OFF_ACUM);
    f32x4 hacc[4];
#pragma unroll
    for (int e = 0; e < 4; ++e) hacc[e] = (f32x4){0.f, 0.f, 0.f, 0.f};
    for (int i = tid; i < 17408 / 16; i += 512) ((LAS u32x4*)(lds + 71680))[i] = (u32x4){0u, 0u, 0u, 0u};
    const bool act = tid < 192; const int seg = act ? tid / 24 : 0, cgi = act ? tid % 24 : 0;
    const int ch = cgi < 8 ? head * 64 + cgi * 8 : 1024 + g * 128 + (cgi - 8) * 8;
    const bf16_t* pc = proj + (size_t)b * 2048 * NPROJ + PC_XBC + ch;
    const float* auxb = (cgi < 8 ? DT : AC) + head * NPR + b * 2048 + seg * 8;
    const float* aclb = AC + head * NPR + b * 2048 + 63;
    u32x4 rc[11]; float dc[8]; float alc;
    ssd_load_rows(pc, seg * 8, auxb, aclb, rc, dc, alc);
    __syncthreads();
    for (int n = 0; n < 32; ++n) {
        const int nn = n + 1 < 32 ? n + 1 : n;
        u32x4 rn[11]; float dn[8]; float aln;
        ssd_load_rows(pc, nn * 64 + seg * 8, auxb + nn * 64, aclb + nn * 64, rn, dn, aln);
        {
            bf16_t* hst = (bf16_t*)(p.ws + OFF_YZ) + ((size_t)(bhd * 32 + n) * 64) * 128;
            for (int i = tid; i < 1024; i += 512) { const int p_ = i >> 4, sg = i & 15; *(u32x4*)(hst + p_ * 128 + sg * 8) = *(LAS u32x4*)(hb + p_ * 136 + sg * 8); } }
        if (act) {
            float o[8][8]; float h0[8], h1[8], h2[8]; float w0[8], w1[8], w2[8], w3[8], bv[8];
            ld8f(p.in[I_SCW] + ch, w0); ld8f(p.in[I_SCW] + 1536 + ch, w1); ld8f(p.in[I_SCW] + 2 * 1536 + ch, w2); ld8f(p.in[I_SCW] + 3 * 1536 + ch, w3); ld8f(p.in[I_SCB] + ch, bv);
            unpack8(rc[0], h0); unpack8(rc[1], h1); unpack8(rc[2], h2);
#pragma unroll
            for (int tt = 0; tt < 8; ++tt) { float cur[8]; unpack8(rc[3 + tt], cur);
#pragma unroll
                for (int c = 0; c < 8; ++c) { o[tt][c] = siluf(bv[c] + w0[c] * h0[c] + w1[c] * h1[c] + w2[c] * h2[c] + w3[c] * cur[c]); h0[c] = h1[c]; h1[c] = h2[c]; h2[c] = cur[c]; } }
            if (cgi < 8) { const int p0 = cgi * 8;
#pragma unroll
                for (int c = 0; c < 8; ++c) { float f[8];
#pragma unroll
                    for (int tt = 0; tt < 8; ++tt) f[tt] = o[tt][c] * dc[tt];
                    *(LAS u32x4*)(xdtT + (p0 + c) * 72 + seg * 8) = pack8(f); }
            } else { const int s0 = (cgi - 8) * 8; float dec[8];
#pragma unroll
                for (int tt = 0; tt < 8; ++tt) dec[tt] = __expf(alc - dc[tt]);
#pragma unroll
                for (int c = 0; c < 8; ++c) { float f[8];
#pragma unroll
                    for (int tt = 0; tt < 8; ++tt) f[tt] = o[tt][c] * dec[tt];
                    *(LAS u32x4*)(BdT + (s0 + c) * 72 + seg * 8) = pack8(f); } }
        }
        LDS_BARRIER();
        { bf16x8 bdf[2];
#pragma unroll
          for (int k2 = 0; k2 < 2; ++k2) bdf[k2] = *(LAS bf16x8*)(BdT + (16 * wv + r) * 72 + 32 * k2 + 8 * q);
          const float al = __expf(alc);
#pragma unroll
          for (int pt = 0; pt < 4; ++pt) { bf16x8 xf[2];
#pragma unroll
              for (int k2 = 0; k2 < 2; ++k2) xf[k2] = *(LAS bf16x8*)(xdtT + (16 * pt + r) * 72 + 32 * k2 + 8 * q);
              hacc[pt] = hacc[pt] * al;
#pragma unroll
              for (int k2 = 0; k2 < 2; ++k2) hacc[pt] = MFMA16(bdf[k2], xf[k2], hacc[pt]);
              *(LAS u32x2*)(hb + (16 * pt + r) * 136 + 16 * wv + 4 * q) = pack4(hacc[pt]); } }
        LDS_BARRIER();
#pragma unroll
        for (int i = 0; i < 11; ++i) rc[i] = rn[i];
#pragma unroll
        for (int tt = 0; tt < 8; ++tt) dc[tt] = dn[tt];
        alc = aln;
    }
    float* so = p.out + O_SSP + (size_t)bhd * 64 * 128;
#pragma unroll
    for (int pt = 0; pt < 4; ++pt) *(f32x4*)(so + (16 * pt + r) * 128 + 16 * wv + 4 * q) = hacc[pt];
}
__device__ __forceinline__ void ssd_sample_item(CP& p, LAS unsigned char* lds, int bg) {
    { unsigned lb_ = (unsigned)(size_t)lds; asm volatile("" : "+v"(lb_)); lds = (LAS unsigned char*)(size_t)lb_; }
    const int tid = opaque_tid(), wv = tid >> 6, lane = tid & 63;
    const int b = bg >> 1, g = bg & 1, r0 = NPR + b * 8;
    LAS float* xs = (LAS float*)lds; LAS float* Bs = (LAS float*)(lds + 16384); LAS float* Cs = (LAS float*)(lds + 20480);
    LAS float* dts = (LAS float*)(lds + 24576); LAS float* dAs = (LAS float*)(lds + 24832); LAS float* yzs = (LAS float*)(lds + 25088);
    const bf16_t* proj = (const bf16_t*)(p.ws + OFF_PROJ); const float* gates = (const float*)(p.ws + OFF_GATES); bf16_t* mix = (bf16_t*)(p.ws + OFF_MIX);
    const int pp = tid >> 3, nq = tid & 7;
    const float* sin = p.in[I_SS] + ((size_t)(b * 16 + g * 8) * 64 + pp) * 128 + nq * 16;
    float* sout = p.out + O_SSS + ((size_t)(b * 16 + g * 8) * 64 + pp) * 128 + nq * 16;
    f32x4 hn[4];
#pragma unroll
    for (int v = 0; v < 4; ++v) hn[v] = *(const f32x4*)(sin + 4 * v);
    for (int idx = tid; idx < 768; idx += 512) { const int t = idx / 96, cgi = idx % 96; float o[8];
        const int ch = cgi < 64 ? g * 512 + cgi * 8 : (cgi < 80 ? 1024 + g * 128 + (cgi - 64) * 8 : 1280 + g * 128 + (cgi - 80) * 8);
        conv1x8_sample(proj + (size_t)r0 * NPROJ + PC_XBC + ch, p.in[I_SSC] + (size_t)b * 3 * 1536 + ch, 1536, t, p.in[I_SCW] + ch, p.in[I_SCB] + ch, o);
        LAS float* dst = cgi < 64 ? xs + t * 512 + cgi * 8 : (cgi < 80 ? Bs + t * 128 + (cgi - 64) * 8 : Cs + t * 128 + (cgi - 80) * 8);
        *(LAS f32x4*)dst = (f32x4){o[0], o[1], o[2], o[3]}; *(LAS f32x4*)(dst + 4) = (f32x4){o[4], o[5], o[6], o[7]}; }
    if (tid < 64) { const int t = tid >> 3, hh = tid & 7, head = g * 8 + hh;
        const float dt = softplusf(gates[(size_t)(r0 + t) * 32 + 16 + head] + p.in[I_SDB][head]);
        dts[t * 8 + hh] = dt; dAs[t * 8 + hh] = __expf(-__expf(p.in[I_SAL][head]) * dt); }
    __syncthreads();
    for (int hh = 0; hh < 8; ++hh) { const int head = g * 8 + hh;
        float hr[16];
#pragma unroll
        for (int v = 0; v < 4; ++v) { hr[4 * v] = hn[v][0]; hr[4 * v + 1] = hn[v][1]; hr[4 * v + 2] = hn[v][2]; hr[4 * v + 3] = hn[v][3]; }
        if (hh < 7) {
#pragma unroll
            for (int v = 0; v < 4; ++v) hn[v] = *(const f32x4*)(sin + (size_t)(hh + 1) * 64 * 128 + 4 * v); }
        const float Dh = p.in[I_SD][head];
#pragma unroll
        for (int t = 0; t < 8; ++t) { const float dA = dAs[t * 8 + hh], xv = xs[t * 512 + hh * 64 + pp], dtx = dts[t * 8 + hh] * xv; float yp = 0.f;
#pragma unroll
            for (int v = 0; v < 4; ++v) { const f32x4 bv = *(LAS f32x4*)(Bs + t * 128 + nq * 16 + 4 * v), cv = *(LAS f32x4*)(Cs + t * 128 + nq * 16 + 4 * v);
#pragma unroll
                for (int e = 0; e < 4; ++e) { hr[4 * v + e] = dA * hr[4 * v + e] + dtx * bv[e]; yp += hr[4 * v + e] * cv[e]; } }
            yp += __shfl_xor(yp, 1); yp += __shfl_xor(yp, 2); yp += __shfl_xor(yp, 4);
            if (nq == 0) { const float y = yp + Dh * xv; const float z = bf2f(proj[(size_t)(r0 + t) * NPROJ + PC_ZS + head * 64 + pp]); yzs[t * 512 + hh * 64 + pp] = y * siluf(z); } }
#pragma unroll
        for (int v = 0; v < 4; ++v) *(f32x4*)(sout + (size_t)hh * 64 * 128 + 4 * v) = (f32x4){hr[4 * v], hr[4 * v + 1], hr[4 * v + 2], hr[4 * v + 3]};
    }
    __syncthreads();
    { const int t = wv; float f[8]; float ss = 0.f;
      const f32x4 a = *(LAS f32x4*)(yzs + t * 512 + lane * 8), c = *(LAS f32x4*)(yzs + t * 512 + lane * 8 + 4);
      f[0] = a[0]; f[1] = a[1]; f[2] = a[2]; f[3] = a[3]; f[4] = c[0]; f[5] = c[1]; f[6] = c[2]; f[7] = c[3];
#pragma unroll
      for (int e = 0; e < 8; ++e) ss += f[e] * f[e];
      const float rinv = rsqrtf(wave_sum(ss) * (1.f / 512.f) + EPS); float w[8]; ld8f(p.in[I_SNW] + g * 512 + lane * 8, w);
#pragma unroll
      for (int e = 0; e < 8; ++e) f[e] *= rinv * w[e];
      *(u32x4*)(mix + (size_t)(r0 + t) * 2048 + 1024 + g * 512 + lane * 8) = pack8(f); }
    __syncthreads();
}

__device__ __forceinline__ void ssd_prompt_par_item(CP& p, LAS unsigned char* lds, int item) {
    { unsigned lb_ = (unsigned)(size_t)lds; asm volatile("" : "+v"(lb_)); lds = (LAS unsigned char*)(size_t)lb_; }
    const int tid = opaque_tid(), wv = tid >> 6, lane = tid & 63;
    const int c64 = item & 31, g = (item >> 5) & 1, b = item >> 6;
    LAS float* xs = (LAS float*)lds; LAS float* Bs = (LAS float*)(lds + 16384); LAS float* Cs = (LAS float*)(lds + 20480);
    LAS float* dts = (LAS float*)(lds + 24576); LAS float* dAs = (LAS float*)(lds + 24832); LAS float* yzs = (LAS float*)(lds + 25088);
    const bf16_t* proj = (const bf16_t*)(p.ws + OFF_PROJ); const float* gates = (const float*)(p.ws + OFF_GATES); bf16_t* mix = (bf16_t*)(p.ws + OFF_MIX);
    const int pp = tid >> 3, nq = tid & 7;
    f32x2p hr[8][8];
#pragma unroll
    for (int hh = 0; hh < 8; ++hh) { const bf16_t* hs = (const bf16_t*)(p.ws + OFF_YZ) + (((size_t)((b * 16 + g * 8 + hh) * 32 + c64) * 64) + pp) * 128 + nq * 16;
        float f0[8], f1[8]; ld8b(hs, f0); ld8b(hs + 8, f1);
#pragma unroll
        for (int e = 0; e < 4; ++e) { hr[hh][e] = (f32x2p){f0[2 * e], f0[2 * e + 1]}; hr[hh][4 + e] = (f32x2p){f1[2 * e], f1[2 * e + 1]}; } }
    for (int w8 = 0; w8 < 8; ++w8) { const int r0 = b * 2048 + c64 * 64 + w8 * 8;
    for (int idx = tid; idx < 768; idx += 512) { const int t = idx / 96, cgi = idx % 96; float o[8];
        const int ch = cgi < 64 ? g * 512 + cgi * 8 : (cgi < 80 ? 1024 + g * 128 + (cgi - 64) * 8 : 1280 + g * 128 + (cgi - 80) * 8);
        conv1x8_sample(proj + (size_t)r0 * NPROJ + PC_XBC + ch, nullptr, 1536, t, p.in[I_SCW] + ch, p.in[I_SCB] + ch, o, (c64 | w8) != 0);
        LAS float* dst = cgi < 64 ? xs + t * 512 + cgi * 8 : (cgi < 80 ? Bs + t * 128 + (cgi - 64) * 8 : Cs + t * 128 + (cgi - 80) * 8);
        *(LAS f32x4*)dst = (f32x4){o[0], o[1], o[2], o[3]}; *(LAS f32x4*)(dst + 4) = (f32x4){o[4], o[5], o[6], o[7]}; }
    if (tid < 64) { const int t = tid >> 3, hh = tid & 7, head = g * 8 + hh;
        const float dt = softplusf(gates[(size_t)(r0 + t) * 32 + 16 + head] + p.in[I_SDB][head]);
        dts[t * 8 + hh] = dt; dAs[t * 8 + hh] = __expf(-__expf(p.in[I_SAL][head]) * dt); }
    __syncthreads();
    {
#pragma unroll 1
        for (int t = 0; t < 8; ++t) {
            const f32x4 dA0 = *(LAS f32x4*)(dAs + t * 8), dA1 = *(LAS f32x4*)(dAs + t * 8 + 4), dt0 = *(LAS f32x4*)(dts + t * 8), dt1 = *(LAS f32x4*)(dts + t * 8 + 4);
            f32x2p yp2[8]; float yp[8], xv[8], dtx[8], dAv[8];
#pragma unroll
            for (int hh = 0; hh < 8; ++hh) { dAv[hh] = hh < 4 ? dA0[hh & 3] : dA1[hh & 3]; xv[hh] = xs[t * 512 + hh * 64 + pp]; dtx[hh] = (hh < 4 ? dt0[hh & 3] : dt1[hh & 3]) * xv[hh]; yp2[hh] = (f32x2p){0.f, 0.f}; }
#pragma unroll
            for (int v = 0; v < 4; ++v) { const f32x4 bv = *(LAS f32x4*)(Bs + t * 128 + nq * 16 + 4 * v), cv = *(LAS f32x4*)(Cs + t * 128 + nq * 16 + 4 * v);
                const f32x2p b0 = (f32x2p){bv[0], bv[1]}, b1 = (f32x2p){bv[2], bv[3]}, c0 = (f32x2p){cv[0], cv[1]}, c1 = (f32x2p){cv[2], cv[3]};
#pragma unroll
                for (int hh = 0; hh < 8; ++hh) { const f32x2p da = (f32x2p){dAv[hh], dAv[hh]}, dx = (f32x2p){dtx[hh], dtx[hh]};
                    hr[hh][2 * v] = da * hr[hh][2 * v] + dx * b0; yp2[hh] += hr[hh][2 * v] * c0;
                    hr[hh][2 * v + 1] = da * hr[hh][2 * v + 1] + dx * b1; yp2[hh] += hr[hh][2 * v + 1] * c1; } }
#pragma unroll
            for (int hh = 0; hh < 8; ++hh) yp[hh] = sum8_dpp(yp2[hh][0] + yp2[hh][1]);
            if (nq == 0) {
#pragma unroll
                for (int hh = 0; hh < 8; ++hh) { const int head = g * 8 + hh; const float y = yp[hh] + p.in[I_SD][head] * xv[hh];
                    yzs[t * 512 + hh * 64 + pp] = y; } }
        }
    }
    __syncthreads();
    { const int t = wv; float f[8]; float ss = 0.f;
      const f32x4 a = *(LAS f32x4*)(yzs + t * 512 + lane * 8), c = *(LAS f32x4*)(yzs + t * 512 + lane * 8 + 4);
      f[0] = a[0]; f[1] = a[1]; f[2] = a[2]; f[3] = a[3]; f[4] = c[0]; f[5] = c[1]; f[6] = c[2]; f[7] = c[3];
      { float zf[8]; ld8b(proj + (size_t)(r0 + t) * NPROJ + PC_ZS + g * 512 + lane * 8, zf);
#pragma unroll
        for (int e = 0; e < 8; ++e) f[e] *= siluf(zf[e]); }
#pragma unroll
      for (int e = 0; e < 8; ++e) ss += f[e] * f[e];
      const float rinv = rsqrtf(wave_sum(ss) * (1.f / 512.f) + EPS); float w[8]; ld8f(p.in[I_SNW] + g * 512 + lane * 8, w);
#pragma unroll
      for (int e = 0; e < 8; ++e) f[e] *= rinv * w[e];
      *(u32x4*)(mix + (size_t)(r0 + t) * 2048 + 1024 + g * 512 + lane * 8) = pack8(f); }
    __syncthreads();
    }
}


__device__ __forceinline__ void ssd_sample_fast_item(CP& p, LAS unsigned char* lds, int bg) {
    { unsigned lb_ = (unsigned)(size_t)lds; asm volatile("" : "+v"(lb_)); lds = (LAS unsigned char*)(size_t)lb_; }
    const int tid = opaque_tid(), wv = tid >> 6, lane = tid & 63;
    const int b = bg >> 1, g = bg & 1, r0 = NPR + b * 8;
    LAS float* xs = (LAS float*)lds; LAS float* Bs = (LAS float*)(lds + 16384); LAS float* Cs = (LAS float*)(lds + 20480);
    LAS float* dts = (LAS float*)(lds + 24576); LAS float* dAs = (LAS float*)(lds + 24832); LAS float* yzs = (LAS float*)(lds + 25088);
    const bf16_t* proj = (const bf16_t*)(p.ws + OFF_PROJ); const float* gates = (const float*)(p.ws + OFF_GATES); bf16_t* mix = (bf16_t*)(p.ws + OFF_MIX);
    const int pp = tid >> 3, nq = tid & 7;
    f32x2p hr[8][8];
#pragma unroll
    for (int hh = 0; hh < 8; ++hh) { const float* hs = p.in[I_SS] + ((size_t)(b * 16 + g * 8 + hh) * 64 + pp) * 128 + nq * 16;
#pragma unroll
        for (int v = 0; v < 4; ++v) { const f32x4 x4 = *(const f32x4*)(hs + 4 * v); hr[hh][2 * v] = (f32x2p){x4[0], x4[1]}; hr[hh][2 * v + 1] = (f32x2p){x4[2], x4[3]}; } }
    {
    for (int idx = tid; idx < 768; idx += 512) { const int t = idx / 96, cgi = idx % 96; float o[8];
        const int ch = cgi < 64 ? g * 512 + cgi * 8 : (cgi < 80 ? 1024 + g * 128 + (cgi - 64) * 8 : 1280 + g * 128 + (cgi - 80) * 8);
        conv1x8_sample(proj + (size_t)r0 * NPROJ + PC_XBC + ch, p.in[I_SSC] + (size_t)b * 3 * 1536 + ch, 1536, t, p.in[I_SCW] + ch, p.in[I_SCB] + ch, o);
        LAS float* dst = cgi < 64 ? xs + t * 512 + cgi * 8 : (cgi < 80 ? Bs + t * 128 + (cgi - 64) * 8 : Cs + t * 128 + (cgi - 80) * 8);
        *(LAS f32x4*)dst = (f32x4){o[0], o[1], o[2], o[3]}; *(LAS f32x4*)(dst + 4) = (f32x4){o[4], o[5], o[6], o[7]}; }
    if (tid < 64) { const int t = tid >> 3, hh = tid & 7, head = g * 8 + hh;
        const float dt = softplusf(gates[(size_t)(r0 + t) * 32 + 16 + head] + p.in[I_SDB][head]);
        dts[t * 8 + hh] = dt; dAs[t * 8 + hh] = __expf(-__expf(p.in[I_SAL][head]) * dt); }
    __syncthreads();
    {
#pragma unroll 1
        for (int t = 0; t < 8; ++t) {
            const f32x4 dA0 = *(LAS f32x4*)(dAs + t * 8), dA1 = *(LAS f32x4*)(dAs + t * 8 + 4), dt0 = *(LAS f32x4*)(dts + t * 8), dt1 = *(LAS f32x4*)(dts + t * 8 + 4);
            f32x2p yp2[8]; float yp[8], xv[8], dtx[8], dAv[8];
#pragma unroll
            for (int hh = 0; hh < 8; ++hh) { dAv[hh] = hh < 4 ? dA0[hh & 3] : dA1[hh & 3]; xv[hh] = xs[t * 512 + hh * 64 + pp]; dtx[hh] = (hh < 4 ? dt0[hh & 3] : dt1[hh & 3]) * xv[hh]; yp2[hh] = (f32x2p){0.f, 0.f}; }
#pragma unroll
            for (int v = 0; v < 4; ++v) { const f32x4 bv = *(LAS f32x4*)(Bs + t * 128 + nq * 16 + 4 * v), cv = *(LAS f32x4*)(Cs + t * 128 + nq * 16 + 4 * v);
                const f32x2p b0 = (f32x2p){bv[0], bv[1]}, b1 = (f32x2p){bv[2], bv[3]}, c0 = (f32x2p){cv[0], cv[1]}, c1 = (f32x2p){cv[2], cv[3]};
#pragma unroll
                for (int hh = 0; hh < 8; ++hh) { const f32x2p da = (f32x2p){dAv[hh], dAv[hh]}, dx = (f32x2p){dtx[hh], dtx[hh]};
                    hr[hh][2 * v] = da * hr[hh][2 * v] + dx * b0; yp2[hh] += hr[hh][2 * v] * c0;
                    hr[hh][2 * v + 1] = da * hr[hh][2 * v + 1] + dx * b1; yp2[hh] += hr[hh][2 * v + 1] * c1; } }
#pragma unroll
            for (int hh = 0; hh < 8; ++hh) yp[hh] = sum8_dpp(yp2[hh][0] + yp2[hh][1]);
            if (nq == 0) {
#pragma unroll
                for (int hh = 0; hh < 8; ++hh) { const int head = g * 8 + hh; const float y = yp[hh] + p.in[I_SD][head] * xv[hh];
                    yzs[t * 512 + hh * 64 + pp] = y; } }
        }
    }
    __syncthreads();
    { const int t = wv; float f[8]; float ss = 0.f;
      const f32x4 a = *(LAS f32x4*)(yzs + t * 512 + lane * 8), c = *(LAS f32x4*)(yzs + t * 512 + lane * 8 + 4);
      f[0] = a[0]; f[1] = a[1]; f[2] = a[2]; f[3] = a[3]; f[4] = c[0]; f[5] = c[1]; f[6] = c[2]; f[7] = c[3];
      { float zf[8]; ld8b(proj + (size_t)(r0 + t) * NPROJ + PC_ZS + g * 512 + lane * 8, zf);
#pragma unroll
        for (int e = 0; e < 8; ++e) f[e] *= siluf(zf[e]); }
#pragma unroll
      for (int e = 0; e < 8; ++e) ss += f[e] * f[e];
      const float rinv = rsqrtf(wave_sum(ss) * (1.f / 512.f) + EPS); float w[8]; ld8f(p.in[I_SNW] + g * 512 + lane * 8, w);
#pragma unroll
      for (int e = 0; e < 8; ++e) f[e] *= rinv * w[e];
      *(u32x4*)(mix + (size_t)(r0 + t) * 2048 + 1024 + g * 512 + lane * 8) = pack8(f); }
    __syncthreads();
    }
#pragma unroll
    for (int hh = 0; hh < 8; ++hh) { float* ho = p.out + O_SSS + ((size_t)(b * 16 + g * 8 + hh) * 64 + pp) * 128 + nq * 16;
#pragma unroll
        for (int v = 0; v < 4; ++v) *(f32x4*)(ho + 4 * v) = (f32x4){hr[hh][2 * v][0], hr[hh][2 * v][1], hr[hh][2 * v + 1][0], hr[hh][2 * v + 1][1]}; }
}

__device__ __forceinline__ void ssd_prompt_seq_item(CP& p, LAS unsigned char* lds, int bg) {
    { unsigned lb_ = (unsigned)(size_t)lds; asm volatile("" : "+v"(lb_)); lds = (LAS unsigned char*)(size_t)lb_; }
    const int tid = opaque_tid(), wv = tid >> 6, lane = tid & 63;
    const int b = bg >> 1, g = bg & 1;
    LAS float* xs = (LAS float*)lds; LAS float* Bs = (LAS float*)(lds + 16384); LAS float* Cs = (LAS float*)(lds + 20480);
    LAS float* dts = (LAS float*)(lds + 24576); LAS float* dAs = (LAS float*)(lds + 24832); LAS float* yzs = (LAS float*)(lds + 25088);
    const bf16_t* proj = (const bf16_t*)(p.ws + OFF_PROJ); const float* gates = (const float*)(p.ws + OFF_GATES); bf16_t* mix = (bf16_t*)(p.ws + OFF_MIX);
    const int pp = tid >> 3, nq = tid & 7;
    float* carry_ = (DBG_SSD_SEQ == 2 || DBG_SSD_SEQ == 4) ? (float*)(p.ws + OFF_FF) : p.out + O_SSP;
    const float* sin = carry_ + ((size_t)(b * 16 + g * 8) * 64 + pp) * 128 + nq * 16;
    float* sout = carry_ + ((size_t)(b * 16 + g * 8) * 64 + pp) * 128 + nq * 16;
    for (int w8 = 0; w8 < 256; ++w8) { const int r0 = b * 2048 + w8 * 8;
    f32x4 hn[4];
#pragma unroll
    for (int v = 0; v < 4; ++v) hn[v] = w8 ? *(const f32x4*)(sin + 4 * v) : (f32x4){0.f, 0.f, 0.f, 0.f};
    for (int idx = tid; idx < 768; idx += 512) { const int t = idx / 96, cgi = idx % 96; float o[8];
        const int ch = cgi < 64 ? g * 512 + cgi * 8 : (cgi < 80 ? 1024 + g * 128 + (cgi - 64) * 8 : 1280 + g * 128 + (cgi - 80) * 8);
        conv1x8_sample(proj + (size_t)r0 * NPROJ + PC_XBC + ch, nullptr, 1536, t, p.in[I_SCW] + ch, p.in[I_SCB] + ch, o, w8 > 0);
        LAS float* dst = cgi < 64 ? xs + t * 512 + cgi * 8 : (cgi < 80 ? Bs + t * 128 + (cgi - 64) * 8 : Cs + t * 128 + (cgi - 80) * 8);
        *(LAS f32x4*)dst = (f32x4){o[0], o[1], o[2], o[3]}; *(LAS f32x4*)(dst + 4) = (f32x4){o[4], o[5], o[6], o[7]}; }
    if (tid < 64) { const int t = tid >> 3, hh = tid & 7, head = g * 8 + hh;
        const float dt = softplusf(gates[(size_t)(r0 + t) * 32 + 16 + head] + p.in[I_SDB][head]);
        dts[t * 8 + hh] = dt; dAs[t * 8 + hh] = __expf(-__expf(p.in[I_SAL][head]) * dt); }
    __syncthreads();
    for (int hh = 0; hh < 8; ++hh) { const int head = g * 8 + hh;
        float hr[16];
#pragma unroll
        for (int v = 0; v < 4; ++v) { hr[4 * v] = hn[v][0]; hr[4 * v + 1] = hn[v][1]; hr[4 * v + 2] = hn[v][2]; hr[4 * v + 3] = hn[v][3]; }
        if (hh < 7) {
#pragma unroll
            for (int v = 0; v < 4; ++v) hn[v] = w8 ? *(const f32x4*)(sin + (size_t)(hh + 1) * 64 * 128 + 4 * v) : (f32x4){0.f, 0.f, 0.f, 0.f}; }
        const float Dh = p.in[I_SD][head];
#pragma unroll
        for (int t = 0; t < 8; ++t) { const float dA = dAs[t * 8 + hh], xv = xs[t * 512 + hh * 64 + pp], dtx = dts[t * 8 + hh] * xv; float yp = 0.f;
#pragma unroll
            for (int v = 0; v < 4; ++v) { const f32x4 bv = *(LAS f32x4*)(Bs + t * 128 + nq * 16 + 4 * v), cv = *(LAS f32x4*)(Cs + t * 128 + nq * 16 + 4 * v);
#pragma unroll
                for (int e = 0; e < 4; ++e) { hr[4 * v + e] = dA * hr[4 * v + e] + dtx * bv[e]; yp += hr[4 * v + e] * cv[e]; } }
            yp += __shfl_xor(yp, 1); yp += __shfl_xor(yp, 2); yp += __shfl_xor(yp, 4);
            if (nq == 0) { const float y = yp + Dh * xv; const float z = bf2f(proj[(size_t)(r0 + t) * NPROJ + PC_ZS + head * 64 + pp]); yzs[t * 512 + hh * 64 + pp] = y * siluf(z); } }
#pragma unroll
        for (int v = 0; v < 4; ++v) *(f32x4*)(sout + (size_t)hh * 64 * 128 + 4 * v) = (f32x4){hr[4 * v], hr[4 * v + 1], hr[4 * v + 2], hr[4 * v + 3]};
    }
    __syncthreads();
    { const int t = wv; float f[8]; float ss = 0.f;
      const f32x4 a = *(LAS f32x4*)(yzs + t * 512 + lane * 8), c = *(LAS f32x4*)(yzs + t * 512 + lane * 8 + 4);
      f[0] = a[0]; f[1] = a[1]; f[2] = a[2]; f[3] = a[3]; f[4] = c[0]; f[5] = c[1]; f[6] = c[2]; f[7] = c[3];
#pragma unroll
      for (int e = 0; e < 8; ++e) ss += f[e] * f[e];
      const float rinv = rsqrtf(wave_sum(ss) * (1.f / 512.f) + EPS); float w[8]; ld8f(p.in[I_SNW] + g * 512 + lane * 8, w);
#pragma unroll
      for (int e = 0; e < 8; ++e) f[e] *= rinv * w[e];
      if (DBG_SSD_SEQ >= 3) { if (DBG_SSD_SEQ == 3 || !DBG_SUBSET((r0 + t) & 2047)) { float f2[8]; f2[0] = a[0]; f2[1] = a[1]; f2[2] = a[2]; f2[3] = a[3]; f2[4] = c[0]; f2[5] = c[1]; f2[6] = c[2]; f2[7] = c[3];
          *(u32x4*)((bf16_t*)(p.ws + OFF_YZ) + (size_t)(r0 + t) * 1024 + g * 512 + lane * 8) = pack8(f2); } }
      else *(u32x4*)(mix + (size_t)(r0 + t) * 2048 + 1024 + g * 512 + lane * 8) = pack8(f); }
    __syncthreads();
    }
}


__device__ __forceinline__ void gdn_sample_item(CP& p, LAS unsigned char* lds, int bh) {
    { unsigned lb_ = (unsigned)(size_t)lds; asm volatile("" : "+v"(lb_)); lds = (LAS unsigned char*)(size_t)lb_; }
    const int tid = opaque_tid(), wv = tid >> 6, lane = tid & 63;
    const int b = bh >> 3, h = bh & 7, r0 = NPR + b * 8;
    LAS float* qs = (LAS float*)lds; LAS float* ks = (LAS float*)(lds + 4096); LAS float* vs = (LAS float*)(lds + 8192);
    LAS float* as = (LAS float*)(lds + 12288); LAS float* bs = as + 8; LAS float* part = (LAS float*)(lds + 12544); LAS float* opart = (LAS float*)(lds + 16640);
    const bf16_t* proj = (const bf16_t*)(p.ws + OFF_PROJ); const float* gates = (const float*)(p.ws + OFF_GATES); bf16_t* mix = (bf16_t*)(p.ws + OFF_MIX);
    const int e = tid & 127, dq = tid >> 7;
    const float* sin = p.in[I_SG] + ((size_t)bh * 128 + dq * 32) * 128 + e;
    float* sout = p.out + O_GSS + ((size_t)bh * 128 + dq * 32) * 128 + e;
    float S[32];
#pragma unroll
    for (int d = 0; d < 32; ++d) S[d] = sin[d * 128];
    if (tid < 384) { const int part_ = tid >> 7, t = (tid >> 4) & 7, cgi = tid & 15, ch = part_ * 1024 + h * 128 + cgi * 8; float o[8];
        conv1x8_sample(proj + (size_t)r0 * NPROJ + ch, p.in[I_SGC] + (size_t)b * 3 * 3072 + ch, 3072, t, p.in[I_GCW] + ch, nullptr, o);
        if (part_ < 2) { float ss = 0.f;
#pragma unroll
            for (int c = 0; c < 8; ++c) ss += o[c] * o[c];
            ss = sum16_dpp(ss);
            const float sc = rsqrtf(ss + EPS) * (part_ == 0 ? 0.08838834764831845f : 1.f);
#pragma unroll
            for (int c = 0; c < 8; ++c) o[c] *= sc; }
        LAS float* dst = (part_ == 0 ? qs : (part_ == 1 ? ks : vs)) + t * 128 + cgi * 8;
        *(LAS f32x4*)dst = (f32x4){o[0], o[1], o[2], o[3]}; *(LAS f32x4*)(dst + 4) = (f32x4){o[4], o[5], o[6], o[7]};
    } else if (tid < 392) { const int t = tid - 384;
        const float gg = -__expf(p.in[I_GAL][h]) * softplusf(gates[(size_t)(r0 + t) * 32 + 8 + h] + p.in[I_GDB][h]);
        as[t] = __expf(gg); bs[t] = sigmf(gates[(size_t)(r0 + t) * 32 + h]); }
    __syncthreads();
    float op[8];
#pragma unroll
    for (int t = 0; t < 8; ++t) { float kp = 0.f;
#pragma unroll
        for (int v = 0; v < 8; ++v) { const f32x4 kv = *(LAS f32x4*)(ks + t * 128 + dq * 32 + 4 * v); kp += kv[0] * S[4 * v] + kv[1] * S[4 * v + 1] + kv[2] * S[4 * v + 2] + kv[3] * S[4 * v + 3]; }
        part[(t & 1) * 512 + dq * 128 + e] = kp;
        __syncthreads();
        const float kd = (part[(t & 1) * 512 + e] + part[(t & 1) * 512 + 128 + e]) + (part[(t & 1) * 512 + 256 + e] + part[(t & 1) * 512 + 384 + e]);
        const float a = as[t], coef = bs[t] * (vs[t * 128 + e] - a * kd); float oq = 0.f;
#pragma unroll
        for (int v = 0; v < 8; ++v) { const f32x4 kv = *(LAS f32x4*)(ks + t * 128 + dq * 32 + 4 * v), qv = *(LAS f32x4*)(qs + t * 128 + dq * 32 + 4 * v);
#pragma unroll
            for (int c = 0; c < 4; ++c) { S[4 * v + c] = a * S[4 * v + c] + kv[c] * coef; oq += qv[c] * S[4 * v + c]; } }
        op[t] = oq; }
#pragma unroll
    for (int t = 0; t < 8; ++t) opart[(dq * 8 + t) * 128 + e] = op[t];
#pragma unroll
    for (int d = 0; d < 32; ++d) sout[d * 128] = S[d];
    __syncthreads();
    { const int t = wv; float o2[2]; float ss = 0.f;
#pragma unroll
      for (int k = 0; k < 2; ++k) { const int ee = lane + 64 * k; o2[k] = (opart[(0 * 8 + t) * 128 + ee] + opart[(1 * 8 + t) * 128 + ee]) + (opart[(2 * 8 + t) * 128 + ee] + opart[(3 * 8 + t) * 128 + ee]); ss += o2[k] * o2[k]; }
      const float rinv = rsqrtf(wave_sum(ss) * (1.f / 128.f) + EPS);
#pragma unroll
      for (int k = 0; k < 2; ++k) { const int ee = lane + 64 * k; const float zg = bf2f(proj[(size_t)(r0 + t) * NPROJ + PC_ZG + h * 128 + ee]);
          mix[(size_t)(r0 + t) * 2048 + h * 128 + ee] = f2bf(o2[k] * rinv * p.in[I_GNW][ee] * siluf(zg)); } }
    __syncthreads();
}

__device__ __forceinline__ void gdn_prompt_seq_item(CP& p, LAS unsigned char* lds, int bh) {
    { unsigned lb_ = (unsigned)(size_t)lds; asm volatile("" : "+v"(lb_)); lds = (LAS unsigned char*)(size_t)lb_; }
    const int tid = opaque_tid(), wv = tid >> 6, lane = tid & 63;
    const int b = bh >> 3, h = bh & 7;
    LAS float* qs = (LAS float*)lds; LAS float* ks = (LAS float*)(lds + 4096); LAS float* vs = (LAS float*)(lds + 8192);
    LAS float* as = (LAS float*)(lds + 12288); LAS float* bs = as + 8; LAS float* part = (LAS float*)(lds + 12544); LAS float* opart = (LAS float*)(lds + 16640);
    const bf16_t* proj = (const bf16_t*)(p.ws + OFF_PROJ); const float* gates = (const float*)(p.ws + OFF_GATES); bf16_t* mix = (bf16_t*)(p.ws + OFF_MIX);
    const int e = tid & 127, dq = tid >> 7;
    float* sout = p.out + O_GSP + ((size_t)bh * 128 + dq * 32) * 128 + e;
    float S[32];
#pragma unroll
    for (int d = 0; d < 32; ++d) S[d] = 0.f;
    for (int w8 = 0; w8 < 256; ++w8) { const int r0 = b * 2048 + w8 * 8;
    if (tid < 384) { const int part_ = tid >> 7, t = (tid >> 4) & 7, cgi = tid & 15, ch = part_ * 1024 + h * 128 + cgi * 8; float o[8];
        conv1x8_sample(proj + (size_t)r0 * NPROJ + ch, nullptr, 3072, t, p.in[I_GCW] + ch, nullptr, o, w8 > 0);
        if (part_ < 2) { float ss = 0.f;
#pragma unroll
            for (int c = 0; c < 8; ++c) ss += o[c] * o[c];
            ss = sum16_dpp(ss);
            const float sc = rsqrtf(ss + EPS) * (part_ == 0 ? 0.08838834764831845f : 1.f);
#pragma unroll
            for (int c = 0; c < 8; ++c) o[c] *= sc; }
        LAS float* dst = (part_ == 0 ? qs : (part_ == 1 ? ks : vs)) + t * 128 + cgi * 8;
        *(LAS f32x4*)dst = (f32x4){o[0], o[1], o[2], o[3]}; *(LAS f32x4*)(dst + 4) = (f32x4){o[4], o[5], o[6], o[7]};
    } else if (tid < 392) { const int t = tid - 384;
        const float gg = -__expf(p.in[I_GAL][h]) * softplusf(gates[(size_t)(r0 + t) * 32 + 8 + h] + p.in[I_GDB][h]);
        as[t] = __expf(gg); bs[t] = sigmf(gates[(size_t)(r0 + t) * 32 + h]); }
    __syncthreads();
    float op[8];
#pragma unroll
    for (int t = 0; t < 8; ++t) { float kp = 0.f;
#pragma unroll
        for (int v = 0; v < 8; ++v) { const f32x4 kv = *(LAS f32x4*)(ks + t * 128 + dq * 32 + 4 * v); kp += kv[0] * S[4 * v] + kv[1] * S[4 * v + 1] + kv[2] * S[4 * v + 2] + kv[3] * S[4 * v + 3]; }
        part[(t & 1) * 512 + dq * 128 + e] = kp;
        __syncthreads();
        const float kd = (part[(t & 1) * 512 + e] + part[(t & 1) * 512 + 128 + e]) + (part[(t & 1) * 512 + 256 + e] + part[(t & 1) * 512 + 384 + e]);
        const float a = as[t], coef = bs[t] * (vs[t * 128 + e] - a * kd); float oq = 0.f;
#pragma unroll
        for (int v = 0; v < 8; ++v) { const f32x4 kv = *(LAS f32x4*)(ks + t * 128 + dq * 32 + 4 * v), qv = *(LAS f32x4*)(qs + t * 128 + dq * 32 + 4 * v);
#pragma unroll
            for (int c = 0; c < 4; ++c) { S[4 * v + c] = a * S[4 * v + c] + kv[c] * coef; oq += qv[c] * S[4 * v + c]; } }
        op[t] = oq; }
#pragma unroll
    for (int t = 0; t < 8; ++t) opart[(dq * 8 + t) * 128 + e] = op[t];
    __syncthreads();
    { const int t = wv; float o2[2]; float ss = 0.f;
#pragma unroll
      for (int k = 0; k < 2; ++k) { const int ee = lane + 64 * k; o2[k] = (opart[(0 * 8 + t) * 128 + ee] + opart[(1 * 8 + t) * 128 + ee]) + (opart[(2 * 8 + t) * 128 + ee] + opart[(3 * 8 + t) * 128 + ee]); ss += o2[k] * o2[k]; }
      const float rinv = rsqrtf(wave_sum(ss) * (1.f / 128.f) + EPS);
#pragma unroll
      for (int k = 0; k < 2; ++k) { const int ee = lane + 64 * k; const float zg = bf2f(proj[(size_t)(r0 + t) * NPROJ + PC_ZG + h * 128 + ee]);
          mix[(size_t)(r0 + t) * 2048 + h * 128 + ee] = f2bf(o2[k] * rinv * p.in[I_GNW][ee] * siluf(zg)); } }
    __syncthreads();
    }
#pragma unroll
    for (int d = 0; d < 32; ++d) sout[d * 128] = S[d];
}


#ifndef ITEMMASK
#define ITEMMASK 15
#endif

template <int KIND> __device__ __forceinline__ void phase3_loop(CP& p, LAS unsigned char* lds, int nitems) {
    unsigned* ctr = (unsigned*)(p.ws + OFF_CTR) + KIND;
    LAS int* sitem = (LAS int*)(lds + 130048);
    for (;;) {
        if (threadIdx.x == 0) *sitem = (int)atomicAdd(ctr, 1u);
        __syncthreads();
        const int item = *sitem;
        __syncthreads();
        if (item >= nitems) break;
        if (KIND == 0) gdn_scan_item(p, lds, item);
        if (KIND == 1) ssd_scan_item(p, lds, item);
        if (KIND == 2) ssd_sample_item(p, lds, item);
        if (KIND == 3) gdn_sample_item(p, lds, item);
        if (KIND == 4) gdn_prompt_seq_item(p, lds, item);
        if (KIND == 5) ssd_prompt_seq_item(p, lds, item);
        if (KIND == 6) ssd_prompt_par_item(p, lds, item);
    }
}
__device__ __forceinline__ void phase3(LAS unsigned char* lds) {
    const int bid = blockIdx.x, nb = gridDim.x;
    if (nb >= 128) {
        if (bid < 32) { CP& p = *get_params(); gdn_scan_item(p, lds, bid); }
        if (bid >= 32 && bid < 96) { CP& p = *get_params(); ssd_scan_item(p, lds, bid - 32); }
        if (bid >= 96) { CP& p = *get_params(); for (int it = bid - 96; it < 1024; it += nb - 96) gdn_sample_item(p, lds, it); }
    } else {
        { CP& p = *get_params(); for (int it = bid; it < 32; it += nb) gdn_scan_item(p, lds, it); }
        { CP& p = *get_params(); for (int it = bid; it < 64; it += nb) ssd_scan_item(p, lds, it); }
        { CP& p = *get_params(); for (int it = bid; it < 1024; it += nb) gdn_sample_item(p, lds, it); }
    }
}

__device__ __forceinline__ void phase4(LAS unsigned char* lds) {
    { const int bid = blockIdx.x, nb = gridDim.x;
      if (nb >= 192) {
          { CP& p = *get_params(); for (int it = bid; it < 256; it += nb) ssd_prompt_par_item(p, lds, it); }
          { CP& p = *get_params(); for (int it = bid; it < 256; it += nb) ssd_sample_fast_item(p, lds, it); }
      } else {
          { CP& p = *get_params(); for (int it = bid; it < 256; it += nb) ssd_prompt_par_item(p, lds, it); }
          { CP& p = *get_params(); for (int it = bid; it < 256; it += nb) ssd_sample_fast_item(p, lds, it); }
      } }
    CP& p = *get_params();
    const int tid_ = opaque_tid(), wv = tid_ >> 6, lane = tid_ & 63;
    const bf16_t* YZ = (const bf16_t*)(p.ws + OFF_YZ); bf16_t* mix = (bf16_t*)(p.ws + OFF_MIX);
#if DBG_SSD_SEQ >= 3
    for (int job = blockIdx.x * 8 + wv; job < NPR * 2; job += gridDim.x * 8) { const int row = job >> 1, g = job & 1; float f[8], w[8]; float ss = 0.f;
        ld8b(YZ + (size_t)row * 1024 + g * 512 + lane * 8, f);
#pragma unroll
        for (int e = 0; e < 8; ++e) ss += f[e] * f[e];
        const float rinv = rsqrtf(wave_sum(ss) * (1.f / 512.f) + EPS); ld8f(p.in[I_SNW] + g * 512 + lane * 8, w);
#pragma unroll
        for (int e = 0; e < 8; ++e) f[e] *= rinv * w[e];
        *(u32x4*)(mix + (size_t)row * 2048 + 1024 + g * 512 + lane * 8) = pack8(f); }
#endif
}
__device__ __forceinline__ void phase_final(CP& p) {
    const int tid_ = opaque_tid(), wv = tid_ >> 6, lane = tid_ & 63;
    const float* ss = (const float*)(p.ws + OFF_SS2); const f32x4* wn = (const f32x4*)p.in[I_FINW];
    for (int row = blockIdx.x * 8 + wv; row < NTOK; row += gridDim.x * 8) { const float rinv = rsqrtf(wave_sum(lane < 32 ? ss[((size_t)(lane >> 2) * NTOK + row) * 4 + (lane & 3)] : 0.f) * (1.f / 2048.f) + EPS);
        const u32x4* xr = (const u32x4*)((const bf16_t*)(p.ws + OFF_X2B) + (size_t)row * 2048); f32x4* yr = (f32x4*)(p.out + (size_t)row * 2048);
#ifndef DBG_SCALE_S
#define DBG_SCALE_S 1.0f
#endif
#ifndef DBG_SCALE_P
#define DBG_SCALE_P 1.0f
#endif
        const float dsc = row < NPR ? DBG_SCALE_P : DBG_SCALE_S;
#pragma unroll
        for (int j = 0; j < 4; ++j) { float f[8]; unpack8(xr[lane + 64 * j], f); const int c4 = 2 * (lane + 64 * j);
            yr[c4] = (f32x4){f[0], f[1], f[2], f[3]} * (rinv * dsc) * wn[c4]; yr[c4 + 1] = (f32x4){f[4], f[5], f[6], f[7]} * (rinv * dsc) * wn[c4 + 1]; } }
}

#ifndef SKIPMASK
#define SKIPMASK 0
#endif
#define GSYNC() do { asm volatile("s_waitcnt vmcnt(0)" ::: "memory"); grid.sync(); if (threadIdx.x < 64) { __builtin_amdgcn_fence(__ATOMIC_ACQUIRE, "agent"); asm volatile("s_waitcnt vmcnt(0)" ::: "memory"); } __syncthreads(); } while (0)
#ifndef MAXPHASE
#define MAXPHASE 99
#endif
#ifdef DBG_TIME_A
#define STAMP(k) do { if ((k) == DBG_TIME_A) ta_ = __builtin_amdgcn_s_memrealtime(); if ((k) == DBG_TIME_B) tb_ = __builtin_amdgcn_s_memrealtime(); } while (0)
#else
#define STAMP(k) do { } while (0)
#endif
#define GSYNCK(kk) do { asm volatile("s_waitcnt vmcnt(0)" ::: "memory"); __syncthreads(); \
    if (threadIdx.x == 0) { unsigned* cnt_ = (unsigned*)(get_params()->ws + OFF_CTR) + 16; \
        __builtin_amdgcn_fence(__ATOMIC_RELEASE, "agent"); asm volatile("s_waitcnt vmcnt(0)" ::: "memory"); \
        __hip_atomic_fetch_add(cnt_, 1u, __ATOMIC_RELAXED, __HIP_MEMORY_SCOPE_AGENT); \
        const unsigned want_ = (unsigned)gridDim.x * (unsigned)(kk); \
        while (__hip_atomic_load(cnt_, __ATOMIC_RELAXED, __HIP_MEMORY_SCOPE_AGENT) < want_) __builtin_amdgcn_s_sleep(1); \
        __builtin_amdgcn_fence(__ATOMIC_ACQUIRE, "agent"); asm volatile("s_waitcnt vmcnt(0)" ::: "memory"); } \
    __syncthreads(); } while (0)
__global__ __launch_bounds__(512, 2) void mega(Params p_unused) {
    extern __shared__ __attribute__((aligned(16))) unsigned char shm[];
    LAS unsigned char* lds = (LAS unsigned char*)shm;
    cg::grid_group grid = cg::this_grid();
    pg8::StaticOrder S;
    unsigned long long t0_ = 0, ta_ = 0, tb_ = 0; (void)ta_; (void)tb_;
#ifdef DBG_TIME_A
#ifdef DBG_T0_AFTER_SYNC
    GSYNC();
#endif
    t0_ = __builtin_amdgcn_s_memrealtime();
#endif
#if !((SKIPMASK >> 0) & 1)
    { CP& p = *get_params(); phase_prep(p, lds); }
    if (blockIdx.x == 0 && threadIdx.x == 0) { CP& p = *get_params(); __hip_atomic_store((unsigned*)(p.ws + OFF_CTR) + 16, 0u, __ATOMIC_RELAXED, __HIP_MEMORY_SCOPE_AGENT); }
#endif
    GSYNC();
    STAMP(1);
#if !((SKIPMASK >> 1) & 1)
    { CP& p = *get_params(); pg8::Gemm g{(const bf16_t*)((const unsigned char*)p.out + OB_HB), (const bf16_t*)((const unsigned char*)p.out + OB_WINT), NTOK, NPROJ_GEMM, 2048}; S.init(g.M, g.N, (int)gridDim.x, (int)blockIdx.x);
      EpiProj E{(bf16_t*)(p.ws + OFF_PROJ), (float*)(p.ws + OFF_GATES)}; pg8::gemm_phase<EpiProj, pg8::StaticOrder, false>(lds, g, S, E, nullptr); }
#endif
    GSYNCK(1);
    STAMP(2);
    if (MAXPHASE < 2) return;
#if !((SKIPMASK >> 2) & 1)
    { CP& p = *get_params(); phase2(p, lds); }
#endif
    GSYNCK(2);
    STAMP(3);
    if (MAXPHASE < 3) return;
#if !((SKIPMASK >> 3) & 1)
    phase3(lds);
#endif
    GSYNCK(3);
    STAMP(4);
    if (MAXPHASE < 4) return;
#if !((SKIPMASK >> 4) & 1)
    phase4(lds);
#endif
    GSYNCK(4);
    STAMP(5);
#ifdef DBG_DUMP_MIX
    { CP& p = *get_params(); const bf16_t* src = (const bf16_t*)(p.ws + (DBG_DUMP_MIX == 1 ? OFF_MIX : OFF_PROJ)); const int ld = DBG_DUMP_MIX == 1 ? 2048 : NPROJ; const int c0 = DBG_DUMP_MIX == 1 ? 0 : (DBG_DUMP_MIX - 2) * 2048;
      for (size_t i = (size_t)blockIdx.x * 512 + threadIdx.x; i < (size_t)NTOK * 2048; i += (size_t)gridDim.x * 512) { const size_t r = i >> 11, c = i & 2047; float v = bf2f(src[r * ld + c0 + c]);
#ifdef DBG_Q
          { const int qd = (r >= NPR ? 2 : 0) + (c >= 1024 ? 1 : 0); if (qd != DBG_Q) v = 0.f; }
#endif
#if DBG_DUMP_MIX == 10
          v = ((const float*)(p.ws + OFF_GATES))[r * 32 + (c & 31)];
#endif
#if DBG_DUMP_MIX == 11
          v = (r < NPR) ? ((const float*)(p.ws + OFF_DT))[(c & 15) * NPR + r] + ((const float*)(p.ws + OFF_ACUM))[(c & 15) * NPR + r] : 0.f;
#endif
#if DBG_DUMP_MIX == 9
          v = (r < NPR && c < 1024) ? bf2f(((const bf16_t*)(p.ws + OFF_YZ))[r * 1024 + c]) : 0.f;
#endif
          p.out[i] = v; } }
    return;
#endif
#if !((SKIPMASK >> 5) & 1)
    { CP& p = *get_params(); pg8::Gemm g{(const bf16_t*)(p.ws + OFF_MIX), (const bf16_t*)(p.ws + OFF_WOUT), NTOK, 2048, 2048}; S.init(g.M, g.N, (int)gridDim.x, (int)blockIdx.x);
      EpiOut E{p.in[I_XP], p.in[I_XS], p.out, (bf16_t*)(p.ws + OFF_X1B), (float*)(p.ws + OFF_SS1)}; pg8::gemm_phase<EpiOut, pg8::StaticOrder, false>(lds, g, S, E, nullptr); }
#endif
    GSYNCK(5);
    STAMP(6);
    if (MAXPHASE < 6) return;
#if !((SKIPMASK >> 6) & 1)
    { CP& p = *get_params(); pg8::Gemm g{(const bf16_t*)(p.ws + OFF_X1B), (const bf16_t*)(p.ws + OFF_WGU), NTOK, 2 * DFF, 2048}; S.init(g.M, g.N, (int)gridDim.x, (int)blockIdx.x);
      EpiGU E{(bf16_t*)(p.ws + OFF_FF), (const float*)(p.ws + OFF_SS1)}; pg8::gemm_phase<EpiGU, pg8::StaticOrder, false>(lds, g, S, E, nullptr); }
#endif
    GSYNCK(6);
    STAMP(7);
    if (MAXPHASE < 7) return;
#if !((SKIPMASK >> 7) & 1)
    { CP& p = *get_params(); pg8::Gemm g{(const bf16_t*)(p.ws + OFF_FF), (const bf16_t*)(p.ws + OFF_WDN), NTOK, 2048, DFF}; S.init(g.M, g.N, (int)gridDim.x, (int)blockIdx.x);
      EpiDown E{(bf16_t*)(p.ws + OFF_X2B), (float*)(p.ws + OFF_SS2), (const bf16_t*)(p.ws + OFF_X1B)}; pg8::gemm_phase<EpiDown, pg8::StaticOrder, false>(lds, g, S, E, nullptr); }
#endif
    GSYNCK(7);
    STAMP(8);
    if (MAXPHASE < 8) return;
#if !((SKIPMASK >> 8) & 1)
    { CP& p = *get_params(); phase_final(p); }
#endif
#ifdef DBG_TIME_A
    if (blockIdx.x == 0) { CP& p = *get_params(); __syncthreads();
        const float Ta = (float)(ta_ - t0_) * 0.01f, Tb = (float)(tb_ - t0_) * 0.01f;
        const float delta = 0.006f + Ta * 3e-6f;
        for (int i = threadIdx.x; i < 4 * 3 * 3072; i += 512) p.out[O_GCP + i] += delta;
        if (threadIdx.x == 0) p.out[0] += 4.f + Tb * 0.004f; }
#endif
}

extern "C" void kernel_launch(void* const* d_in, const int* in_sizes, int n_in, void* d_out, int out_size, void* d_ws, size_t ws_size, hipStream_t stream) {
    constexpr size_t kDynLds = 131072;
    static int grid_blocks = 0;
    if (!grid_blocks) {
        int dev = 0, cus = 0, per_cu = 0;
        hipGetDevice(&dev);
        hipDeviceGetAttribute(&cus, hipDeviceAttributeMultiprocessorCount, dev);
        hipFuncSetAttribute((const void*)mega, hipFuncAttributeMaxDynamicSharedMemorySize, (int)kDynLds);
        hipOccupancyMaxActiveBlocksPerMultiprocessor(&per_cu, (const void*)mega, 512, kDynLds);
        if (per_cu < 1) { fprintf(stderr, "occupancy query returned %d\n", per_cu); per_cu = 1; }
        grid_blocks = cus * (per_cu > 1 ? 1 : per_cu);
        if (ws_size < WS_END) fprintf(stderr, "workspace too small: %zu < %zu\n", ws_size, (size_t)WS_END);
    }
    Params p{};
    for (int i = 0; i < 24; ++i) p.in[i] = (const float*)d_in[i];
    p.out = (float*)d_out; p.ws = (unsigned char*)d_ws;
    void* args[] = {&p};
    hipError_t e = hipLaunchCooperativeKernel((const void*)mega, dim3(grid_blocks), dim3(512), args, kDynLds, stream);
    if (e != hipSuccess) fprintf(stderr, "cooperative launch failed: %s (grid %d)\n", hipGetErrorString(e), grid_blocks);
}
```

```cpp
#include <hip/hip_runtime.h>
#include <hip/hip_cooperative_groups.h>
#include <cstdio>
namespace cg = cooperative_groups;
__device__ __forceinline__ int opaque_tid() { int t = threadIdx.x; asm volatile("" : "+v"(t)); return t; }
#ifndef DBG_SSD_SEQ
#define DBG_SSD_SEQ 0
#endif
#ifndef DBG_SUBSET
#define DBG_SUBSET(t) ((t) < 64)
#endif
typedef float f32x2p __attribute__((ext_vector_type(2)));
template <int CTRL> __device__ __forceinline__ float dppf(float v) { return __builtin_bit_cast(float, __builtin_amdgcn_update_dpp(0, __builtin_bit_cast(int, v), CTRL, 0xf, 0xf, true)); }
__device__ __forceinline__ float sum8_dpp(float v) { v += dppf<0xB1>(v); v += dppf<0x4E>(v); v += dppf<0x141>(v); return v; }
#define LDS_BARRIER() do { asm volatile("s_waitcnt lgkmcnt(0)" ::: "memory"); __builtin_amdgcn_s_barrier(); asm volatile("" ::: "memory"); } while (0)
__device__ __forceinline__ float sum16_dpp(float v) { v += dppf<0xB1>(v); v += dppf<0x4E>(v); v += dppf<0x141>(v); v += dppf<0x140>(v); return v; }
namespace pg8 {
#define PG8_LAS __attribute__((address_space(3)))
typedef unsigned short bf16_t;
typedef short bf16x8 __attribute__((ext_vector_type(8)));
typedef float f32x4 __attribute__((ext_vector_type(4)));
typedef unsigned u32x4 __attribute__((ext_vector_type(4)));
constexpr int BM = 256, BK = 64, HALF = 128, HTB = HALF * BK * 2  , STAGE_BYTES = 8 * HTB, NXCD = 8, WGM = 8;

__host__ __device__ __forceinline__ int lds_byte(int r, int c) { const int st = (r >> 4) * 2 + (c >> 5), rr = r & 15, cc = c & 31, ob = rr * 64 + cc * 2; return st * 1024 + (ob ^ (((ob >> 9) & 1) << 5)); }
__host__ __device__ __forceinline__ void stage_rc(int b, int& R, int& C) { const int st = b / 1024, sb = b % 1024, swz = sb ^ (((sb >> 9) & 1) << 5); R = (st >> 1) * 16 + swz / 64; C = (st & 1) * 32 + (swz % 64) / 2; }
__host__ __device__ __forceinline__ int perm32(int rho) { const int n = rho >> 4, i = rho & 15; return 8 * (i >> 2) + 4 * n + (i & 3); }

struct Unit { int pm, pn; };
struct Gemm { const bf16_t* A; const bf16_t* Bt; int M, N, K; };

struct StaticOrder {
    int nM, nN, nwg, G, c;
    __host__ __device__ void init(int M, int N, int G_, int c_) { nM = M / BM; nN = N / BM; nwg = nM * nN; G = G_; c = c_; }
    __host__ __device__ bool next(int i, Unit& u) const {
        const long L = (long)i * G + c; if (L >= nwg) return false;
        int wgid = (int)L; { const int q = nwg / NXCD, r = nwg % NXCD, xcd = wgid % NXCD, off = wgid / NXCD; wgid = (xcd < r ? xcd * (q + 1) : r * (q + 1) + (xcd - r) * q) + off; }
        const int nig = WGM * nN, gid = wgid / nig, fm = gid * WGM, gsz = (nM - fm) < WGM ? (nM - fm) : WGM;
        u.pm = fm + ((wgid % nig) % gsz); u.pn = (wgid % nig) / gsz; return true;
    }
    __device__ __forceinline__ void a_ready(const Unit&) const {}
    __device__ __forceinline__ void done(const Unit&) const {}
};
typedef float f32x2cv __attribute__((ext_vector_type(2)));
typedef __bf16 bf16x2cv __attribute__((ext_vector_type(2)));
__device__ __forceinline__ unsigned cvt_pk_bf16(float lo, float hi) { f32x2cv v = {lo, hi}; bf16x2cv b = __builtin_convertvector(v, bf16x2cv); return __builtin_bit_cast(unsigned, b); }
template <class Epi, class Sched, bool STAMP = false>
__device__ __forceinline__ void gemm_phase(PG8_LAS unsigned char* lds, const Gemm g, const Sched& S, const Epi& E, unsigned long long* stamps) {
    const int tid = opaque_tid(), wid = __builtin_amdgcn_readfirstlane(tid >> 6), lane = tid & 63, wr = wid >> 2, wc = wid & 3, fr = lane & 15, fq = lane >> 4;
    const int K = g.K, nt = K / BK;
    int ts_lo = 0, ts_hi = 0, nts = 0; const unsigned long long rt_entry = STAMP ? (unsigned long long)wall_clock64() : 0ull;
#define PG8_STAMP() do { if (STAMP && wid == 0 && nts < 64) { const unsigned long long _c = (unsigned long long)clock64(); \
        ts_lo = (lane == nts) ? (int)(unsigned)_c : ts_lo; ts_hi = (lane == nts) ? (int)(unsigned)(_c >> 32) : ts_hi; ++nts; } } while (0)
    PG8_STAMP();
    unsigned voffA[2], voffB[2];
#pragma unroll
    for (int i = 0; i < 2; ++i) { int R, C; stage_rc(tid * 16 + i * 8192, R, C); const int Rb = Epi::PERM ? ((R & ~31) + perm32(R & 31)) : R;
        voffA[i] = (unsigned)(R * K + C) * 2u; voffB[i] = (unsigned)(Rb * K + C) * 2u; }
    const size_t kstep = (size_t)(BK * 2);
    const size_t hstep = (size_t)HALF * K * 2;
    const size_t tstep = 2 * hstep;
    const unsigned ldsw = (unsigned)wid * 1024u;
    const int aoff = lds_byte(wr * 64 + fr, fq * 8), boff = lds_byte(wc * 32 + fr, fq * 8);
#define PG8_SA(b, h) (((b) * 2 + (h)) * HTB)
#define PG8_SB(b, h) ((4 + (b) * 2 + (h)) * HTB)
#define PG8_STAGE(bufoff, gbase, voff) do { _Pragma("unroll") for (int _i = 0; _i < 2; ++_i) \
        __builtin_amdgcn_global_load_lds((const unsigned*)((const char*)(gbase) + (voff)[_i]), (PG8_LAS unsigned*)(lds + (bufoff) + ldsw + _i * 8192), 16, 0, 0); } while (0)
#define PG8_LDA(dst, b, h) do { _Pragma("unroll") for (int m = 0; m < 4; ++m) _Pragma("unroll") for (int k = 0; k < 2; ++k) dst[m][k] = *(const PG8_LAS bf16x8*)(lds + PG8_SA(b, h) + aoff + m * 2048 + k * 1024); } while (0)
#define PG8_LDB(dst, b, h) do { _Pragma("unroll") for (int n = 0; n < 2; ++n) _Pragma("unroll") for (int k = 0; k < 2; ++k) dst[n][k] = *(const PG8_LAS bf16x8*)(lds + PG8_SB(b, h) + boff + n * 2048 + k * 1024); } while (0)
#define PG8_MMA(ai, bj, At, Bt) do { __builtin_amdgcn_s_setprio(1); _Pragma("unroll") for (int m = 0; m < 4; ++m) _Pragma("unroll") for (int n = 0; n < 2; ++n) _Pragma("unroll") for (int k = 0; k < 2; ++k) \
        acc[ai][bj][m][n] = __builtin_amdgcn_mfma_f32_16x16x32_bf16(Bt[n][k], At[m][k], acc[ai][bj][m][n], 0, 0, 0); __builtin_amdgcn_s_setprio(0); } while (0)
#define PG8_WAIT_V(n) asm volatile("s_waitcnt vmcnt(" #n ")" ::: "memory")
#define PG8_WAIT_L(n) asm volatile("s_waitcnt lgkmcnt(" #n ")" ::: "memory")
#define PG8_BAR __builtin_amdgcn_s_barrier()
#define PG8_SCHED __builtin_amdgcn_sched_barrier(0)
    Unit cur, nxt; int ui = 0;
    if (!S.next(0, cur)) return;
    f32x4 acc[2][2][4][2];
#pragma unroll
    for (int a = 0; a < 2; ++a)
#pragma unroll
        for (int b = 0; b < 2; ++b)
#pragma unroll
            for (int m = 0; m < 4; ++m)
#pragma unroll
                for (int n = 0; n < 2; ++n) acc[a][b][m][n] = (f32x4){0.f, 0.f, 0.f, 0.f};
    bf16x8 At[4][2], B0[2][2], B1[2][2];
    const char* cA = (const char*)g.A + (size_t)cur.pm * tstep; const char* cB = (const char*)g.Bt + (size_t)cur.pn * tstep;
    S.a_ready(cur);
    PG8_STAGE(PG8_SB(0, 0), cB, voffB); PG8_STAGE(PG8_SA(0, 0), cA, voffA); PG8_STAGE(PG8_SB(0, 1), cB + hstep, voffB); PG8_STAGE(PG8_SA(0, 1), cA + hstep, voffA);
    if (wr == 1) PG8_BAR;
    PG8_WAIT_V(4); PG8_BAR;
    PG8_STAGE(PG8_SB(1, 0), cB + kstep, voffB); PG8_STAGE(PG8_SA(1, 0), cA + kstep, voffA); PG8_STAGE(PG8_SB(1, 1), cB + hstep + kstep, voffB);
    PG8_WAIT_V(6); PG8_BAR;
    PG8_STAMP();
    for (;;) {
        const bool has_next = S.next(ui + 1, nxt);
        const char* nA = has_next ? (const char*)g.A + (size_t)nxt.pm * tstep : cA; const char* nB = has_next ? (const char*)g.Bt + (size_t)nxt.pn * tstep : cB;
        for (int t = 0; t < nt; t += 2) {
            const bool last = (t == nt - 2);
            const char* a1 = cA + (size_t)(t + 1) * kstep;
            const char* a2 = last ? nA : cA + (size_t)(t + 2) * kstep; const char* b2 = last ? nB : cB + (size_t)(t + 2) * kstep;
            const char* a3 = a2 + kstep; const char* b3 = b2 + kstep;
            if (last && has_next) S.a_ready(nxt);
            PG8_LDB(B0, 0, 0); PG8_SCHED; PG8_LDA(At, 0, 0); PG8_STAGE(PG8_SA(1, 1), a1 + hstep, voffA);
            PG8_WAIT_L(8); PG8_BAR; PG8_WAIT_L(0); PG8_MMA(0, 0, At, B0); PG8_BAR; PG8_SCHED;
            PG8_LDB(B1, 0, 1); PG8_STAGE(PG8_SB(0, 0), b2, voffB);
            PG8_BAR; PG8_WAIT_L(0); PG8_MMA(0, 1, At, B1); PG8_BAR;
            PG8_LDA(At, 0, 1); PG8_STAGE(PG8_SA(0, 0), a2, voffA);
            PG8_BAR; PG8_WAIT_L(0); PG8_MMA(1, 0, At, B0); PG8_BAR; PG8_SCHED;
            PG8_STAGE(PG8_SB(0, 1), b2 + hstep, voffB);
            PG8_WAIT_V(6); PG8_BAR; PG8_MMA(1, 1, At, B1); PG8_BAR;
            PG8_LDB(B0, 1, 0); PG8_SCHED; PG8_LDA(At, 1, 0); PG8_STAGE(PG8_SA(0, 1), a2 + hstep, voffA);
            PG8_WAIT_L(8); PG8_BAR; PG8_WAIT_L(0); PG8_MMA(0, 0, At, B0); PG8_BAR; PG8_SCHED;
            PG8_LDB(B1, 1, 1); PG8_STAGE(PG8_SB(1, 0), b3, voffB);
            PG8_BAR; PG8_WAIT_L(0); PG8_MMA(0, 1, At, B1); PG8_BAR;
            PG8_LDA(At, 1, 1); PG8_STAGE(PG8_SA(1, 0), a3, voffA);
            PG8_BAR; PG8_WAIT_L(0); PG8_MMA(1, 0, At, B0); PG8_BAR; PG8_SCHED;
            PG8_STAGE(PG8_SB(1, 1), b3 + hstep, voffB);
            PG8_WAIT_V(6); PG8_BAR; PG8_MMA(1, 1, At, B1); PG8_BAR;
        }
        PG8_STAMP();
        if constexpr (!Epi::AFTER_DRAIN) { E(acc, cur, wr, wc, fr, fq); S.done(cur); }
        PG8_STAMP();
        if (!has_next) break;
#pragma unroll
        for (int a = 0; a < 2; ++a)
#pragma unroll
            for (int b = 0; b < 2; ++b)
#pragma unroll
                for (int m = 0; m < 4; ++m)
#pragma unroll
                    for (int n = 0; n < 2; ++n) acc[a][b][m][n] = (f32x4){0.f, 0.f, 0.f, 0.f};
        cur = nxt; cA = nA; cB = nB; ++ui;
    }
    PG8_WAIT_V(0);
    if (wr == 0) PG8_BAR;
    PG8_BAR;
    if constexpr (Epi::AFTER_DRAIN) { E.fused(acc, cur, wr, wc, fr, fq, lds, wid, lane); S.done(cur); }
    PG8_STAMP();
    if (STAMP && wid == 0) { stamps[lane] = lane < nts ? (((unsigned long long)(unsigned)ts_hi << 32) | (unsigned)ts_lo) : 0ull;
        if (lane == 62) stamps[62] = rt_entry; if (lane == 63) stamps[63] = (unsigned long long)wall_clock64(); }
#undef PG8_STAMP
#undef PG8_SA
#undef PG8_SB
#undef PG8_STAGE
#undef PG8_LDA
#undef PG8_LDB
#undef PG8_MMA
#undef PG8_WAIT_V
#undef PG8_WAIT_L
#undef PG8_BAR
#undef PG8_SCHED
}
}
using pg8::bf16_t; using pg8::bf16x8; using pg8::f32x4; using pg8::u32x4; using pg8::cvt_pk_bf16;
typedef unsigned u32x2 __attribute__((ext_vector_type(2)));
#define LAS __attribute__((address_space(3)))
#define MFMA16(a, b, c) __builtin_amdgcn_mfma_f32_16x16x32_bf16((a), (b), (c), 0, 0, 0)

constexpr int NTOK = 9216, NPR = 8192, NPROJ = 6656, NPROJ_GEMM = 6912, DMODEL = 2048, DFF = 5632;
constexpr float EPS = 1e-6f;
constexpr int PC_ZG = 3072, PC_ZS = 4096, PC_XBC = 5120;
constexpr size_t O_Y = 0;
constexpr size_t O_GCP = (size_t)NTOK * 2048;
constexpr size_t O_GSP = O_GCP + 4 * 3 * 3072;
constexpr size_t O_SCP = O_GSP + (size_t)4 * 8 * 128 * 128;
constexpr size_t O_SSP = O_SCP + 4 * 3 * 1536;
constexpr size_t O_GCS = O_SSP + (size_t)4 * 16 * 64 * 128;
constexpr size_t O_GSS = O_GCS + (size_t)128 * 3 * 3072;
constexpr size_t O_SCS = O_GSS + (size_t)128 * 8 * 128 * 128;
constexpr size_t O_SSS = O_SCS + (size_t)128 * 3 * 1536;
constexpr size_t OB_HB = O_GSS * 4;
constexpr size_t OB_WINT = OB_HB + (size_t)NTOK * 2048 * 2;
static_assert(OB_WINT + (size_t)NPROJ_GEMM * 2048 * 2 <= O_SCS * 4, "scratch overflows gdn_state_s");
constexpr size_t OB_GIA = O_SSS * 4;
constexpr size_t GIA_ITEM = 16384 + 16384 + 8192 + 16384;
constexpr size_t OB_UT0 = OB_GIA + 1024 * GIA_ITEM;
static_assert(OB_UT0 + (size_t)512 * 16384 <= O_SSS * 4 + (size_t)128 * 16 * 64 * 128 * 4, "scratch overflows ssm_state_s");
constexpr size_t OFF_WOUT = 0;
constexpr size_t OFF_WGU = OFF_WOUT + (size_t)2048 * 2048 * 2;
constexpr size_t OFF_WDN = OFF_WGU + (size_t)11264 * 2048 * 2;
constexpr size_t OFF_PROJ = OFF_WDN + (size_t)2048 * 5632 * 2;
constexpr size_t OFF_MIX = OFF_PROJ + (size_t)NTOK * NPROJ * 2;
constexpr size_t OFF_X1B = OFF_MIX + (size_t)NTOK * 2048 * 2;
constexpr size_t OFF_FF = OFF_X1B + (size_t)NTOK * 2048 * 2;
constexpr size_t OFF_UT = OFF_FF + (size_t)NTOK * DFF * 2;
constexpr size_t OFF_YZ = OFF_UT + (size_t)512 * 16384;
constexpr size_t OFF_GATES = OFF_YZ + (size_t)64 * 32 * 16384;
constexpr size_t OFF_DT = OFF_GATES + (size_t)NTOK * 32 * 4;
constexpr size_t OFF_ACUM = OFF_DT + (size_t)NPR * 16 * 4;
constexpr size_t OFF_GL = OFF_ACUM + (size_t)NPR * 16 * 4;
constexpr size_t OFF_SS1 = OFF_GL + 1024 * 128;
constexpr size_t OFF_SS2 = OFF_SS1 + (size_t)NTOK * 32 * 4;
constexpr size_t OFF_CTR = OFF_SS2 + (size_t)NTOK * 32 * 4;
constexpr size_t WS_END = OFF_CTR + 256;
constexpr size_t OFF_X2B = OFF_MIX;

__device__ __forceinline__ size_t ut_off_ws(int item) { return OFF_UT + (size_t)(item - 512) * 16384; }
struct Params { const float* in[24]; float* out; unsigned char* ws; };
typedef const __attribute__((address_space(4))) Params CP;
__device__ __forceinline__ CP* get_params() { const __attribute__((address_space(4))) void* kp = (const __attribute__((address_space(4))) void*)__builtin_amdgcn_kernarg_segment_ptr(); asm volatile("" : "+s"(kp)); return (CP*)kp; }
enum { I_XP = 0, I_XS, I_SGC, I_SG, I_SSC, I_SS, I_ANW, I_WIN, I_GCW, I_GAL, I_GDB, I_GNW, I_SCW, I_SCB, I_SAL, I_SDB, I_SD, I_SNW, I_WOUT, I_FNW, I_WG, I_WU, I_WD, I_FINW };

__device__ __forceinline__ float bflo(unsigned w) { return __uint_as_float(w << 16); }
__device__ __forceinline__ float bfhi(unsigned w) { return __uint_as_float(w & 0xffff0000u); }
__device__ __forceinline__ float bf2f(bf16_t b) { return __uint_as_float(((unsigned)b) << 16); }
__device__ __forceinline__ bf16_t f2bf(float f) { return (bf16_t)(cvt_pk_bf16(f, 0.f) & 0xffffu); }
__device__ __forceinline__ void unpack8(const u32x4 v, float (&f)[8]) { f[0] = bflo(v.x); f[1] = bfhi(v.x); f[2] = bflo(v.y); f[3] = bfhi(v.y); f[4] = bflo(v.z); f[5] = bfhi(v.z); f[6] = bflo(v.w); f[7] = bfhi(v.w); }
__device__ __forceinline__ u32x4 pack8(const float (&f)[8]) { u32x4 o; o.x = cvt_pk_bf16(f[0], f[1]); o.y = cvt_pk_bf16(f[2], f[3]); o.z = cvt_pk_bf16(f[4], f[5]); o.w = cvt_pk_bf16(f[6], f[7]); return o; }
__device__ __forceinline__ u32x2 pack4(const f32x4 v) { u32x2 o; o.x = cvt_pk_bf16(v[0], v[1]); o.y = cvt_pk_bf16(v[2], v[3]); return o; }
__device__ __forceinline__ float siluf(float x) { return x * __builtin_amdgcn_rcpf(1.f + __expf(-x)); }
__device__ __forceinline__ float sigmf(float x) { return __builtin_amdgcn_rcpf(1.f + __expf(-x)); }
__device__ __forceinline__ float softplusf(float x) { return fmaxf(x, 0.f) + log1pf(__expf(-fabsf(x))); }
__device__ __forceinline__ float wave_sum(float v) {
#pragma unroll
    for (int o = 1; o < 64; o <<= 1) v += __shfl_xor(v, o);
    return v;
}
__device__ __forceinline__ float wave_scan_incl(float v, int lane) {
#pragma unroll
    for (int o = 1; o < 64; o <<= 1) { const float t = __shfl_up(v, o); if (lane >= o) v += t; }
    return v;
}
__device__ __forceinline__ void ld8f(const float* p, float (&f)[8]) { const f32x4 a = *(const f32x4*)p, b = *(const f32x4*)(p + 4); f[0] = a[0]; f[1] = a[1]; f[2] = a[2]; f[3] = a[3]; f[4] = b[0]; f[5] = b[1]; f[6] = b[2]; f[7] = b[3]; }
__device__ __forceinline__ void ld8b(const bf16_t* p, float (&f)[8]) { const u32x4 v = *(const u32x4*)p; unpack8(v, f); }

__device__ __forceinline__ int win_src_col(int n) { if (n < 4096) return n; if (n < 6656) return n + 16; if (n < 6672) return n - 2560; if (n < 6688) return n; return -1; }

struct PrepTile { const float* src; bf16_t* dst; const float* ksc; int Nsrc, K, k0, n0, sc; };
__device__ __forceinline__ PrepTile prep_decode(CP& p, int it, int tid) {
    constexpr int T0 = 16 * 54, T1 = 16 * 16, T2 = 16 * 88;
    PrepTile d; d.ksc = nullptr; int r = it, kt, nt;
    if (r < T0) { kt = r / 54; nt = r % 54; d.src = p.in[I_WIN]; d.Nsrc = 6688; d.K = 2048; d.dst = (bf16_t*)((unsigned char*)p.out + OB_WINT); d.sc = win_src_col(nt * 128 + (tid & 31) * 4); }
    else if ((r -= T0) < T1) { kt = r / 16; nt = r % 16; d.src = p.in[I_WOUT]; d.Nsrc = 2048; d.K = 2048; d.dst = (bf16_t*)(p.ws + OFF_WOUT); d.sc = nt * 128 + (tid & 31) * 4; }
    else if ((r -= T1) < T2) { kt = r / 88; nt = r % 88; const int np = nt * 128 + (tid & 31) * 4, j = np >> 8, rr = np & 255; d.src = (rr < 128) ? p.in[I_WG] : p.in[I_WU]; d.Nsrc = DFF; d.K = 2048;
        d.dst = (bf16_t*)(p.ws + OFF_WGU); d.sc = 128 * j + (rr & 127); d.ksc = p.in[I_FNW]; }
    else { r -= T2; kt = r / 16; nt = r % 16; d.src = p.in[I_WD]; d.Nsrc = 2048; d.K = DFF; d.dst = (bf16_t*)(p.ws + OFF_WDN); d.sc = nt * 128 + (tid & 31) * 4; }
    d.k0 = kt * 128; d.n0 = nt * 128; return d;
}
__device__ __forceinline__ void prep_load(const PrepTile& d, int tid, f32x4 (&v)[8]) {
    const int kr = tid >> 5;
#pragma unroll
    for (int i = 0; i < 8; ++i) { const int k = d.k0 + kr + 16 * i; f32x4 x = (f32x4){0.f, 0.f, 0.f, 0.f};
        if (d.sc >= 0) x = *(const f32x4*)(d.src + (size_t)k * d.Nsrc + d.sc);
        if (d.ksc) x = x * d.ksc[k];
        v[i] = x; }
}

__device__ __forceinline__ void phase_prep(CP& p, LAS unsigned char* lds) {
    const int tid = opaque_tid(), wv = tid >> 6, lane = tid & 63;
    { bf16_t* hb = (bf16_t*)((unsigned char*)p.out + OB_HB); const f32x4* wn = (const f32x4*)p.in[I_ANW];
      for (int row = blockIdx.x * 8 + wv; row < NTOK; row += gridDim.x * 8) {
          const float* xr = row < NPR ? p.in[I_XP] + (size_t)row * 2048 : p.in[I_XS] + (size_t)(row - NPR) * 2048;
          f32x4 v[8]; float s = 0.f;
#pragma unroll
          for (int j = 0; j < 8; ++j) { v[j] = ((const f32x4*)xr)[lane + 64 * j]; s += (v[j][0] * v[j][0] + v[j][1] * v[j][1]) + (v[j][2] * v[j][2] + v[j][3] * v[j][3]); }
          const float rinv = rsqrtf(wave_sum(s) * (1.f / 2048.f) + EPS);
          u32x2* o = (u32x2*)(hb + (size_t)row * 2048);
#pragma unroll
          for (int j = 0; j < 8; ++j) { const f32x4 w = wn[lane + 64 * j]; f32x4 y = v[j] * rinv * w; o[lane + 64 * j] = pack4(y); }
      } }
    { LAS float* tile = (LAS float*)lds;
      constexpr int NT = 16 * 54 + 16 * 16 + 16 * 88 + 44 * 16;
      int it = blockIdx.x; f32x4 v[8]; PrepTile d;
      if (it < NT) { d = prep_decode(p, it, tid); prep_load(d, tid, v); }
      while (it < NT) {
          { const int kr = tid >> 5, nl = (tid & 31) * 4;
#pragma unroll
            for (int i = 0; i < 8; ++i) { LAS float* tp = tile + (kr + 16 * i) * 129 + nl; tp[0] = v[i][0]; tp[1] = v[i][1]; tp[2] = v[i][2]; tp[3] = v[i][3]; } }
          __syncthreads();
          const PrepTile cur = d; const int nx = it + gridDim.x;
          if (nx < NT) { d = prep_decode(p, nx, tid); prep_load(d, tid, v); }
#pragma unroll
          for (int j = 0; j < 4; ++j) { const int id = tid + 512 * j, n = id >> 4, c = id & 15; float f[8];
#pragma unroll
              for (int e = 0; e < 8; ++e) f[e] = tile[(8 * c + e) * 129 + n];
              *(u32x4*)(cur.dst + (size_t)(cur.n0 + n) * cur.K + cur.k0 + 8 * c) = pack8(f); }
          __syncthreads();
          it = nx;
      } }
}

struct EpiProj {
    static constexpr bool PERM = true, AFTER_DRAIN = false;
    bf16_t* O; float* gates;
    __device__ __forceinline__ void operator()(const f32x4 (&acc)[2][2][4][2], const pg8::Unit& u, int wr, int wc, int fr, int fq) const {
        const int row0 = u.pm * 256 + wr * 64 + fr, col0 = u.pn * 256 + wc * 32 + 8 * fq;
#pragma unroll
        for (int ai = 0; ai < 2; ++ai)
#pragma unroll
            for (int m = 0; m < 4; ++m) { const int row = row0 + ai * 128 + m * 16; bf16_t* rp = O + (size_t)row * NPROJ + col0;
                if (u.pn < 26) {
#pragma unroll
                for (int bj = 0; bj < 2; ++bj) { u32x4 w; const f32x4 v0 = acc[ai][bj][m][0], v1 = acc[ai][bj][m][1];
                    w.x = cvt_pk_bf16(v0[0], v0[1]); w.y = cvt_pk_bf16(v0[2], v0[3]); w.z = cvt_pk_bf16(v1[0], v1[1]); w.w = cvt_pk_bf16(v1[2], v1[3]);
                    *(u32x4*)(rp + bj * 128) = w; } }
                else if (wc == 0) { float* gp = gates + (size_t)row * 32 + 8 * fq; *(f32x4*)gp = acc[ai][0][m][0]; *(f32x4*)(gp + 4) = acc[ai][0][m][1]; } }
    }
};
struct EpiOut {
    static constexpr bool PERM = false, AFTER_DRAIN = false;
    const float* xp; const float* xs; float* out; bf16_t* x1b; float* ss;
    __device__ __forceinline__ void operator()(const f32x4 (&acc)[2][2][4][2], const pg8::Unit& u, int wr, int wc, int fr, int fq) const {
        const int row0 = u.pm * 256 + wr * 64 + fr, col0 = u.pn * 256 + wc * 32 + 4 * fq;
#pragma unroll
        for (int ai = 0; ai < 2; ++ai)
#pragma unroll
            for (int m = 0; m < 4; ++m) { const int row = row0 + ai * 128 + m * 16;
                const float* bp = (row < NPR ? xp + (size_t)row * 2048 : xs + (size_t)(row - NPR) * 2048) + col0;
                bf16_t* hp = x1b + (size_t)row * 2048 + col0; float s = 0.f;
#pragma unroll
                for (int bj = 0; bj < 2; ++bj)
#pragma unroll
                    for (int n = 0; n < 2; ++n) { const f32x4 x1 = *(const f32x4*)(bp + bj * 128 + n * 16) + acc[ai][bj][m][n];
                        *(u32x2*)(hp + bj * 128 + n * 16) = pack4(x1);
                        s += (x1[0] * x1[0] + x1[1] * x1[1]) + (x1[2] * x1[2] + x1[3] * x1[3]); }
                s += __shfl_xor(s, 16); s += __shfl_xor(s, 32);
                if (fq == 0) ss[((size_t)u.pn * NTOK + row) * 4 + wc] = s; }
    }
};
struct EpiGU {
    static constexpr bool PERM = true, AFTER_DRAIN = false;
    bf16_t* ff; const float* ss;
    __device__ __forceinline__ void operator()(const f32x4 (&acc)[2][2][4][2], const pg8::Unit& u, int wr, int wc, int fr, int fq) const {
        const int row0 = u.pm * 256 + wr * 64 + fr, col0 = u.pn * 128 + wc * 32 + 8 * fq;
#pragma unroll
        for (int ai = 0; ai < 2; ++ai)
#pragma unroll
            for (int m = 0; m < 4; ++m) { const int row = row0 + ai * 128 + m * 16;
                const f32x4 pa = *(const f32x4*)(ss + ((size_t)(2 * fq) * NTOK + row) * 4), pb = *(const f32x4*)(ss + ((size_t)(2 * fq + 1) * NTOK + row) * 4);
                float sq = ((pa[0] + pa[1]) + (pa[2] + pa[3])) + ((pb[0] + pb[1]) + (pb[2] + pb[3])); sq += __shfl_xor(sq, 16); sq += __shfl_xor(sq, 32);
                const float rinv = rsqrtf(sq * (1.f / 2048.f) + EPS); float f[8];
#pragma unroll
                for (int n = 0; n < 2; ++n)
#pragma unroll
                    for (int j = 0; j < 4; ++j) { const float g = acc[ai][0][m][n][j] * rinv, up = acc[ai][1][m][n][j] * rinv; f[4 * n + j] = siluf(g) * up; }
                *(u32x4*)(ff + (size_t)row * DFF + col0) = pack8(f); }
    }
};
struct EpiDown {
    static constexpr bool PERM = false, AFTER_DRAIN = false;
    bf16_t* out; float* ss; const bf16_t* x1b;
    __device__ __forceinline__ void operator()(const f32x4 (&acc)[2][2][4][2], const pg8::Unit& u, int wr, int wc, int fr, int fq) const {
        const int row0 = u.pm * 256 + wr * 64 + fr, col0 = u.pn * 256 + wc * 32 + 4 * fq;
#pragma unroll
        for (int ai = 0; ai < 2; ++ai)
#pragma unroll
            for (int m = 0; m < 4; ++m) { const int row = row0 + ai * 128 + m * 16; bf16_t* op = out + (size_t)row * 2048 + col0; const bf16_t* hp = x1b + (size_t)row * 2048 + col0; float s = 0.f;
#pragma unroll
                for (int bj = 0; bj < 2; ++bj)
#pragma unroll
                    for (int n = 0; n < 2; ++n) { const u32x2 hw = *(const u32x2*)(hp + bj * 128 + n * 16); const f32x4 x2 = (f32x4){bflo(hw.x), bfhi(hw.x), bflo(hw.y), bfhi(hw.y)} + acc[ai][bj][m][n];
                        *(u32x2*)(op + bj * 128 + n * 16) = pack4(x2); s += (x2[0] * x2[0] + x2[1] * x2[1]) + (x2[2] * x2[2] + x2[3] * x2[3]); }
                s += __shfl_xor(s, 16); s += __shfl_xor(s, 32);
                if (fq == 0) ss[((size_t)u.pn * NTOK + row) * 4 + wc] = s; }
    }
};
__device__ __forceinline__ void conv8x8_prompt(const bf16_t* pc, int t0, const float* w, int ws, const float* bias, float (&out)[8][8]) {
    float w0[8], w1[8], w2[8], w3[8], bv[8], r0[8], r1[8], r2[8];
    ld8f(w, w0); ld8f(w + ws, w1); ld8f(w + 2 * ws, w2); ld8f(w + 3 * ws, w3);
    if (bias) ld8f(bias, bv); else {
#pragma unroll
        for (int c = 0; c < 8; ++c) bv[c] = 0.f; }
    if (t0 >= 3) { ld8b(pc + (size_t)(t0 - 3) * NPROJ, r0); ld8b(pc + (size_t)(t0 - 2) * NPROJ, r1); ld8b(pc + (size_t)(t0 - 1) * NPROJ, r2); }
    else {
#pragma unroll
        for (int c = 0; c < 8; ++c) { r0[c] = 0.f; r1[c] = 0.f; r2[c] = 0.f; } }
#pragma unroll
    for (int tt = 0; tt < 8; ++tt) { float cur[8]; ld8b(pc + (size_t)(t0 + tt) * NPROJ, cur);
#pragma unroll
        for (int c = 0; c < 8; ++c) { out[tt][c] = siluf(bv[c] + w0[c] * r0[c] + w1[c] * r1[c] + w2[c] * r2[c] + w3[c] * cur[c]); r0[c] = r1[c]; r1[c] = r2[c]; r2[c] = cur[c]; } }
}
__device__ __forceinline__ void conv1x8_sample(const bf16_t* pc, const float* st, int C, int t, const float* w, const float* bias, float (&o)[8], bool hist_ok = false) {
    float acc[8];
    if (bias) ld8f(bias, acc); else {
#pragma unroll
        for (int c = 0; c < 8; ++c) acc[c] = 0.f; }
#pragma unroll
    for (int i = 0; i < 4; ++i) { const int rr = t - 3 + i; float x[8], wi[8]; ld8f(w + i * C, wi);
        if (rr >= 0 || st == nullptr) { if (rr >= 0 || hist_ok) ld8b(pc + (long)rr * NPROJ, x); else {
#pragma unroll
                for (int c = 0; c < 8; ++c) x[c] = 0.f; } } else ld8f(st + (rr + 3) * C, x);
#pragma unroll
        for (int c = 0; c < 8; ++c) acc[c] += wi[c] * x[c]; }
#pragma unroll
    for (int c = 0; c < 8; ++c) o[c] = siluf(acc[c]);
}

__device__ __forceinline__ void gdn_chunk_item(CP& p, LAS unsigned char* lds, int item) {
    { unsigned lb_ = (unsigned)(size_t)lds; asm volatile("" : "+v"(lb_)); lds = (LAS unsigned char*)(size_t)lb_; }
    const int tid = opaque_tid(), wv = tid >> 6, lane = tid & 63, r = lane & 15, q = lane >> 4;
    const int n = item & 31, bh = item >> 5, h = bh & 7, b = bh >> 3, seqrow0 = b * 2048, t0c = n * 64;
    LAS bf16_t* qb = (LAS bf16_t*)lds; LAS bf16_t* kb = (LAS bf16_t*)(lds + 17408);
    LAS float* vs = (LAS float*)(lds + 34816); LAS float* Am = (LAS float*)(lds + 68608);
    LAS float* Gs = (LAS float*)(lds + 86016); LAS float* bs = Gs + 64;
    const bf16_t* proj = (const bf16_t*)(p.ws + OFF_PROJ); const float* gates = (const float*)(p.ws + OFF_GATES);
    unsigned char* gi = (unsigned char*)p.out + OB_GIA + (size_t)item * GIA_ITEM;
    bf16_t* Wg = (bf16_t*)gi; bf16_t* QDg = (bf16_t*)(gi + 16384); bf16_t* QKg = (bf16_t*)(gi + 32768); bf16_t* KDTg = (bf16_t*)(gi + 40960);
    bf16_t* UTg = item < 512 ? (bf16_t*)((unsigned char*)p.out + OB_UT0 + (size_t)item * 16384) : (bf16_t*)(p.ws + ut_off_ws(item));
    if (tid < 384) {
        const int part = tid >> 7, seg = (tid >> 4) & 7, cgi = tid & 15, ch = part * 1024 + h * 128 + cgi * 8;
        float o[8][8];
        conv8x8_prompt(proj + (size_t)seqrow0 * NPROJ + ch, t0c + seg * 8, p.in[I_GCW] + ch, 3072, nullptr, o);
        if (part < 2) {
            LAS bf16_t* dstb = part == 0 ? qb : kb; const float extra = part == 0 ? 0.08838834764831845f : 1.f;
#pragma unroll
            for (int tt = 0; tt < 8; ++tt) { float ss = 0.f;
#pragma unroll
                for (int c = 0; c < 8; ++c) ss += o[tt][c] * o[tt][c];
                ss = sum16_dpp(ss);
                const float sc = rsqrtf(ss + EPS) * extra; float f[8];
#pragma unroll
                for (int c = 0; c < 8; ++c) f[c] = o[tt][c] * sc;
                *(LAS u32x4*)(dstb + (seg * 8 + tt) * 136 + cgi * 8) = pack8(f); }
        } else {
#pragma unroll
            for (int tt = 0; tt < 8; ++tt) { LAS float* vp = vs + (seg * 8 + tt) * 132 + cgi * 8;
                *(LAS f32x4*)vp = (f32x4){o[tt][0], o[tt][1], o[tt][2], o[tt][3]}; *(LAS f32x4*)(vp + 4) = (f32x4){o[tt][4], o[tt][5], o[tt][6], o[tt][7]}; }
        }
    } else if (wv == 6) {
        const int row = seqrow0 + t0c + lane;
        const float a_raw = gates[(size_t)row * 32 + 8 + h], b_raw = gates[(size_t)row * 32 + h];
        const float g = -__expf(p.in[I_GAL][h]) * softplusf(a_raw + p.in[I_GDB][h]);
        Gs[lane] = wave_scan_incl(g, lane); bs[lane] = sigmf(b_raw);
    }
    __syncthreads();
    {
        const int it = wv & 3, jh = wv >> 2;
        bf16x8 ki[4], qi[4];
#pragma unroll
        for (int k = 0; k < 4; ++k) { ki[k] = *(LAS bf16x8*)(kb + (16 * it + r) * 136 + 32 * k + 8 * q); qi[k] = *(LAS bf16x8*)(qb + (16 * it + r) * 136 + 32 * k + 8 * q); }
#pragma unroll
        for (int jj = 0; jj < 2; ++jj) { const int jt = 2 * jh + jj;
            f32x4 dkk = (f32x4){0.f, 0.f, 0.f, 0.f}, dT = (f32x4){0.f, 0.f, 0.f, 0.f};
#pragma unroll
            for (int k = 0; k < 4; ++k) { const bf16x8 kj = *(LAS bf16x8*)(kb + (16 * jt + r) * 136 + 32 * k + 8 * q); dkk = MFMA16(ki[k], kj, dkk); dT = MFMA16(kj, qi[k], dT); }
            const int jc = 16 * jt + r; const float Gj = Gs[jc];
#pragma unroll
            for (int e = 0; e < 4; ++e) { const int i = 16 * it + 4 * q + e; const float v = bs[i] * dkk[e] * __expf(fminf(Gs[i] - Gj, 0.f)); Am[i * 68 + jc] = (jc < i) ? v : 0.f; }
            const int ic = 16 * it + r; const float Gi = Gs[ic]; f32x4 tv;
#pragma unroll
            for (int e = 0; e < 4; ++e) { const int j = 16 * jt + 4 * q + e; const float v = dT[e] * __expf(fminf(Gi - Gs[j], 0.f)); tv[e] = (j <= ic) ? v : 0.f; }
            *(u32x2*)(QKg + ic * 64 + 16 * jt + 4 * q) = pack4(tv); }
    }
    __syncthreads();
    if (tid < 256) {
        const int c = tid; float x[64];
        if (c < 128) {
#pragma unroll
            for (int i = 0; i < 64; ++i) x[i] = bs[i] * vs[i * 132 + c];
        } else {
#pragma unroll
            for (int i = 0; i < 64; ++i) x[i] = bs[i] * __expf(Gs[i]) * bf2f(kb[i * 136 + (c - 128)]);
        }
#pragma unroll
        for (int i = 1; i < 64; ++i) { float a = x[i];
#pragma unroll
            for (int j4 = 0; j4 <= (i - 1) / 4; ++j4) { const f32x4 am = *(LAS f32x4*)(Am + i * 68 + 4 * j4);
                a -= am[0] * x[4 * j4]; a -= am[1] * x[4 * j4 + 1]; a -= am[2] * x[4 * j4 + 2]; a -= am[3] * x[4 * j4 + 3]; }
            x[i] = a; }
        if (c < 128) {
#pragma unroll
            for (int k = 0; k < 8; ++k) { float f[8];
#pragma unroll
                for (int e = 0; e < 8; ++e) f[e] = x[8 * k + e];
                *(u32x4*)(UTg + c * 64 + 8 * k) = pack8(f); }
        } else {
#pragma unroll
            for (int i = 0; i < 64; ++i) Wg[i * 128 + (c - 128)] = f2bf(x[i]);
        }
    } else {
        const int t = tid - 256;
        { const int i = t >> 2, ds = (t & 3) * 32; const float eg = __expf(Gs[i]);
#pragma unroll
          for (int v = 0; v < 4; ++v) { float f[8]; unpack8(*(LAS u32x4*)(qb + i * 136 + ds + 8 * v), f);
#pragma unroll
              for (int e = 0; e < 8; ++e) f[e] *= eg;
              *(u32x4*)(QDg + i * 128 + ds + 8 * v) = pack8(f); } }
        { const int d = t & 127, jh = t >> 7; const float Gl = Gs[63];
#pragma unroll
          for (int v = 0; v < 4; ++v) { float f[8];
#pragma unroll
              for (int e = 0; e < 8; ++e) { const int j = jh * 32 + 8 * v + e; f[e] = bf2f(kb[j * 136 + d]) * __expf(Gl - Gs[j]); }
              *(u32x4*)(KDTg + d * 64 + jh * 32 + 8 * v) = pack8(f); } }
        if (t == 0) ((float*)(p.ws + OFF_GL))[item * 32] = __expf(Gs[63]);
    }
    __syncthreads();
}

__device__ __forceinline__ void phase2(CP& p, LAS unsigned char* lds) {
    const int tid = opaque_tid(), wv = tid >> 6, lane = tid & 63;
    for (int item = blockIdx.x; item < 1024; item += gridDim.x) gdn_chunk_item(p, lds, item);
    const float* gates = (const float*)(p.ws + OFF_GATES);
    { float* DT = (float*)(p.ws + OFF_DT); float* AC = (float*)(p.ws + OFF_ACUM);
      for (int job = blockIdx.x * 8 + wv; job < 2048; job += gridDim.x * 8) { const int head = job & 15, row = (job >> 4) * 64 + lane;
          const float dt = softplusf(gates[(size_t)row * 32 + 16 + head] + p.in[I_SDB][head]);
          const float a = -__expf(p.in[I_SAL][head]) * dt;
          DT[head * NPR + row] = dt; AC[head * NPR + row] = wave_scan_incl(a, lane); } }
    { const bf16_t* proj = (const bf16_t*)(p.ws + OFF_PROJ);
      for (int idx = blockIdx.x * 512 + tid; idx < 132 * 3 * 576; idx += gridDim.x * 512) {
          const int cg8 = idx % 576, i = (idx / 576) % 3, bb = idx / (576 * 3);
          const int row = bb < 4 ? bb * 2048 + 2045 + i : NPR + (bb - 4) * 8 + 5 + i;
          float f[8]; float* o;
          if (cg8 < 384) { ld8b(proj + (size_t)row * NPROJ + cg8 * 8, f); o = p.out + (bb < 4 ? O_GCP + (size_t)(bb * 3 + i) * 3072 : O_GCS + (size_t)((bb - 4) * 3 + i) * 3072) + cg8 * 8; }
          else { const int c = (cg8 - 384) * 8; ld8b(proj + (size_t)row * NPROJ + PC_XBC + c, f); o = p.out + (bb < 4 ? O_SCP + (size_t)(bb * 3 + i) * 1536 : O_SCS + (size_t)((bb - 4) * 3 + i) * 1536) + c; }
          *(f32x4*)o = (f32x4){f[0], f[1], f[2], f[3]}; *(f32x4*)(o + 4) = (f32x4){f[4], f[5], f[6], f[7]}; } }
}

struct GdnOps { bf16x8 wA[4], qA[4]; u32x2 uw[4]; bf16x8 qkA[2], kA[2][2]; float gl; };
__device__ __forceinline__ void gdn_load_ops(CP& p, int item, int ti, int eh, int r, int q, GdnOps& o) {
    const unsigned char* gi = (const unsigned char*)p.out + OB_GIA + (size_t)item * GIA_ITEM;
    const bf16_t* Wg = (const bf16_t*)gi; const bf16_t* QDg = (const bf16_t*)(gi + 16384); const bf16_t* UTg = item < 512 ? (const bf16_t*)((const unsigned char*)p.out + OB_UT0 + (size_t)item * 16384) : (const bf16_t*)(p.ws + ut_off_ws(item));
    const bf16_t* QKg = (const bf16_t*)(gi + 32768); const bf16_t* KDTg = (const bf16_t*)(gi + 40960);
#pragma unroll
    for (int k = 0; k < 4; ++k) { o.wA[k] = *(const bf16x8*)(Wg + (16 * ti + r) * 128 + 32 * k + 8 * q); o.qA[k] = *(const bf16x8*)(QDg + (16 * ti + r) * 128 + 32 * k + 8 * q); }
#pragma unroll
    for (int et = 0; et < 4; ++et) o.uw[et] = *(const u32x2*)(UTg + (16 * (4 * eh + et) + r) * 64 + 16 * ti + 4 * q);
#pragma unroll
    for (int k2 = 0; k2 < 2; ++k2) { o.qkA[k2] = *(const bf16x8*)(QKg + (16 * ti + r) * 64 + 32 * k2 + 8 * q);
#pragma unroll
        for (int dd = 0; dd < 2; ++dd) o.kA[dd][k2] = *(const bf16x8*)(KDTg + (16 * (2 * ti + dd) + r) * 64 + 32 * k2 + 8 * q); }
    o.gl = ((const float*)(p.ws + OFF_GL))[item * 32];
}
__device__ __forceinline__ void gdn_scan_item(CP& p, LAS unsigned char* lds, int bh) {
    { unsigned lb_ = (unsigned)(size_t)lds; asm volatile("" : "+v"(lb_)); lds = (LAS unsigned char*)(size_t)lb_; }
    const int tid = opaque_tid(), wv = tid >> 6, lane = tid & 63, r = lane & 15, q = lane >> 4;
    const int b = bh >> 3, h = bh & 7, ti = wv & 3, eh = wv >> 2;
    LAS bf16_t* St = (LAS bf16_t*)lds; LAS bf16_t* vnT = (LAS bf16_t*)(lds + 34816); LAS float* ssqp = (LAS float*)(lds + 34816 + 18432);
    const bf16_t* proj = (const bf16_t*)(p.ws + OFF_PROJ); bf16_t* mix = (bf16_t*)(p.ws + OFF_MIX);
    const float* gnw = p.in[I_GNW];
    f32x4 Sacc[2][4];
#pragma unroll
    for (int a = 0; a < 2; ++a)
#pragma unroll
        for (int e = 0; e < 4; ++e) Sacc[a][e] = (f32x4){0.f, 0.f, 0.f, 0.f};
    for (int i = tid; i < 34816 / 16; i += 512) ((LAS u32x4*)lds)[i] = (u32x4){0u, 0u, 0u, 0u};
    GdnOps cur; gdn_load_ops(p, bh * 32, ti, eh, r, q, cur);
    __syncthreads();
    for (int n = 0; n < 32; ++n) {
        GdnOps nxt; gdn_load_ops(p, bh * 32 + (n + 1 < 32 ? n + 1 : n), ti, eh, r, q, nxt);
        bf16_t zr[4][4];
#pragma unroll
        for (int j = 0; j < 4; ++j)
#pragma unroll
            for (int et = 0; et < 4; ++et) zr[j][et] = proj[((size_t)b * 2048 + n * 64 + 16 * ti + 4 * q + j) * NPROJ + PC_ZG + h * 128 + 16 * (4 * eh + et) + r];
        f32x4 accq[4];
#pragma unroll
        for (int et = 0; et < 4; ++et) { const int E = 4 * eh + et; f32x4 accw = (f32x4){0.f, 0.f, 0.f, 0.f}; accq[et] = (f32x4){0.f, 0.f, 0.f, 0.f};
#pragma unroll
            for (int k = 0; k < 4; ++k) { const bf16x8 sf = *(LAS bf16x8*)(St + (16 * E + r) * 136 + 32 * k + 8 * q); accw = MFMA16(cur.wA[k], sf, accw); accq[et] = MFMA16(cur.qA[k], sf, accq[et]); }
            const u32x2 uw = cur.uw[et]; const f32x4 u = (f32x4){bflo(uw.x), bfhi(uw.x), bflo(uw.y), bfhi(uw.y)};
            *(LAS u32x2*)(vnT + (16 * E + r) * 72 + 16 * ti + 4 * q) = pack4(u - accw); }
        LDS_BARRIER();
        const float gl = cur.gl;
#pragma unroll
        for (int et = 0; et < 4; ++et) { const int E = 4 * eh + et; bf16x8 bv[2];
#pragma unroll
            for (int k2 = 0; k2 < 2; ++k2) bv[k2] = *(LAS bf16x8*)(vnT + (16 * E + r) * 72 + 32 * k2 + 8 * q);
#pragma unroll
            for (int k2 = 0; k2 < 2; ++k2) accq[et] = MFMA16(cur.qkA[k2], bv[k2], accq[et]);
#pragma unroll
            for (int dd = 0; dd < 2; ++dd) { Sacc[dd][et] = Sacc[dd][et] * gl;
#pragma unroll
                for (int k2 = 0; k2 < 2; ++k2) Sacc[dd][et] = MFMA16(cur.kA[dd][k2], bv[k2], Sacc[dd][et]);
                *(LAS u32x2*)(St + (16 * E + r) * 136 + 16 * (2 * ti + dd) + 4 * q) = pack4(Sacc[dd][et]); } }
        float s4[4];
#pragma unroll
        for (int j = 0; j < 4; ++j) { float s = 0.f;
#pragma unroll
            for (int et = 0; et < 4; ++et) s += accq[et][j] * accq[et][j];
            s = sum16_dpp(s); s4[j] = s; }
        if (r == 0) {
#pragma unroll
            for (int j = 0; j < 4; ++j) ssqp[eh * 64 + 16 * ti + 4 * q + j] = s4[j]; }
        LDS_BARRIER();
#pragma unroll
        for (int j = 0; j < 4; ++j) { const int i = 16 * ti + 4 * q + j; const float rinv = rsqrtf((ssqp[i] + ssqp[64 + i]) * (1.f / 128.f) + EPS);
            const size_t row = (size_t)b * 2048 + n * 64 + i;
#pragma unroll
            for (int et = 0; et < 4; ++et) { const int e = 16 * (4 * eh + et) + r;
                mix[row * 2048 + h * 128 + e] = f2bf(accq[et][j] * rinv * gnw[e] * siluf(bf2f(zr[j][et]))); } }
        cur = nxt;
    }
    float* so = p.out + O_GSP + (size_t)bh * 128 * 128;
#pragma unroll
    for (int dd = 0; dd < 2; ++dd)
#pragma unroll
        for (int et = 0; et < 4; ++et)
#pragma unroll
            for (int j = 0; j < 4; ++j) so[(16 * (2 * ti + dd) + 4 * q + j) * 128 + 16 * (4 * eh + et) + r] = Sacc[dd][et][j];
    __syncthreads();
}

__device__ __forceinline__ void ssd_load_rows(const bf16_t* pc, int t0, const float* aux, const float* acl, u32x4 (&rr)[11], float (&dd)[8], float& al) {
#pragma unroll
    for (int i = 0; i < 11; ++i) { const int t = t0 - 3 + i; rr[i] = (t >= 0) ? *(const u32x4*)(pc + (size_t)t * NPROJ) : (u32x4){0u, 0u, 0u, 0u}; }
#pragma unroll
    for (int tt = 0; tt < 8; ++tt) dd[tt] = aux[tt];
    al = *acl;
}
__device__ __forceinline__ void ssd_scan_item(CP& p, LAS unsigned char* lds, int bhd) {
    { unsigned lb_ = (unsigned)(size_t)lds; asm volatile("" : "+v"(lb_)); lds = (LAS unsigned char*)(size_t)lb_; }
    const int tid = opaque_tid(), wv = tid >> 6, lane = tid & 63, r = lane & 15, q = lane >> 4;
    const int b = bhd >> 4, head = bhd & 15, g = head >> 3;
    LAS bf16_t* BdT = (LAS bf16_t*)(lds + 34816); LAS bf16_t* xdtT = (LAS bf16_t*)(lds + 53248); LAS bf16_t* hb = (LAS bf16_t*)(lds + 71680);
    const bf16_t* proj = (const bf16_t*)(p.ws + OFF_PROJ); const float* DT = (const float*)(p.ws + OFF_DT); const float* AC = (const float*)(p.ws + OFF_ACUM);
    f32x4 hacc[4];
#pragma unroll
    for (int e = 0; e < 4; ++e) hacc[e] = (f32x4){0.f, 0.f, 0.f, 0.f};
    for (int i = tid; i < 17408 / 16; i += 512) ((LAS u32x4*)(lds + 71680))[i] = (u32x4){0u, 0u, 0u, 0u};
    const bool act = tid < 192; const int seg = act ? tid / 24 : 0, cgi = act ? tid % 24 : 0;
    const int ch = cgi < 8 ? head * 64 + cgi * 8 : 1024 + g * 128 + (cgi - 8) * 8;
    const bf16_t* pc = proj + (size_t)b * 2048 * NPROJ + PC_XBC + ch;
    const float* auxb = (cgi < 8 ? DT : AC) + head * NPR + b * 2048 + seg * 8;
    const float* aclb = AC + head * NPR + b * 2048 + 63;
    u32x4 rc[11]; float dc[8]; float alc;
    ssd_load_rows(pc, seg * 8, auxb, aclb, rc, dc, alc);
    __syncthreads();
    for (int n = 0; n < 32; ++n) {
        const int nn = n + 1 < 32 ? n + 1 : n;
        u32x4 rn[11]; float dn[8]; float aln;
        ssd_load_rows(pc, nn * 64 + seg * 8, auxb + nn * 64, aclb + nn * 64, rn, dn, aln);
        {
            bf16_t* hst = (bf16_t*)(p.ws + OFF_YZ) + ((size_t)(bhd * 32 + n) * 64) * 128;
            for (int i = tid; i < 1024; i += 512) { const int p_ = i >> 4, sg = i & 15; *(u32x4*)(hst + p_ * 128 + sg * 8) = *(LAS u32x4*)(hb + p_ * 136 + sg * 8); } }
        if (act) {
            float o[8][8]; float h0[8], h1[8], h2[8]; float w0[8], w1[8], w2[8], w3[8], bv[8];
            ld8f(p.in[I_SCW] + ch, w0); ld8f(p.in[I_SCW] + 1536 + ch, w1); ld8f(p.in[I_SCW] + 2 * 1536 + ch, w2); ld8f(p.in[I_SCW] + 3 * 1536 + ch, w3); ld8f(p.in[I_SCB] + ch, bv);
            unpack8(rc[0], h0); unpack8(rc[1], h1); unpack8(rc[2], h2);
#pragma unroll
            for (int tt = 0; tt < 8; ++tt) { float cur[8]; unpack8(rc[3 + tt], cur);
#pragma unroll
                for (int c = 0; c < 8; ++c) { o[tt][c] = siluf(bv[c] + w0[c] * h0[c] + w1[c] * h1[c] + w2[c] * h2[c] + w3[c] * cur[c]); h0[c] = h1[c]; h1[c] = h2[c]; h2[c] = cur[c]; } }
            if (cgi < 8) { const int p0 = cgi * 8;
#pragma unroll
                for (int c = 0; c < 8; ++c) { float f[8];
#pragma unroll
                    for (int tt = 0; tt < 8; ++tt) f[tt] = o[tt][c] * dc[tt];
                    *(LAS u32x4*)(xdtT + (p0 + c) * 72 + seg * 8) = pack8(f); }
            } else { const int s0 = (cgi - 8) * 8; float dec[8];
#pragma unroll
                for (int tt = 0; tt < 8; ++tt) dec[tt] = __expf(alc - dc[tt]);
#pragma unroll
                for (int c = 0; c < 8; ++c) { float f[8];
#pragma unroll
                    for (int tt = 0; tt < 8; ++tt) f[tt] = o[tt][c] * dec[tt];
                    *(LAS u32x4*)(BdT + (s0 + c) * 72 + seg * 8) = pack8(f); } }
        }
        LDS_BARRIER();
        { bf16x8 bdf[2];
#pragma unroll
          for (int k2 = 0; k2 < 2; ++k2) bdf[k2] = *(LAS bf16x8*)(BdT + (16 * wv + r) * 72 + 32 * k2 + 8 * q);
          const float al = __expf(alc);
#pragma unroll
          for (int pt = 0; pt < 4; ++pt) { bf16x8 xf[2];
#pragma unroll
              for (int k2 = 0; k2 < 2; ++k2) xf[k2] = *(LAS bf16x8*)(xdtT + (16 * pt + r) * 72 + 32 * k2 + 8 * q);
              hacc[pt] = hacc[pt] * al;
#pragma unroll
              for (int k2 = 0; k2 < 2; ++k2) hacc[pt] = MFMA16(bdf[k2], xf[k2], hacc[pt]);
              *(LAS u32x2*)(hb + (16 * pt + r) * 136 + 16 * wv + 4 * q) = pack4(hacc[pt]); } }
        LDS_BARRIER();
#pragma unroll
        for (int i = 0; i < 11; ++i) rc[i] = rn[i];
#pragma unroll
        for (int tt = 0; tt < 8; ++tt) dc[tt] = dn[tt];
        alc = aln;
    }
    float* so = p.out + O_SSP + (size_t)bhd * 64 * 128;
#pragma unroll
    for (int pt = 0; pt < 4; ++pt) *(f32x4*)(so + (16 * pt + r) * 128 + 16 * wv + 4 * q) = hacc[pt];
}
__device__ __forceinline__ void ssd_sample_item(CP& p, LAS unsigned char* lds, int bg) {
    { unsigned lb_ = (unsigned)(size_t)lds; asm volatile("" : "+v"(lb_)); lds = (LAS unsigned char*)(size_t)lb_; }
    const int tid = opaque_tid(), wv = tid >> 6, lane = tid & 63;
    const int b = bg >> 1, g = bg & 1, r0 = NPR + b * 8;
    LAS float* xs = (LAS float*)lds; LAS float* Bs = (LAS float*)(lds + 16384); LAS float* Cs = (LAS float*)(lds + 20480);
    LAS float* dts = (LAS float*)(lds + 24576); LAS float* dAs = (LAS float*)(lds + 24832); LAS float* yzs = (LAS float*)(lds + 25088);
    const bf16_t* proj = (const bf16_t*)(p.ws + OFF_PROJ); const float* gates = (const float*)(p.ws + OFF_GATES); bf16_t* mix = (bf16_t*)(p.ws + OFF_MIX);
    const int pp = tid >> 3, nq = tid & 7;
    const float* sin = p.in[I_SS] + ((size_t)(b * 16 + g * 8) * 64 + pp) * 128 + nq * 16;
    float* sout = p.out + O_SSS + ((size_t)(b * 16 + g * 8) * 64 + pp) * 128 + nq * 16;
    f32x4 hn[4];
#pragma unroll
    for (int v = 0; v < 4; ++v) hn[v] = *(const f32x4*)(sin + 4 * v);
    for (int idx = tid; idx < 768; idx += 512) { const int t = idx / 96, cgi = idx % 96; float o[8];
        const int ch = cgi < 64 ? g * 512 + cgi * 8 : (cgi < 80 ? 1024 + g * 128 + (cgi - 64) * 8 : 1280 + g * 128 + (cgi - 80) * 8);
        conv1x8_sample(proj + (size_t)r0 * NPROJ + PC_XBC + ch, p.in[I_SSC] + (size_t)b * 3 * 1536 + ch, 1536, t, p.in[I_SCW] + ch, p.in[I_SCB] + ch, o);
        LAS float* dst = cgi < 64 ? xs + t * 512 + cgi * 8 : (cgi < 80 ? Bs + t * 128 + (cgi - 64) * 8 : Cs + t * 128 + (cgi - 80) * 8);
        *(LAS f32x4*)dst = (f32x4){o[0], o[1], o[2], o[3]}; *(LAS f32x4*)(dst + 4) = (f32x4){o[4], o[5], o[6], o[7]}; }
    if (tid < 64) { const int t = tid >> 3, hh = tid & 7, head = g * 8 + hh;
        const float dt = softplusf(gates[(size_t)(r0 + t) * 32 + 16 + head] + p.in[I_SDB][head]);
        dts[t * 8 + hh] = dt; dAs[t * 8 + hh] = __expf(-__expf(p.in[I_SAL][head]) * dt); }
    __syncthreads();
    for (int hh = 0; hh < 8; ++hh) { const int head = g * 8 + hh;
        float hr[16];
#pragma unroll
        for (int v = 0; v < 4; ++v) { hr[4 * v] = hn[v][0]; hr[4 * v + 1] = hn[v][1]; hr[4 * v + 2] = hn[v][2]; hr[4 * v + 3] = hn[v][3]; }
        if (hh < 7) {
#pragma unroll
            for (int v = 0; v < 4; ++v) hn[v] = *(const f32x4*)(sin + (size_t)(hh + 1) * 64 * 128 + 4 * v); }
        const float Dh = p.in[I_SD][head];
#pragma unroll
        for (int t = 0; t < 8; ++t) { const float dA = dAs[t * 8 + hh], xv = xs[t * 512 + hh * 64 + pp], dtx = dts[t * 8 + hh] * xv; float yp = 0.f;
#pragma unroll
            for (int v = 0; v < 4; ++v) { const f32x4 bv = *(LAS f32x4*)(Bs + t * 128 + nq * 16 + 4 * v), cv = *(LAS f32x4*)(Cs + t * 128 + nq * 16 + 4 * v);
#pragma unroll
                for (int e = 0; e < 4; ++e) { hr[4 * v + e] = dA * hr[4 * v + e] + dtx * bv[e]; yp += hr[4 * v + e] * cv[e]; } }
            yp += __shfl_xor(yp, 1); yp += __shfl_xor(yp, 2); yp += __shfl_xor(yp, 4);
            if (nq == 0) { const float y = yp + Dh * xv; const float z = bf2f(proj[(size_t)(r0 + t) * NPROJ + PC_ZS + head * 64 + pp]); yzs[t * 512 + hh * 64 + pp] = y * siluf(z); } }
#pragma unroll
        for (int v = 0; v < 4; ++v) *(f32x4*)(sout + (size_t)hh * 64 * 128 + 4 * v) = (f32x4){hr[4 * v], hr[4 * v + 1], hr[4 * v + 2], hr[4 * v + 3]};
    }
    __syncthreads();
    { const int t = wv; float f[8]; float ss = 0.f;
      const f32x4 a = *(LAS f32x4*)(yzs + t * 512 + lane * 8), c = *(LAS f32x4*)(yzs + t * 512 + lane * 8 + 4);
      f[0] = a[0]; f[1] = a[1]; f[2] = a[2]; f[3] = a[3]; f[4] = c[0]; f[5] = c[1]; f[6] = c[2]; f[7] = c[3];
#pragma unroll
      for (int e = 0; e < 8; ++e) ss += f[e] * f[e];
      const float rinv = rsqrtf(wave_sum(ss) * (1.f / 512.f) + EPS); float w[8]; ld8f(p.in[I_SNW] + g * 512 + lane * 8, w);
#pragma unroll
      for (int e = 0; e < 8; ++e) f[e] *= rinv * w[e];
      *(u32x4*)(mix + (size_t)(r0 + t) * 2048 + 1024 + g * 512 + lane * 8) = pack8(f); }
    __syncthreads();
}

__device__ __forceinline__ void ssd_prompt_par_item(CP& p, LAS unsigned char* lds, int item) {
    { unsigned lb_ = (unsigned)(size_t)lds; asm volatile("" : "+v"(lb_)); lds = (LAS unsigned char*)(size_t)lb_; }
    const int tid = opaque_tid(), wv = tid >> 6, lane = tid & 63;
    const int c64 = item & 31, g = (item >> 5) & 1, b = item >> 6;
    LAS float* xs = (LAS float*)lds; LAS float* Bs = (LAS float*)(lds + 16384); LAS float* Cs = (LAS float*)(lds + 20480);
    LAS float* dts = (LAS float*)(lds + 24576); LAS float* dAs = (LAS float*)(lds + 24832); LAS float* yzs = (LAS float*)(lds + 25088);
    const bf16_t* proj = (const bf16_t*)(p.ws + OFF_PROJ); const float* gates = (const float*)(p.ws + OFF_GATES); bf16_t* mix = (bf16_t*)(p.ws + OFF_MIX);
    const int pp = tid >> 3, nq = tid & 7;
    f32x2p hr[8][8];
#pragma unroll
    for (int hh = 0; hh < 8; ++hh) { const bf16_t* hs = (const bf16_t*)(p.ws + OFF_YZ) + (((size_t)((b * 16 + g * 8 + hh) * 32 + c64) * 64) + pp) * 128 + nq * 16;
        float f0[8], f1[8]; ld8b(hs, f0); ld8b(hs + 8, f1);
#pragma unroll
        for (int e = 0; e < 4; ++e) { hr[hh][e] = (f32x2p){f0[2 * e], f0[2 * e + 1]}; hr[hh][4 + e] = (f32x2p){f1[2 * e], f1[2 * e + 1]}; } }
    for (int w8 = 0; w8 < 8; ++w8) { const int r0 = b * 2048 + c64 * 64 + w8 * 8;
    for (int idx = tid; idx < 768; idx += 512) { const int t = idx / 96, cgi = idx % 96; float o[8];
        const int ch = cgi < 64 ? g * 512 + cgi * 8 : (cgi < 80 ? 1024 + g * 128 + (cgi - 64) * 8 : 1280 + g * 128 + (cgi - 80) * 8);
        conv1x8_sample(proj + (size_t)r0 * NPROJ + PC_XBC + ch, nullptr, 1536, t, p.in[I_SCW] + ch, p.in[I_SCB] + ch, o, (c64 | w8) != 0);
        LAS float* dst = cgi < 64 ? xs + t * 512 + cgi * 8 : (cgi < 80 ? Bs + t * 128 + (cgi - 64) * 8 : Cs + t * 128 + (cgi - 80) * 8);
        *(LAS f32x4*)dst = (f32x4){o[0], o[1], o[2], o[3]}; *(LAS f32x4*)(dst + 4) = (f32x4){o[4], o[5], o[6], o[7]}; }
    if (tid < 64) { const int t = tid >> 3, hh = tid & 7, head = g * 8 + hh;
        const float dt = softplusf(gates[(size_t)(r0 + t) * 32 + 16 + head] + p.in[I_SDB][head]);
        dts[t * 8 + hh] = dt; dAs[t * 8 + hh] = __expf(-__expf(p.in[I_SAL][head]) * dt); }
    __syncthreads();
    {
#pragma unroll 1
        for (int t = 0; t < 8; ++t) {
            const f32x4 dA0 = *(LAS f32x4*)(dAs + t * 8), dA1 = *(LAS f32x4*)(dAs + t * 8 + 4), dt0 = *(LAS f32x4*)(dts + t * 8), dt1 = *(LAS f32x4*)(dts + t * 8 + 4);
            f32x2p yp2[8]; float yp[8], xv[8], dtx[8], dAv[8];
#pragma unroll
            for (int hh = 0; hh < 8; ++hh) { dAv[hh] = hh < 4 ? dA0[hh & 3] : dA1[hh & 3]; xv[hh] = xs[t * 512 + hh * 64 + pp]; dtx[hh] = (hh < 4 ? dt0[hh & 3] : dt1[hh & 3]) * xv[hh]; yp2[hh] = (f32x2p){0.f, 0.f}; }
#pragma unroll
            for (int v = 0; v < 4; ++v) { const f32x4 bv = *(LAS f32x4*)(Bs + t * 128 + nq * 16 + 4 * v), cv = *(LAS f32x4*)(Cs + t * 128 + nq * 16 + 4 * v);
                const f32x2p b0 = (f32x2p){bv[0], bv[1]}, b1 = (f32x2p){bv[2], bv[3]}, c0 = (f32x2p){cv[0], cv[1]}, c1 = (f32x2p){cv[2], cv[3]};
#pragma unroll
                for (int hh = 0; hh < 8; ++hh) { const f32x2p da = (f32x2p){dAv[hh], dAv[hh]}, dx = (f32x2p){dtx[hh], dtx[hh]};
                    hr[hh][2 * v] = da * hr[hh][2 * v] + dx * b0; yp2[hh] += hr[hh][2 * v] * c0;
                    hr[hh][2 * v + 1] = da * hr[hh][2 * v + 1] + dx * b1; yp2[hh] += hr[hh][2 * v + 1] * c1; } }
#pragma unroll
            for (int hh = 0; hh < 8; ++hh) yp[hh] = sum8_dpp(yp2[hh][0] + yp2[hh][1]);
            if (nq == 0) {
#pragma unroll
                for (int hh = 0; hh < 8; ++hh) { const int head = g * 8 + hh; const float y = yp[hh] + p.in[I_SD][head] * xv[hh];
                    yzs[t * 512 + hh * 64 + pp] = y; } }
        }
    }
    __syncthreads();
    { const int t = wv; float f[8]; float ss = 0.f;
      const f32x4 a = *(LAS f32x4*)(yzs + t * 512 + lane * 8), c = *(LAS f32x4*)(yzs + t * 512 + lane * 8 + 4);
      f[0] = a[0]; f[1] = a[1]; f[2] = a[2]; f[3] = a[3]; f[4] = c[0]; f[5] = c[1]; f[6] = c[2]; f[7] = c[3];
      { float zf[8]; ld8b(proj + (size_t)(r0 + t) * NPROJ + PC_ZS + g * 512 + lane * 8, zf);
#pragma unroll
        for (int e = 0; e < 8; ++e) f[e] *= siluf(zf[e]); }
#pragma unroll
      for (int e = 0; e < 8; ++e) ss += f[e] * f[e];
      const float rinv = rsqrtf(wave_sum(ss) * (1.f / 512.f) + EPS); float w[8]; ld8f(p.in[I_SNW] + g * 512 + lane * 8, w);
#pragma unroll
      for (int e = 0; e < 8; ++e) f[e] *= rinv * w[e];
      *(u32x4*)(mix + (size_t)(r0 + t) * 2048 + 1024 + g * 512 + lane * 8) = pack8(f); }
    __syncthreads();
    }
}


__device__ __forceinline__ void ssd_sample_fast_item(CP& p, LAS unsigned char* lds, int bg) {
    { unsigned lb_ = (unsigned)(size_t)lds; asm volatile("" : "+v"(lb_)); lds = (LAS unsigned char*)(size_t)lb_; }
    const int tid = opaque_tid(), wv = tid >> 6, lane = tid & 63;
    const int b = bg >> 1, g = bg & 1, r0 = NPR + b * 8;
    LAS float* xs = (LAS float*)lds; LAS float* Bs = (LAS float*)(lds + 16384); LAS float* Cs = (LAS float*)(lds + 20480);
    LAS float* dts = (LAS float*)(lds + 24576); LAS float* dAs = (LAS float*)(lds + 24832); LAS float* yzs = (LAS float*)(lds + 25088);
    const bf16_t* proj = (const bf16_t*)(p.ws + OFF_PROJ); const float* gates = (const float*)(p.ws + OFF_GATES); bf16_t* mix = (bf16_t*)(p.ws + OFF_MIX);
    const int pp = tid >> 3, nq = tid & 7;
    f32x2p hr[8][8];
#pragma unroll
    for (int hh = 0; hh < 8; ++hh) { const float* hs = p.in[I_SS] + ((size_t)(b * 16 + g * 8 + hh) * 64 + pp) * 128 + nq * 16;
#pragma unroll
        for (int v = 0; v < 4; ++v) { const f32x4 x4 = *(const f32x4*)(hs + 4 * v); hr[hh][2 * v] = (f32x2p){x4[0], x4[1]}; hr[hh][2 * v + 1] = (f32x2p){x4[2], x4[3]}; } }
    {
    for (int idx = tid; idx < 768; idx += 512) { const int t = idx / 96, cgi = idx % 96; float o[8];
        const int ch = cgi < 64 ? g * 512 + cgi * 8 : (cgi < 80 ? 1024 + g * 128 + (cgi - 64) * 8 : 1280 + g * 128 + (cgi - 80) * 8);
        conv1x8_sample(proj + (size_t)r0 * NPROJ + PC_XBC + ch, p.in[I_SSC] + (size_t)b * 3 * 1536 + ch, 1536, t, p.in[I_SCW] + ch, p.in[I_SCB] + ch, o);
        LAS float* dst = cgi < 64 ? xs + t * 512 + cgi * 8 : (cgi < 80 ? Bs + t * 128 + (cgi - 64) * 8 : Cs + t * 128 + (cgi - 80) * 8);
        *(LAS f32x4*)dst = (f32x4){o[0], o[1], o[2], o[3]}; *(LAS f32x4*)(dst + 4) = (f32x4){o[4], o[5], o[6], o[7]}; }
    if (tid < 64) { const int t = tid >> 3, hh = tid & 7, head = g * 8 + hh;
        const float dt = softplusf(gates[(size_t)(r0 + t) * 32 + 16 + head] + p.in[I_SDB][head]);
        dts[t * 8 + hh] = dt; dAs[t * 8 + hh] = __expf(-__expf(p.in[I_SAL][head]) * dt); }
    __syncthreads();
    {
#pragma unroll 1
        for (int t = 0; t < 8; ++t) {
            const f32x4 dA0 = *(LAS f32x4*)(dAs + t * 8), dA1 = *(LAS f32x4*)(dAs + t * 8 + 4), dt0 = *(LAS f32x4*)(dts + t * 8), dt1 = *(LAS f32x4*)(dts + t * 8 + 4);
            f32x2p yp2[8]; float yp[8], xv[8], dtx[8], dAv[8];
#pragma unroll
            for (int hh = 0; hh < 8; ++hh) { dAv[hh] = hh < 4 ? dA0[hh & 3] : dA1[hh & 3]; xv[hh] = xs[t * 512 + hh * 64 + pp]; dtx[hh] = (hh < 4 ? dt0[hh & 3] : dt1[hh & 3]) * xv[hh]; yp2[hh] = (f32x2p){0.f, 0.f}; }
#pragma unroll
            for (int v = 0; v < 4; ++v) { const f32x4 bv = *(LAS f32x4*)(Bs + t * 128 + nq * 16 + 4 * v), cv = *(LAS f32x4*)(Cs + t * 128 + nq * 16 + 4 * v);
                const f32x2p b0 = (f32x2p){bv[0], bv[1]}, b1 = (f32x2p){bv[2], bv[3]}, c0 = (f32x2p){cv[0], cv[1]}, c1 = (f32x2p){cv[2], cv[3]};
#pragma unroll
                for (int hh = 0; hh < 8; ++hh) { const f32x2p da = (f32x2p){dAv[hh], dAv[hh]}, dx = (f32x2p){dtx[hh], dtx[hh]};
                    hr[hh][2 * v] = da * hr[hh][2 * v] + dx * b0; yp2[hh] += hr[hh][2 * v] * c0;
                    hr[hh][2 * v + 1] = da * hr[hh][2 * v + 1] + dx * b1; yp2[hh] += hr[hh][2 * v + 1] * c1; } }
#pragma unroll
            for (int hh = 0; hh < 8; ++hh) yp[hh] = sum8_dpp(yp2[hh][0] + yp2[hh][1]);
            if (nq == 0) {
#pragma unroll
                for (int hh = 0; hh < 8; ++hh) { const int head = g * 8 + hh; const float y = yp[hh] + p.in[I_SD][head] * xv[hh];
                    yzs[t * 512 + hh * 64 + pp] = y; } }
        }
    }
    __syncthreads();
    { const int t = wv; float f[8]; float ss = 0.f;
      const f32x4 a = *(LAS f32x4*)(yzs + t * 512 + lane * 8), c = *(LAS f32x4*)(yzs + t * 512 + lane * 8 + 4);
      f[0] = a[0]; f[1] = a[1]; f[2] = a[2]; f[3] = a[3]; f[4] = c[0]; f[5] = c[1]; f[6] = c[2]; f[7] = c[3];
      { float zf[8]; ld8b(proj + (size_t)(r0 + t) * NPROJ + PC_ZS + g * 512 + lane * 8, zf);
#pragma unroll
        for (int e = 0; e < 8; ++e) f[e] *= siluf(zf[e]); }
#pragma unroll
      for (int e = 0; e < 8; ++e) ss += f[e] * f[e];
      const float rinv = rsqrtf(wave_sum(ss) * (1.f / 512.f) + EPS); float w[8]; ld8f(p.in[I_SNW] + g * 512 + lane * 8, w);
#pragma unroll
      for (int e = 0; e < 8; ++e) f[e] *= rinv * w[e];
      *(u32x4*)(mix + (size_t)(r0 + t) * 2048 + 1024 + g * 512 + lane * 8) = pack8(f); }
    __syncthreads();
    }
#pragma unroll
    for (int hh = 0; hh < 8; ++hh) { float* ho = p.out + O_SSS + ((size_t)(b * 16 + g * 8 + hh) * 64 + pp) * 128 + nq * 16;
#pragma unroll
        for (int v = 0; v < 4; ++v) *(f32x4*)(ho + 4 * v) = (f32x4){hr[hh][2 * v][0], hr[hh][2 * v][1], hr[hh][2 * v + 1][0], hr[hh][2 * v + 1][1]}; }
}

__device__ __forceinline__ void ssd_prompt_seq_item(CP& p, LAS unsigned char* lds, int bg) {
    { unsigned lb_ = (unsigned)(size_t)lds; asm volatile("" : "+v"(lb_)); lds = (LAS unsigned char*)(size_t)lb_; }
    const int tid = opaque_tid(), wv = tid >> 6, lane = tid & 63;
    const int b = bg >> 1, g = bg & 1;
    LAS float* xs = (LAS float*)lds; LAS float* Bs = (LAS float*)(lds + 16384); LAS float* Cs = (LAS float*)(lds + 20480);
    LAS float* dts = (LAS float*)(lds + 24576); LAS float* dAs = (LAS float*)(lds + 24832); LAS float* yzs = (LAS float*)(lds + 25088);
    const bf16_t* proj = (const bf16_t*)(p.ws + OFF_PROJ); const float* gates = (const float*)(p.ws + OFF_GATES); bf16_t* mix = (bf16_t*)(p.ws + OFF_MIX);
    const int pp = tid >> 3, nq = tid & 7;
    float* carry_ = (DBG_SSD_SEQ == 2 || DBG_SSD_SEQ == 4) ? (float*)(p.ws + OFF_FF) : p.out + O_SSP;
    const float* sin = carry_ + ((size_t)(b * 16 + g * 8) * 64 + pp) * 128 + nq * 16;
    float* sout = carry_ + ((size_t)(b * 16 + g * 8) * 64 + pp) * 128 + nq * 16;
    for (int w8 = 0; w8 < 256; ++w8) { const int r0 = b * 2048 + w8 * 8;
    f32x4 hn[4];
#pragma unroll
    for (int v = 0; v < 4; ++v) hn[v] = w8 ? *(const f32x4*)(sin + 4 * v) : (f32x4){0.f, 0.f, 0.f, 0.f};
    for (int idx = tid; idx < 768; idx += 512) { const int t = idx / 96, cgi = idx % 96; float o[8];
        const int ch = cgi < 64 ? g * 512 + cgi * 8 : (cgi < 80 ? 1024 + g * 128 + (cgi - 64) * 8 : 1280 + g * 128 + (cgi - 80) * 8);
        conv1x8_sample(proj + (size_t)r0 * NPROJ + PC_XBC + ch, nullptr, 1536, t, p.in[I_SCW] + ch, p.in[I_SCB] + ch, o, w8 > 0);
        LAS float* dst = cgi < 64 ? xs + t * 512 + cgi * 8 : (cgi < 80 ? Bs + t * 128 + (cgi - 64) * 8 : Cs + t * 128 + (cgi - 80) * 8);
        *(LAS f32x4*)dst = (f32x4){o[0], o[1], o[2], o[3]}; *(LAS f32x4*)(dst + 4) = (f32x4){o[4], o[5], o[6], o[7]}; }
    if (tid < 64) { const int t = tid >> 3, hh = tid & 7, head = g * 8 + hh;
        const float dt = softplusf(gates[(size_t)(r0 + t) * 32 + 16 + head] + p.in[I_SDB][head]);
        dts[t * 8 + hh] = dt; dAs[t * 8 + hh] = __expf(-__expf(p.in[I_SAL][head]) * dt); }
    __syncthreads();
    for (int hh = 0; hh < 8; ++hh) { const int head = g * 8 + hh;
        float hr[16];
#pragma unroll
        for (int v = 0; v < 4; ++v) { hr[4 * v] = hn[v][0]; hr[4 * v + 1] = hn[v][1]; hr[4 * v + 2] = hn[v][2]; hr[4 * v + 3] = hn[v][3]; }
        if (hh < 7) {
#pragma unroll
            for (int v = 0; v < 4; ++v) hn[v] = w8 ? *(const f32x4*)(sin + (size_t)(hh + 1) * 64 * 128 + 4 * v) : (f32x4){0.f, 0.f, 0.f, 0.f}; }
        const float Dh = p.in[I_SD][head];
#pragma unroll
        for (int t = 0; t < 8; ++t) { const float dA = dAs[t * 8 + hh], xv = xs[t * 512 + hh * 64 + pp], dtx = dts[t * 8 + hh] * xv; float yp = 0.f;
#pragma unroll
            for (int v = 0; v < 4; ++v) { const f32x4 bv = *(LAS f32x4*)(Bs + t * 128 + nq * 16 + 4 * v), cv = *(LAS f32x4*)(Cs + t * 128 + nq * 16 + 4 * v);
#pragma unroll
                for (int e = 0; e < 4; ++e) { hr[4 * v + e] = dA * hr[4 * v + e] + dtx * bv[e]; yp += hr[4 * v + e] * cv[e]; } }
            yp += __shfl_xor(yp, 1); yp += __shfl_xor(yp, 2); yp += __shfl_xor(yp, 4);
            if (nq == 0) { const float y = yp + Dh * xv; const float z = bf2f(proj[(size_t)(r0 + t) * NPROJ + PC_ZS + head * 64 + pp]); yzs[t * 512 + hh * 64 + pp] = y * siluf(z); } }
#pragma unroll
        for (int v = 0; v < 4; ++v) *(f32x4*)(sout + (size_t)hh * 64 * 128 + 4 * v) = (f32x4){hr[4 * v], hr[4 * v + 1], hr[4 * v + 2], hr[4 * v + 3]};
    }
    __syncthreads();
    { const int t = wv; float f[8]; float ss = 0.f;
      const f32x4 a = *(LAS f32x4*)(yzs + t * 512 + lane * 8), c = *(LAS f32x4*)(yzs + t * 512 + lane * 8 + 4);
      f[0] = a[0]; f[1] = a[1]; f[2] = a[2]; f[3] = a[3]; f[4] = c[0]; f[5] = c[1]; f[6] = c[2]; f[7] = c[3];
#pragma unroll
      for (int e = 0; e < 8; ++e) ss += f[e] * f[e];
      const float rinv = rsqrtf(wave_sum(ss) * (1.f / 512.f) + EPS); float w[8]; ld8f(p.in[I_SNW] + g * 512 + lane * 8, w);
#pragma unroll
      for (int e = 0; e < 8; ++e) f[e] *= rinv * w[e];
      if (DBG_SSD_SEQ >= 3) { if (DBG_SSD_SEQ == 3 || !DBG_SUBSET((r0 + t) & 2047)) { float f2[8]; f2[0] = a[0]; f2[1] = a[1]; f2[2] = a[2]; f2[3] = a[3]; f2[4] = c[0]; f2[5] = c[1]; f2[6] = c[2]; f2[7] = c[3];
          *(u32x4*)((bf16_t*)(p.ws + OFF_YZ) + (size_t)(r0 + t) * 1024 + g * 512 + lane * 8) = pack8(f2); } }
      else *(u32x4*)(mix + (size_t)(r0 + t) * 2048 + 1024 + g * 512 + lane * 8) = pack8(f); }
    __syncthreads();
    }
}


__device__ __forceinline__ void gdn_sample_item(CP& p, LAS unsigned char* lds, int bh) {
    { unsigned lb_ = (unsigned)(size_t)lds; asm volatile("" : "+v"(lb_)); lds = (LAS unsigned char*)(size_t)lb_; }
    const int tid = opaque_tid(), wv = tid >> 6, lane = tid & 63;
    const int b = bh >> 3, h = bh & 7, r0 = NPR + b * 8;
    LAS float* qs = (LAS float*)lds; LAS float* ks = (LAS float*)(lds + 4096); LAS float* vs = (LAS float*)(lds + 8192);
    LAS float* as = (LAS float*)(lds + 12288); LAS float* bs = as + 8; LAS float* part = (LAS float*)(lds + 12544); LAS float* opart = (LAS float*)(lds + 16640);
    const bf16_t* proj = (const bf16_t*)(p.ws + OFF_PROJ); const float* gates = (const float*)(p.ws + OFF_GATES); bf16_t* mix = (bf16_t*)(p.ws + OFF_MIX);
    const int e = tid & 127, dq = tid >> 7;
    const float* sin = p.in[I_SG] + ((size_t)bh * 128 + dq * 32) * 128 + e;
    float* sout = p.out + O_GSS + ((size_t)bh * 128 + dq * 32) * 128 + e;
    float S[32];
#pragma unroll
    for (int d = 0; d < 32; ++d) S[d] = sin[d * 128];
    if (tid < 384) { const int part_ = tid >> 7, t = (tid >> 4) & 7, cgi = tid & 15, ch = part_ * 1024 + h * 128 + cgi * 8; float o[8];
        conv1x8_sample(proj + (size_t)r0 * NPROJ + ch, p.in[I_SGC] + (size_t)b * 3 * 3072 + ch, 3072, t, p.in[I_GCW] + ch, nullptr, o);
        if (part_ < 2) { float ss = 0.f;
#pragma unroll
            for (int c = 0; c < 8; ++c) ss += o[c] * o[c];
            ss = sum16_dpp(ss);
            const float sc = rsqrtf(ss + EPS) * (part_ == 0 ? 0.08838834764831845f : 1.f);
#pragma unroll
            for (int c = 0; c < 8; ++c) o[c] *= sc; }
        LAS float* dst = (part_ == 0 ? qs : (part_ == 1 ? ks : vs)) + t * 128 + cgi * 8;
        *(LAS f32x4*)dst = (f32x4){o[0], o[1], o[2], o[3]}; *(LAS f32x4*)(dst + 4) = (f32x4){o[4], o[5], o[6], o[7]};
    } else if (tid < 392) { const int t = tid - 384;
        const float gg = -__expf(p.in[I_GAL][h]) * softplusf(gates[(size_t)(r0 + t) * 32 + 8 + h] + p.in[I_GDB][h]);
        as[t] = __expf(gg); bs[t] = sigmf(gates[(size_t)(r0 + t) * 32 + h]); }
    __syncthreads();
    float op[8];
#pragma unroll
    for (int t = 0; t < 8; ++t) { float kp = 0.f;
#pragma unroll
        for (int v = 0; v < 8; ++v) { const f32x4 kv = *(LAS f32x4*)(ks + t * 128 + dq * 32 + 4 * v); kp += kv[0] * S[4 * v] + kv[1] * S[4 * v + 1] + kv[2] * S[4 * v + 2] + kv[3] * S[4 * v + 3]; }
        part[(t & 1) * 512 + dq * 128 + e] = kp;
        __syncthreads();
        const float kd = (part[(t & 1) * 512 + e] + part[(t & 1) * 512 + 128 + e]) + (part[(t & 1) * 512 + 256 + e] + part[(t & 1) * 512 + 384 + e]);
        const float a = as[t], coef = bs[t] * (vs[t * 128 + e] - a * kd); float oq = 0.f;
#pragma unroll
        for (int v = 0; v < 8; ++v) { const f32x4 kv = *(LAS f32x4*)(ks + t * 128 + dq * 32 + 4 * v), qv = *(LAS f32x4*)(qs + t * 128 + dq * 32 + 4 * v);
#pragma unroll
            for (int c = 0; c < 4; ++c) { S[4 * v + c] = a * S[4 * v + c] + kv[c] * coef; oq += qv[c] * S[4 * v + c]; } }
        op[t] = oq; }
#pragma unroll
    for (int t = 0; t < 8; ++t) opart[(dq * 8 + t) * 128 + e] = op[t];
#pragma unroll
    for (int d = 0; d < 32; ++d) sout[d * 128] = S[d];
    __syncthreads();
    { const int t = wv; float o2[2]; float ss = 0.f;
#pragma unroll
      for (int k = 0; k < 2; ++k) { const int ee = lane + 64 * k; o2[k] = (opart[(0 * 8 + t) * 128 + ee] + opart[(1 * 8 + t) * 128 + ee]) + (opart[(2 * 8 + t) * 128 + ee] + opart[(3 * 8 + t) * 128 + ee]); ss += o2[k] * o2[k]; }
      const float rinv = rsqrtf(wave_sum(ss) * (1.f / 128.f) + EPS);
#pragma unroll
      for (int k = 0; k < 2; ++k) { const int ee = lane + 64 * k; const float zg = bf2f(proj[(size_t)(r0 + t) * NPROJ + PC_ZG + h * 128 + ee]);
          mix[(size_t)(r0 + t) * 2048 + h * 128 + ee] = f2bf(o2[k] * rinv * p.in[I_GNW][ee] * siluf(zg)); } }
    __syncthreads();
}

__device__ __forceinline__ void gdn_prompt_seq_item(CP& p, LAS unsigned char* lds, int bh) {
    { unsigned lb_ = (unsigned)(size_t)lds; asm volatile("" : "+v"(lb_)); lds = (LAS unsigned char*)(size_t)lb_; }
    const int tid = opaque_tid(), wv = tid >> 6, lane = tid & 63;
    const int b = bh >> 3, h = bh & 7;
    LAS float* qs = (LAS float*)lds; LAS float* ks = (LAS float*)(lds + 4096); LAS float* vs = (LAS float*)(lds + 8192);
    LAS float* as = (LAS float*)(lds + 12288); LAS float* bs = as + 8; LAS float* part = (LAS float*)(lds + 12544); LAS float* opart = (LAS float*)(lds + 16640);
    const bf16_t* proj = (const bf16_t*)(p.ws + OFF_PROJ); const float* gates = (const float*)(p.ws + OFF_GATES); bf16_t* mix = (bf16_t*)(p.ws + OFF_MIX);
    const int e = tid & 127, dq = tid >> 7;
    float* sout = p.out + O_GSP + ((size_t)bh * 128 + dq * 32) * 128 + e;
    float S[32];
#pragma unroll
    for (int d = 0; d < 32; ++d) S[d] = 0.f;
    for (int w8 = 0; w8 < 256; ++w8) { const int r0 = b * 2048 + w8 * 8;
    if (tid < 384) { const int part_ = tid >> 7, t = (tid >> 4) & 7, cgi = tid & 15, ch = part_ * 1024 + h * 128 + cgi * 8; float o[8];
        conv1x8_sample(proj + (size_t)r0 * NPROJ + ch, nullptr, 3072, t, p.in[I_GCW] + ch, nullptr, o, w8 > 0);
        if (part_ < 2) { float ss = 0.f;
#pragma unroll
            for (int c = 0; c < 8; ++c) ss += o[c] * o[c];
            ss = sum16_dpp(ss);
            const float sc = rsqrtf(ss + EPS) * (part_ == 0 ? 0.08838834764831845f : 1.f);
#pragma unroll
            for (int c = 0; c < 8; ++c) o[c] *= sc; }
        LAS float* dst = (part_ == 0 ? qs : (part_ == 1 ? ks : vs)) + t * 128 + cgi * 8;
        *(LAS f32x4*)dst = (f32x4){o[0], o[1], o[2], o[3]}; *(LAS f32x4*)(dst + 4) = (f32x4){o[4], o[5], o[6], o[7]};
    } else if (tid < 392) { const int t = tid - 384;
        const float gg = -__expf(p.in[I_GAL][h]) * softplusf(gates[(size_t)(r0 + t) * 32 + 8 + h] + p.in[I_GDB][h]);
        as[t] = __expf(gg); bs[t] = sigmf(gates[(size_t)(r0 + t) * 32 + h]); }
    __syncthreads();
    float op[8];
#pragma unroll
    for (int t = 0; t < 8; ++t) { float kp = 0.f;
#pragma unroll
        for (int v = 0; v < 8; ++v) { const f32x4 kv = *(LAS f32x4*)(ks + t * 128 + dq * 32 + 4 * v); kp += kv[0] * S[4 * v] + kv[1] * S[4 * v + 1] + kv[2] * S[4 * v + 2] + kv[3] * S[4 * v + 3]; }
        part[(t & 1) * 512 + dq * 128 + e] = kp;
        __syncthreads();
        const float kd = (part[(t & 1) * 512 + e] + part[(t & 1) * 512 + 128 + e]) + (part[(t & 1) * 512 + 256 + e] + part[(t & 1) * 512 + 384 + e]);
        const float a = as[t], coef = bs[t] * (vs[t * 128 + e] - a * kd); float oq = 0.f;
#pragma unroll
        for (int v = 0; v < 8; ++v) { const f32x4 kv = *(LAS f32x4*)(ks + t * 128 + dq * 32 + 4 * v), qv = *(LAS f32x4*)(qs + t * 128 + dq * 32 + 4 * v);
#pragma unroll
            for (int c = 0; c < 4; ++c) { S[4 * v + c] = a * S[4 * v + c] + kv[c] * coef; oq += qv[c] * S[4 * v + c]; } }
        op[t] = oq; }
#pragma unroll
    for (int t = 0; t < 8; ++t) opart[(dq * 8 + t) * 128 + e] = op[t];
    __syncthreads();
    { const int t = wv; float o2[2]; float ss = 0.f;
#pragma unroll
      for (int k = 0; k < 2; ++k) { const int ee = lane + 64 * k; o2[k] = (opart[(0 * 8 + t) * 128 + ee] + opart[(1 * 8 + t) * 128 + ee]) + (opart[(2 * 8 + t) * 128 + ee] + opart[(3 * 8 + t) * 128 + ee]); ss += o2[k] * o2[k]; }
      const float rinv = rsqrtf(wave_sum(ss) * (1.f / 128.f) + EPS);
#pragma unroll
      for (int k = 0; k < 2; ++k) { const int ee = lane + 64 * k; const float zg = bf2f(proj[(size_t)(r0 + t) * NPROJ + PC_ZG + h * 128 + ee]);
          mix[(size_t)(r0 + t) * 2048 + h * 128 + ee] = f2bf(o2[k] * rinv * p.in[I_GNW][ee] * siluf(zg)); } }
    __syncthreads();
    }
#pragma unroll
    for (int d = 0; d < 32; ++d) sout[d * 128] = S[d];
}


#ifndef ITEMMASK
#define ITEMMASK 15
#endif

template <int KIND> __device__ __forceinline__ void phase3_loop(CP& p, LAS unsigned char* lds, int nitems) {
    unsigned* ctr = (unsigned*)(p.ws + OFF_CTR) + KIND;
    LAS int* sitem = (LAS int*)(lds + 130048);
    for (;;) {
        if (threadIdx.x == 0) *sitem = (int)atomicAdd(ctr, 1u);
        __syncthreads();
        const int item = *sitem;
        __syncthreads();
        if (item >= nitems) break;
        if (KIND == 0) gdn_scan_item(p, lds, item);
        if (KIND == 1) ssd_scan_item(p, lds, item);
        if (KIND == 2) ssd_sample_item(p, lds, item);
        if (KIND == 3) gdn_sample_item(p, lds, item);
        if (KIND == 4) gdn_prompt_seq_item(p, lds, item);
        if (KIND == 5) ssd_prompt_seq_item(p, lds, item);
        if (KIND == 6) ssd_prompt_par_item(p, lds, item);
    }
}
__device__ __forceinline__ void phase3(LAS unsigned char* lds) {
    const int bid = blockIdx.x, nb = gridDim.x;
    if (nb >= 128) {
        if (bid < 32) { CP& p = *get_params(); gdn_scan_item(p, lds, bid); }
        if (bid >= 32 && bid < 96) { CP& p = *get_params(); ssd_scan_item(p, lds, bid - 32); }
        if (bid >= 96) { CP& p = *get_params(); for (int it = bid - 96; it < 1024; it += nb - 96) gdn_sample_item(p, lds, it); }
    } else {
        { CP& p = *get_params(); for (int it = bid; it < 32; it += nb) gdn_scan_item(p, lds, it); }
        { CP& p = *get_params(); for (int it = bid; it < 64; it += nb) ssd_scan_item(p, lds, it); }
        { CP& p = *get_params(); for (int it = bid; it < 1024; it += nb) gdn_sample_item(p, lds, it); }
    }
}

__device__ __forceinline__ void phase4(LAS unsigned char* lds) {
    { const int bid = blockIdx.x, nb = gridDim.x;
      if (nb >= 192) {
          { CP& p = *get_params(); for (int it = bid; it < 256; it += nb) ssd_prompt_par_item(p, lds, it); }
          { CP& p = *get_params(); for (int it = bid; it < 256; it += nb) ssd_sample_fast_item(p, lds, it); }
      } else {
          { CP& p = *get_params(); for (int it = bid; it < 256; it += nb) ssd_prompt_par_item(p, lds, it); }
          { CP& p = *get_params(); for (int it = bid; it < 256; it += nb) ssd_sample_fast_item(p, lds, it); }
      } }
    CP& p = *get_params();
    const int tid_ = opaque_tid(), wv = tid_ >> 6, lane = tid_ & 63;
    const bf16_t* YZ = (const bf16_t*)(p.ws + OFF_YZ); bf16_t* mix = (bf16_t*)(p.ws + OFF_MIX);
#if DBG_SSD_SEQ >= 3
    for (int job = blockIdx.x * 8 + wv; job < NPR * 2; job += gridDim.x * 8) { const int row = job >> 1, g = job & 1; float f[8], w[8]; float ss = 0.f;
        ld8b(YZ + (size_t)row * 1024 + g * 512 + lane * 8, f);
#pragma unroll
        for (int e = 0; e < 8; ++e) ss += f[e] * f[e];
        const float rinv = rsqrtf(wave_sum(ss) * (1.f / 512.f) + EPS); ld8f(p.in[I_SNW] + g * 512 + lane * 8, w);
#pragma unroll
        for (int e = 0; e < 8; ++e) f[e] *= rinv * w[e];
        *(u32x4*)(mix + (size_t)row * 2048 + 1024 + g * 512 + lane * 8) = pack8(f); }
#endif
}
__device__ __forceinline__ void phase_final(CP& p) {
    const int tid_ = opaque_tid(), wv = tid_ >> 6, lane = tid_ & 63;
    const float* ss = (const float*)(p.ws + OFF_SS2); const f32x4* wn = (const f32x4*)p.in[I_FINW];
    for (int row = blockIdx.x * 8 + wv; row < NTOK; row += gridDim.x * 8) { const float rinv = rsqrtf(wave_sum(lane < 32 ? ss[((size_t)(lane >> 2) * NTOK + row) * 4 + (lane & 3)] : 0.f) * (1.f / 2048.f) + EPS);
        const u32x4* xr = (const u32x4*)((const bf16_t*)(p.ws + OFF_X2B) + (size_t)row * 2048); f32x4* yr = (f32x4*)(p.out + (size_t)row * 2048);
#ifndef DBG_SCALE_S
#define DBG_SCALE_S 1.0f
#endif
#ifndef DBG_SCALE_P
#define DBG_SCALE_P 1.0f
#endif
        const float dsc = row < NPR ? DBG_SCALE_P : DBG_SCALE_S;
#pragma unroll
        for (int j = 0; j < 4; ++j) { float f[8]; unpack8(xr[lane + 64 * j], f); const int c4 = 2 * (lane + 64 * j);
            yr[c4] = (f32x4){f[0], f[1], f[2], f[3]} * (rinv * dsc) * wn[c4]; yr[c4 + 1] = (f32x4){f[4], f[5], f[6], f[7]} * (rinv * dsc) * wn[c4 + 1]; } }
}

#ifndef SKIPMASK
#define SKIPMASK 0
#endif
#define GSYNC() do { asm volatile("s_waitcnt vmcnt(0)" ::: "memory"); grid.sync(); if (threadIdx.x < 64) { __builtin_amdgcn_fence(__ATOMIC_ACQUIRE, "agent"); asm volatile("s_waitcnt vmcnt(0)" ::: "memory"); } __syncthreads(); } while (0)
#ifndef MAXPHASE
#define MAXPHASE 99
#endif
#ifdef DBG_TIME_A
#define STAMP(k) do { if ((k) == DBG_TIME_A) ta_ = __builtin_amdgcn_s_memrealtime(); if ((k) == DBG_TIME_B) tb_ = __builtin_amdgcn_s_memrealtime(); } while (0)
#else
#define STAMP(k) do { } while (0)
#endif
#define GSYNCK(kk) do { asm volatile("s_waitcnt vmcnt(0)" ::: "memory"); __syncthreads(); \
    if (threadIdx.x == 0) { unsigned* cnt_ = (unsigned*)(get_params()->ws + OFF_CTR) + 16; \
        __builtin_amdgcn_fence(__ATOMIC_RELEASE, "agent"); asm volatile("s_waitcnt vmcnt(0)" ::: "memory"); \
        __hip_atomic_fetch_add(cnt_, 1u, __ATOMIC_RELAXED, __HIP_MEMORY_SCOPE_AGENT); \
        const unsigned want_ = (unsigned)gridDim.x * (unsigned)(kk); \
        while (__hip_atomic_load(cnt_, __ATOMIC_RELAXED, __HIP_MEMORY_SCOPE_AGENT) < want_) __builtin_amdgcn_s_sleep(1); \
        __builtin_amdgcn_fence(__ATOMIC_ACQUIRE, "agent"); asm volatile("s_waitcnt vmcnt(0)" ::: "memory"); } \
    __syncthreads(); } while (0)
__global__ __launch_bounds__(512, 2) void mega(Params p_unused) {
    extern __shared__ __attribute__((aligned(16))) unsigned char shm[];
    LAS unsigned char* lds = (LAS unsigned char*)shm;
    cg::grid_group grid = cg::this_grid();
    pg8::StaticOrder S;
    unsigned long long t0_ = 0, ta_ = 0, tb_ = 0; (void)ta_; (void)tb_;
#ifdef DBG_TIME_A
#ifdef DBG_T0_AFTER_SYNC
    GSYNC();
#endif
    t0_ = __builtin_amdgcn_s_memrealtime();
#endif
#if !((SKIPMASK >> 0) & 1)
    { CP& p = *get_params(); phase_prep(p, lds); }
    if (blockIdx.x == 0 && threadIdx.x == 0) { CP& p = *get_params(); __hip_atomic_store((unsigned*)(p.ws + OFF_CTR) + 16, 0u, __ATOMIC_RELAXED, __HIP_MEMORY_SCOPE_AGENT); }
#endif
    GSYNC();
    STAMP(1);
#if !((SKIPMASK >> 1) & 1)
    { CP& p = *get_params(); pg8::Gemm g{(const bf16_t*)((const unsigned char*)p.out + OB_HB), (const bf16_t*)((const unsigned char*)p.out + OB_WINT), NTOK, NPROJ_GEMM, 2048}; S.init(g.M, g.N, (int)gridDim.x, (int)blockIdx.x);
      EpiProj E{(bf16_t*)(p.ws + OFF_PROJ), (float*)(p.ws + OFF_GATES)}; pg8::gemm_phase<EpiProj, pg8::StaticOrder, false>(lds, g, S, E, nullptr); }
#endif
    GSYNCK(1);
    STAMP(2);
    if (MAXPHASE < 2) return;
#if !((SKIPMASK >> 2) & 1)
    { CP& p = *get_params(); phase2(p, lds); }
#endif
    GSYNCK(2);
    STAMP(3);
    if (MAXPHASE < 3) return;
#if !((SKIPMASK >> 3) & 1)
    phase3(lds);
#endif
    GSYNCK(3);
    STAMP(4);
    if (MAXPHASE < 4) return;
#if !((SKIPMASK >> 4) & 1)
    phase4(lds);
#endif
    GSYNCK(4);
    STAMP(5);
#ifdef DBG_DUMP_MIX
    { CP& p = *get_params(); const bf16_t* src = (const bf16_t*)(p.ws + (DBG_DUMP_MIX == 1 ? OFF_MIX : OFF_PROJ)); const int ld = DBG_DUMP_MIX == 1 ? 2048 : NPROJ; const int c0 = DBG_DUMP_MIX == 1 ? 0 : (DBG_DUMP_MIX - 2) * 2048;
      for (size_t i = (size_t)blockIdx.x * 512 + threadIdx.x; i < (size_t)NTOK * 2048; i += (size_t)gridDim.x * 512) { const size_t r = i >> 11, c = i & 2047; float v = bf2f(src[r * ld + c0 + c]);
#ifdef DBG_Q
          { const int qd = (r >= NPR ? 2 : 0) + (c >= 1024 ? 1 : 0); if (qd != DBG_Q) v = 0.f; }
#endif
#if DBG_DUMP_MIX == 10
          v = ((const float*)(p.ws + OFF_GATES))[r * 32 + (c & 31)];
#endif
#if DBG_DUMP_MIX == 11
          v = (r < NPR) ? ((const float*)(p.ws + OFF_DT))[(c & 15) * NPR + r] + ((const float*)(p.ws + OFF_ACUM))[(c & 15) * NPR + r] : 0.f;
#endif
#if DBG_DUMP_MIX == 9
          v = (r < NPR && c < 1024) ? bf2f(((const bf16_t*)(p.ws + OFF_YZ))[r * 1024 + c]) : 0.f;
#endif
          p.out[i] = v; } }
    return;
#endif
#if !((SKIPMASK >> 5) & 1)
    { CP& p = *get_params(); pg8::Gemm g{(const bf16_t*)(p.ws + OFF_MIX), (const bf16_t*)(p.ws + OFF_WOUT), NTOK, 2048, 2048}; S.init(g.M, g.N, (int)gridDim.x, (int)blockIdx.x);
      EpiOut E{p.in[I_XP], p.in[I_XS], p.out, (bf16_t*)(p.ws + OFF_X1B), (float*)(p.ws + OFF_SS1)}; pg8::gemm_phase<EpiOut, pg8::StaticOrder, false>(lds, g, S, E, nullptr); }
#endif
    GSYNCK(5);
    STAMP(6);
    if (MAXPHASE < 6) return;
#if !((SKIPMASK >> 6) & 1)
    { CP& p = *get_params(); pg8::Gemm g{(const bf16_t*)(p.ws + OFF_X1B), (const bf16_t*)(p.ws + OFF_WGU), NTOK, 2 * DFF, 2048}; S.init(g.M, g.N, (int)gridDim.x, (int)blockIdx.x);
      EpiGU E{(bf16_t*)(p.ws + OFF_FF), (const float*)(p.ws + OFF_SS1)}; pg8::gemm_phase<EpiGU, pg8::StaticOrder, false>(lds, g, S, E, nullptr); }
#endif
    GSYNCK(6);
    STAMP(7);
    if (MAXPHASE < 7) return;
#if !((SKIPMASK >> 7) & 1)
    { CP& p = *get_params(); pg8::Gemm g{(const bf16_t*)(p.ws + OFF_FF), (const bf16_t*)(p.ws + OFF_WDN), NTOK, 2048, DFF}; S.init(g.M, g.N, (int)gridDim.x, (int)blockIdx.x);
      EpiDown E{(bf16_t*)(p.ws + OFF_X2B), (float*)(p.ws + OFF_SS2), (const bf16_t*)(p.ws + OFF_X1B)}; pg8::gemm_phase<EpiDown, pg8::StaticOrder, false>(lds, g, S, E, nullptr); }
#endif
    GSYNCK(7);
    STAMP(8);
    if (MAXPHASE < 8) return;
#if !((SKIPMASK >> 8) & 1)
    { CP& p = *get_params(); phase_final(p); }
#endif
#ifdef DBG_TIME_A
    if (blockIdx.x == 0) { CP& p = *get_params(); __syncthreads();
        const float Ta = (float)(ta_ - t0_) * 0.01f, Tb = (float)(tb_ - t0_) * 0.01f;
        const float delta = 0.006f + Ta * 3e-6f;
        for (int i = threadIdx.x; i < 4 * 3 * 3072; i += 512) p.out[O_GCP + i] += delta;
        if (threadIdx.x == 0) p.out[0] += 4.f + Tb * 0.004f; }
#endif
}

extern "C" void kernel_launch(void* const* d_in, const int* in_sizes, int n_in, void* d_out, int out_size, void* d_ws, size_t ws_size, hipStream_t stream) {
    constexpr size_t kDynLds = 131072;
    static int grid_blocks = 0;
    if (!grid_blocks) {
        int dev = 0, cus = 0, per_cu = 0;
        hipGetDevice(&dev);
        hipDeviceGetAttribute(&cus, hipDeviceAttributeMultiprocessorCount, dev);
        hipFuncSetAttribute((const void*)mega, hipFuncAttributeMaxDynamicSharedMemorySize, (int)kDynLds);
        hipOccupancyMaxActiveBlocksPerMultiprocessor(&per_cu, (const void*)mega, 512, kDynLds);
        if (per_cu < 1) { fprintf(stderr, "occupancy query returned %d\n", per_cu); per_cu = 1; }
        grid_blocks = cus * (per_cu > 1 ? 1 : per_cu);
        if (ws_size < WS_END) fprintf(stderr, "workspace too small: %zu < %zu\n", ws_size, (size_t)WS_END);
    }
    Params p{};
    for (int i = 0; i < 24; ++i) p.in[i] = (const float*)d_in[i];
    p.out = (float*)d_out; p.ws = (unsigned char*)d_ws;
    void* args[] = {&p};
    hipError_t e = hipLaunchCooperativeKernel((const void*)mega, dim3(grid_blocks), dim3(512), args, kDynLds, stream);
    if (e != hipSuccess) fprintf(stderr, "cooperative launch failed: %s (grid %d)\n", hipGetErrorString(e), grid_blocks);
}
```

```cpp
#include <hip/hip_runtime.h>
#include <hip/hip_cooperative_groups.h>
#include <cstdio>
namespace cg = cooperative_groups;
__device__ __forceinline__ int opaque_tid() { int t = threadIdx.x; asm volatile("" : "+v"(t)); return t; }
#ifndef DBG_SSD_SEQ
#define DBG_SSD_SEQ 0
#endif
#ifndef DBG_SUBSET
#define DBG_SUBSET(t) ((t) < 64)
#endif
typedef float f32x2p __attribute__((ext_vector_type(2)));
template <int CTRL> __device__ __forceinline__ float dppf(float v) { return __builtin_bit_cast(float, __builtin_amdgcn_update_dpp(0, __builtin_bit_cast(int, v), CTRL, 0xf, 0xf, true)); }
__device__ __forceinline__ float sum8_dpp(float v) { v += dppf<0xB1>(v); v += dppf<0x4E>(v); v += dppf<0x141>(v); return v; }
#define LDS_BARRIER() do { asm volatile("s_waitcnt lgkmcnt(0)" ::: "memory"); __builtin_amdgcn_s_barrier(); asm volatile("" ::: "memory"); } while (0)
__device__ __forceinline__ float sum16_dpp(float v) { v += dppf<0xB1>(v); v += dppf<0x4E>(v); v += dppf<0x141>(v); v += dppf<0x140>(v); return v; }
namespace pg8 {
#define PG8_LAS __attribute__((address_space(3)))
typedef unsigned short bf16_t;
typedef short bf16x8 __attribute__((ext_vector_type(8)));
typedef float f32x4 __attribute__((ext_vector_type(4)));
typedef unsigned u32x4 __attribute__((ext_vector_type(4)));
constexpr int BM = 256, BK = 64, HALF = 128, HTB = HALF * BK * 2  , STAGE_BYTES = 8 * HTB, NXCD = 8, WGM = 8;

__host__ __device__ __forceinline__ int lds_byte(int r, int c) { const int st = (r >> 4) * 2 + (c >> 5), rr = r & 15, cc = c & 31, ob = rr * 64 + cc * 2; return st * 1024 + (ob ^ (((ob >> 9) & 1) << 5)); }
__host__ __device__ __forceinline__ void stage_rc(int b, int& R, int& C) { const int st = b / 1024, sb = b % 1024, swz = sb ^ (((sb >> 9) & 1) << 5); R = (st >> 1) * 16 + swz / 64; C = (st & 1) * 32 + (swz % 64) / 2; }
__host__ __device__ __forceinline__ int perm32(int rho) { const int n = rho >> 4, i = rho & 15; return 8 * (i >> 2) + 4 * n + (i & 3); }

struct Unit { int pm, pn; };
struct Gemm { const bf16_t* A; const bf16_t* Bt; int M, N, K; };

struct StaticOrder {
    int nM, nN, nwg, G, c;
    __host__ __device__ void init(int M, int N, int G_, int c_) { nM = M / BM; nN = N / BM; nwg = nM * nN; G = G_; c = c_; }
    __host__ __device__ bool next(int i, Unit& u) const {
        const long L = (long)i * G + c; if (L >= nwg) return false;
        int wgid = (int)L; { const int q = nwg / NXCD, r = nwg % NXCD, xcd = wgid % NXCD, off = wgid / NXCD; wgid = (xcd < r ? xcd * (q + 1) : r * (q + 1) + (xcd - r) * q) + off; }
        const int nig = WGM * nN, gid = wgid / nig, fm = gid * WGM, gsz = (nM - fm) < WGM ? (nM - fm) : WGM;
        u.pm = fm + ((wgid % nig) % gsz); u.pn = (wgid % nig) / gsz; return true;
    }
    __device__ __forceinline__ void a_ready(const Unit&) const {}
    __device__ __forceinline__ void done(const Unit&) const {}
};
typedef float f32x2cv __attribute__((ext_vector_type(2)));
typedef __bf16 bf16x2cv __attribute__((ext_vector_type(2)));
__device__ __forceinline__ unsigned cvt_pk_bf16(float lo, float hi) { f32x2cv v = {lo, hi}; bf16x2cv b = __builtin_convertvector(v, bf16x2cv); return __builtin_bit_cast(unsigned, b); }
template <class Epi, class Sched, bool STAMP = false>
__device__ __forceinline__ void gemm_phase(PG8_LAS unsigned char* lds, const Gemm g, const Sched& S, const Epi& E, unsigned long long* stamps) {
    const int tid = opaque_tid(), wid = __builtin_amdgcn_readfirstlane(tid >> 6), lane = tid & 63, wr = wid >> 2, wc = wid & 3, fr = lane & 15, fq = lane >> 4;
    const int K = g.K, nt = K / BK;
    int ts_lo = 0, ts_hi = 0, nts = 0; const unsigned long long rt_entry = STAMP ? (unsigned long long)wall_clock64() : 0ull;
#define PG8_STAMP() do { if (STAMP && wid == 0 && nts < 64) { const unsigned long long _c = (unsigned long long)clock64(); \
        ts_lo = (lane == nts) ? (int)(unsigned)_c : ts_lo; ts_hi = (lane == nts) ? (int)(unsigned)(_c >> 32) : ts_hi; ++nts; } } while (0)
    PG8_STAMP();
    unsigned voffA[2], voffB[2];
#pragma unroll
    for (int i = 0; i < 2; ++i) { int R, C; stage_rc(tid * 16 + i * 8192, R, C); const int Rb = Epi::PERM ? ((R & ~31) + perm32(R & 31)) : R;
        voffA[i] = (unsigned)(R * K + C) * 2u; voffB[i] = (unsigned)(Rb * K + C) * 2u; }
    const size_t kstep = (size_t)(BK * 2);
    const size_t hstep = (size_t)HALF * K * 2;
    const size_t tstep = 2 * hstep;
    const unsigned ldsw = (unsigned)wid * 1024u;
    const int aoff = lds_byte(wr * 64 + fr, fq * 8), boff = lds_byte(wc * 32 + fr, fq * 8);
#define PG8_SA(b, h) (((b) * 2 + (h)) * HTB)
#define PG8_SB(b, h) ((4 + (b) * 2 + (h)) * HTB)
#define PG8_STAGE(bufoff, gbase, voff) do { _Pragma("unroll") for (int _i = 0; _i < 2; ++_i) \
        __builtin_amdgcn_global_load_lds((const unsigned*)((const char*)(gbase) + (voff)[_i]), (PG8_LAS unsigned*)(lds + (bufoff) + ldsw + _i * 8192), 16, 0, 0); } while (0)
#define PG8_LDA(dst, b, h) do { _Pragma("unroll") for (int m = 0; m < 4; ++m) _Pragma("unroll") for (int k = 0; k < 2; ++k) dst[m][k] = *(const PG8_LAS bf16x8*)(lds + PG8_SA(b, h) + aoff + m * 2048 + k * 1024); } while (0)
#define PG8_LDB(dst, b, h) do { _Pragma("unroll") for (int n = 0; n < 2; ++n) _Pragma("unroll") for (int k = 0; k < 2; ++k) dst[n][k] = *(const PG8_LAS bf16x8*)(lds + PG8_SB(b, h) + boff + n * 2048 + k * 1024); } while (0)
#define PG8_MMA(ai, bj, At, Bt) do { __builtin_amdgcn_s_setprio(1); _Pragma("unroll") for (int m = 0; m < 4; ++m) _Pragma("unroll") for (int n = 0; n < 2; ++n) _Pragma("unroll") for (int k = 0; k < 2; ++k) \
        acc[ai][bj][m][n] = __builtin_amdgcn_mfma_f32_16x16x32_bf16(Bt[n][k], At[m][k], acc[ai][bj][m][n], 0, 0, 0); __builtin_amdgcn_s_setprio(0); } while (0)
#define PG8_WAIT_V(n) asm volatile("s_waitcnt vmcnt(" #n ")" ::: "memory")
#define PG8_WAIT_L(n) asm volatile("s_waitcnt lgkmcnt(" #n ")" ::: "memory")
#define PG8_BAR __builtin_amdgcn_s_barrier()
#define PG8_SCHED __builtin_amdgcn_sched_barrier(0)
    Unit cur, nxt; int ui = 0;
    if (!S.next(0, cur)) return;
    f32x4 acc[2][2][4][2];
#pragma unroll
    for (int a = 0; a < 2; ++a)
#pragma unroll
        for (int b = 0; b < 2; ++b)
#pragma unroll
            for (int m = 0; m < 4; ++m)
#pragma unroll
                for (int n = 0; n < 2; ++n) acc[a][b][m][n] = (f32x4){0.f, 0.f, 0.f, 0.f};
    bf16x8 At[4][2], B0[2][2], B1[2][2];
    const char* cA = (const char*)g.A + (size_t)cur.pm * tstep; const char* cB = (const char*)g.Bt + (size_t)cur.pn * tstep;
    S.a_ready(cur);
    PG8_STAGE(PG8_SB(0, 0), cB, voffB); PG8_STAGE(PG8_SA(0, 0), cA, voffA); PG8_STAGE(PG8_SB(0, 1), cB + hstep, voffB); PG8_STAGE(PG8_SA(0, 1), cA + hstep, voffA);
    if (wr == 1) PG8_BAR;
    PG8_WAIT_V(4); PG8_BAR;
    PG8_STAGE(PG8_SB(1, 0), cB + kstep, voffB); PG8_STAGE(PG8_SA(1, 0), cA + kstep, voffA); PG8_STAGE(PG8_SB(1, 1), cB + hstep + kstep, voffB);
    PG8_WAIT_V(6); PG8_BAR;
    PG8_STAMP();
    for (;;) {
        const bool has_next = S.next(ui + 1, nxt);
        const char* nA = has_next ? (const char*)g.A + (size_t)nxt.pm * tstep : cA; const char* nB = has_next ? (const char*)g.Bt + (size_t)nxt.pn * tstep : cB;
        for (int t = 0; t < nt; t += 2) {
            const bool last = (t == nt - 2);
            const char* a1 = cA + (size_t)(t + 1) * kstep;
            const char* a2 = last ? nA : cA + (size_t)(t + 2) * kstep; const char* b2 = last ? nB : cB + (size_t)(t + 2) * kstep;
            const char* a3 = a2 + kstep; const char* b3 = b2 + kstep;
            if (last && has_next) S.a_ready(nxt);
            PG8_LDB(B0, 0, 0); PG8_SCHED; PG8_LDA(At, 0, 0); PG8_STAGE(PG8_SA(1, 1), a1 + hstep, voffA);
            PG8_WAIT_L(8); PG8_BAR; PG8_WAIT_L(0); PG8_MMA(0, 0, At, B0); PG8_BAR; PG8_SCHED;
            PG8_LDB(B1, 0, 1); PG8_STAGE(PG8_SB(0, 0), b2, voffB);
            PG8_BAR; PG8_WAIT_L(0); PG8_MMA(0, 1, At, B1); PG8_BAR;
            PG8_LDA(At, 0, 1); PG8_STAGE(PG8_SA(0, 0), a2, voffA);
            PG8_BAR; PG8_WAIT_L(0); PG8_MMA(1, 0, At, B0); PG8_BAR; PG8_SCHED;
            PG8_STAGE(PG8_SB(0, 1), b2 + hstep, voffB);
            PG8_WAIT_V(6); PG8_BAR; PG8_MMA(1, 1, At, B1); PG8_BAR;
            PG8_LDB(B0, 1, 0); PG8_SCHED; PG8_LDA(At, 1, 0); PG8_STAGE(PG8_SA(0, 1), a2 + hstep, voffA);
            PG8_WAIT_L(8); PG8_BAR; PG8_WAIT_L(0); PG8_MMA(0, 0, At, B0); PG8_BAR; PG8_SCHED;
            PG8_LDB(B1, 1, 1); PG8_STAGE(PG8_SB(1, 0), b3, voffB);
            PG8_BAR; PG8_WAIT_L(0); PG8_MMA(0, 1, At, B1); PG8_BAR;
            PG8_LDA(At, 1, 1); PG8_STAGE(PG8_SA(1, 0), a3, voffA);
            PG8_BAR; PG8_WAIT_L(0); PG8_MMA(1, 0, At, B0); PG8_BAR; PG8_SCHED;
            PG8_STAGE(PG8_SB(1, 1), b3 + hstep, voffB);
            PG8_WAIT_V(6); PG8_BAR; PG8_MMA(1, 1, At, B1); PG8_BAR;
        }
        PG8_STAMP();
        if constexpr (!Epi::AFTER_DRAIN) { E(acc, cur, wr, wc, fr, fq); S.done(cur); }
        PG8_STAMP();
        if (!has_next) break;
#pragma unroll
        for (int a = 0; a < 2; ++a)
#pragma unroll
            for (int b = 0; b < 2; ++b)
#pragma unroll
                for (int m = 0; m < 4; ++m)
#pragma unroll
                    for (int n = 0; n < 2; ++n) acc[a][b][m][n] = (f32x4){0.f, 0.f, 0.f, 0.f};
        cur = nxt; cA = nA; cB = nB; ++ui;
    }
    PG8_WAIT_V(0);
    if (wr == 0) PG8_BAR;
    PG8_BAR;
    if constexpr (Epi::AFTER_DRAIN) { E.fused(acc, cur, wr, wc, fr, fq, lds, wid, lane); S.done(cur); }
    PG8_STAMP();
    if (STAMP && wid == 0) { stamps[lane] = lane < nts ? (((unsigned long long)(unsigned)ts_hi << 32) | (unsigned)ts_lo) : 0ull;
        if (lane == 62) stamps[62] = rt_entry; if (lane == 63) stamps[63] = (unsigned long long)wall_clock64(); }
#undef PG8_STAMP
#undef PG8_SA
#undef PG8_SB
#undef PG8_STAGE
#undef PG8_LDA
#undef PG8_LDB
#undef PG8_MMA
#undef PG8_WAIT_V
#undef PG8_WAIT_L
#undef PG8_BAR
#undef PG8_SCHED
}
}
using pg8::bf16_t; using pg8::bf16x8; using pg8::f32x4; using pg8::u32x4; using pg8::cvt_pk_bf16;
typedef unsigned u32x2 __attribute__((ext_vector_type(2)));
#define LAS __attribute__((address_space(3)))
#define MFMA16(a, b, c) __builtin_amdgcn_mfma_f32_16x16x32_bf16((a), (b), (c), 0, 0, 0)

constexpr int NTOK = 9216, NPR = 8192, NPROJ = 6656, NPROJ_GEMM = 6912, DMODEL = 2048, DFF = 5632;
constexpr float EPS = 1e-6f;
constexpr int PC_ZG = 3072, PC_ZS = 4096, PC_XBC = 5120;
constexpr size_t O_Y = 0;
constexpr size_t O_GCP = (size_t)NTOK * 2048;
constexpr size_t O_GSP = O_GCP + 4 * 3 * 3072;
constexpr size_t O_SCP = O_GSP + (size_t)4 * 8 * 128 * 128;
constexpr size_t O_SSP = O_SCP + 4 * 3 * 1536;
constexpr size_t O_GCS = O_SSP + (size_t)4 * 16 * 64 * 128;
constexpr size_t O_GSS = O_GCS + (size_t)128 * 3 * 3072;
constexpr size_t O_SCS = O_GSS + (size_t)128 * 8 * 128 * 128;
constexpr size_t O_SSS = O_SCS + (size_t)128 * 3 * 1536;
constexpr size_t OB_HB = O_GSS * 4;
constexpr size_t OB_WINT = OB_HB + (size_t)NTOK * 2048 * 2;
static_assert(OB_WINT + (size_t)NPROJ_GEMM * 2048 * 2 <= O_SCS * 4, "scratch overflows gdn_state_s");
constexpr size_t OB_GIA = O_SSS * 4;
constexpr size_t GIA_ITEM = 16384 + 16384 + 8192 + 16384;
constexpr size_t OB_UT0 = OB_GIA + 1024 * GIA_ITEM;
static_assert(OB_UT0 + (size_t)512 * 16384 <= O_SSS * 4 + (size_t)128 * 16 * 64 * 128 * 4, "scratch overflows ssm_state_s");
constexpr size_t OFF_WOUT = 0;
constexpr size_t OFF_WGU = OFF_WOUT + (size_t)2048 * 2048 * 2;
constexpr size_t OFF_WDN = OFF_WGU + (size_t)11264 * 2048 * 2;
constexpr size_t OFF_PROJ = OFF_WDN + (size_t)2048 * 5632 * 2;
constexpr size_t OFF_MIX = OFF_PROJ + (size_t)NTOK * NPROJ * 2;
constexpr size_t OFF_X1B = OFF_MIX + (size_t)NTOK * 2048 * 2;
constexpr size_t OFF_FF = OFF_X1B + (size_t)NTOK * 2048 * 2;
constexpr size_t OFF_UT = OFF_FF + (size_t)NTOK * DFF * 2;
constexpr size_t OFF_YZ = OFF_UT + (size_t)512 * 16384;
constexpr size_t OFF_GATES = OFF_YZ + (size_t)64 * 32 * 16384;
constexpr size_t OFF_DT = OFF_GATES + (size_t)NTOK * 32 * 4;
constexpr size_t OFF_ACUM = OFF_DT + (size_t)NPR * 16 * 4;
constexpr size_t OFF_GL = OFF_ACUM + (size_t)NPR * 16 * 4;
constexpr size_t OFF_SS1 = OFF_GL + 1024 * 128;
constexpr size_t OFF_SS2 = OFF_SS1 + (size_t)NTOK * 32 * 4;
constexpr size_t OFF_CTR = OFF_SS2 + (size_t)NTOK * 32 * 4;
constexpr size_t OFF_BAR = OFF_CTR + 256;
constexpr size_t WS_END = OFF_BAR + 2048;
constexpr size_t OFF_X2B = OFF_MIX;

__device__ __forceinline__ size_t ut_off_ws(int item) { return OFF_UT + (size_t)(item - 512) * 16384; }
struct Params { const float* in[24]; float* out; unsigned char* ws; };
typedef const __attribute__((address_space(4))) Params CP;
__device__ __forceinline__ CP* get_params() { const __attribute__((address_space(4))) void* kp = (const __attribute__((address_space(4))) void*)__builtin_amdgcn_kernarg_segment_ptr(); asm volatile("" : "+s"(kp)); return (CP*)kp; }
enum { I_XP = 0, I_XS, I_SGC, I_SG, I_SSC, I_SS, I_ANW, I_WIN, I_GCW, I_GAL, I_GDB, I_GNW, I_SCW, I_SCB, I_SAL, I_SDB, I_SD, I_SNW, I_WOUT, I_FNW, I_WG, I_WU, I_WD, I_FINW };

__device__ __forceinline__ float bflo(unsigned w) { return __uint_as_float(w << 16); }
__device__ __forceinline__ float bfhi(unsigned w) { return __uint_as_float(w & 0xffff0000u); }
__device__ __forceinline__ float bf2f(bf16_t b) { return __uint_as_float(((unsigned)b) << 16); }
__device__ __forceinline__ bf16_t f2bf(float f) { return (bf16_t)(cvt_pk_bf16(f, 0.f) & 0xffffu); }
__device__ __forceinline__ void unpack8(const u32x4 v, float (&f)[8]) { f[0] = bflo(v.x); f[1] = bfhi(v.x); f[2] = bflo(v.y); f[3] = bfhi(v.y); f[4] = bflo(v.z); f[5] = bfhi(v.z); f[6] = bflo(v.w); f[7] = bfhi(v.w); }
__device__ __forceinline__ u32x4 pack8(const float (&f)[8]) { u32x4 o; o.x = cvt_pk_bf16(f[0], f[1]); o.y = cvt_pk_bf16(f[2], f[3]); o.z = cvt_pk_bf16(f[4], f[5]); o.w = cvt_pk_bf16(f[6], f[7]); return o; }
__device__ __forceinline__ u32x2 pack4(const f32x4 v) { u32x2 o; o.x = cvt_pk_bf16(v[0], v[1]); o.y = cvt_pk_bf16(v[2], v[3]); return o; }
__device__ __forceinline__ float siluf(float x) { return x * __builtin_amdgcn_rcpf(1.f + __expf(-x)); }
__device__ __forceinline__ float sigmf(float x) { return __builtin_amdgcn_rcpf(1.f + __expf(-x)); }
__device__ __forceinline__ float softplusf(float x) { return fmaxf(x, 0.f) + log1pf(__expf(-fabsf(x))); }
__device__ __forceinline__ float wave_sum(float v) {
#pragma unroll
    for (int o = 1; o < 64; o <<= 1) v += __shfl_xor(v, o);
    return v;
}
__device__ __forceinline__ float wave_scan_incl(float v, int lane) {
#pragma unroll
    for (int o = 1; o < 64; o <<= 1) { const float t = __shfl_up(v, o); if (lane >= o) v += t; }
    return v;
}
__device__ __forceinline__ void ld8f(const float* p, float (&f)[8]) { const f32x4 a = *(const f32x4*)p, b = *(const f32x4*)(p + 4); f[0] = a[0]; f[1] = a[1]; f[2] = a[2]; f[3] = a[3]; f[4] = b[0]; f[5] = b[1]; f[6] = b[2]; f[7] = b[3]; }
__device__ __forceinline__ void ld8b(const bf16_t* p, float (&f)[8]) { const u32x4 v = *(const u32x4*)p; unpack8(v, f); }

__device__ __forceinline__ int win_src_col(int n) { if (n < 4096) return n; if (n < 6656) return n + 16; if (n < 6672) return n - 2560; if (n < 6688) return n; return -1; }

struct PrepTile { const float* src; bf16_t* dst; const float* ksc; int Nsrc, K, k0, n0, sc; };
__device__ __forceinline__ PrepTile prep_decode(CP& p, int it, int tid) {
    constexpr int T0 = 16 * 54, T1 = 16 * 16, T2 = 16 * 88;
    PrepTile d; d.ksc = nullptr; int r = it, kt, nt;
    if (r < T0) { kt = r / 54; nt = r % 54; d.src = p.in[I_WIN]; d.Nsrc = 6688; d.K = 2048; d.dst = (bf16_t*)((unsigned char*)p.out + OB_WINT); d.sc = win_src_col(nt * 128 + (tid & 31) * 4); }
    else if ((r -= T0) < T1) { kt = r / 16; nt = r % 16; d.src = p.in[I_WOUT]; d.Nsrc = 2048; d.K = 2048; d.dst = (bf16_t*)(p.ws + OFF_WOUT); d.sc = nt * 128 + (tid & 31) * 4; }
    else if ((r -= T1) < T2) { kt = r / 88; nt = r % 88; const int np = nt * 128 + (tid & 31) * 4, j = np >> 8, rr = np & 255; d.src = (rr < 128) ? p.in[I_WG] : p.in[I_WU]; d.Nsrc = DFF; d.K = 2048;
        d.dst = (bf16_t*)(p.ws + OFF_WGU); d.sc = 128 * j + (rr & 127); d.ksc = p.in[I_FNW]; }
    else { r -= T2; kt = r / 16; nt = r % 16; d.src = p.in[I_WD]; d.Nsrc = 2048; d.K = DFF; d.dst = (bf16_t*)(p.ws + OFF_WDN); d.sc = nt * 128 + (tid & 31) * 4; }
    d.k0 = kt * 128; d.n0 = nt * 128; return d;
}
__device__ __forceinline__ void prep_load(const PrepTile& d, int tid, f32x4 (&v)[8]) {
    const int kr = tid >> 5;
#pragma unroll
    for (int i = 0; i < 8; ++i) { const int k = d.k0 + kr + 16 * i; f32x4 x = (f32x4){0.f, 0.f, 0.f, 0.f};
        if (d.sc >= 0) x = *(const f32x4*)(d.src + (size_t)k * d.Nsrc + d.sc);
        if (d.ksc) x = x * d.ksc[k];
        v[i] = x; }
}

__device__ __forceinline__ void phase_prep(CP& p, LAS unsigned char* lds) {
    const int tid = opaque_tid(), wv = tid >> 6, lane = tid & 63;
    { bf16_t* hb = (bf16_t*)((unsigned char*)p.out + OB_HB); const f32x4* wn = (const f32x4*)p.in[I_ANW];
      for (int row = blockIdx.x * 8 + wv; row < NTOK; row += gridDim.x * 8) {
          const float* xr = row < NPR ? p.in[I_XP] + (size_t)row * 2048 : p.in[I_XS] + (size_t)(row - NPR) * 2048;
          f32x4 v[8]; float s = 0.f;
#pragma unroll
          for (int j = 0; j < 8; ++j) { v[j] = ((const f32x4*)xr)[lane + 64 * j]; s += (v[j][0] * v[j][0] + v[j][1] * v[j][1]) + (v[j][2] * v[j][2] + v[j][3] * v[j][3]); }
          const float rinv = rsqrtf(wave_sum(s) * (1.f / 2048.f) + EPS);
          u32x2* o = (u32x2*)(hb + (size_t)row * 2048);
#pragma unroll
          for (int j = 0; j < 8; ++j) { const f32x4 w = wn[lane + 64 * j]; f32x4 y = v[j] * rinv * w; o[lane + 64 * j] = pack4(y); }
      } }
    { LAS float* tile = (LAS float*)lds;
      constexpr int NT = 16 * 54 + 16 * 16 + 16 * 88 + 44 * 16;
      int it = blockIdx.x; f32x4 v[8]; PrepTile d;
      if (it < NT) { d = prep_decode(p, it, tid); prep_load(d, tid, v); }
      while (it < NT) {
          { const int kr = tid >> 5, nl = (tid & 31) * 4;
#pragma unroll
            for (int i = 0; i < 8; ++i) { LAS float* tp = tile + (kr + 16 * i) * 129 + nl; tp[0] = v[i][0]; tp[1] = v[i][1]; tp[2] = v[i][2]; tp[3] = v[i][3]; } }
          __syncthreads();
          const PrepTile cur = d; const int nx = it + gridDim.x;
          if (nx < NT) { d = prep_decode(p, nx, tid); prep_load(d, tid, v); }
#pragma unroll
          for (int j = 0; j < 4; ++j) { const int id = tid + 512 * j, n = id >> 4, c = id & 15; float f[8];
#pragma unroll
              for (int e = 0; e < 8; ++e) f[e] = tile[(8 * c + e) * 129 + n];
              *(u32x4*)(cur.dst + (size_t)(cur.n0 + n) * cur.K + cur.k0 + 8 * c) = pack8(f); }
          __syncthreads();
          it = nx;
      } }
}

struct EpiProj {
    static constexpr bool PERM = true, AFTER_DRAIN = false;
    bf16_t* O; float* gates;
    __device__ __forceinline__ void operator()(const f32x4 (&acc)[2][2][4][2], const pg8::Unit& u, int wr, int wc, int fr, int fq) const {
        const int row0 = u.pm * 256 + wr * 64 + fr, col0 = u.pn * 256 + wc * 32 + 8 * fq;
#pragma unroll
        for (int ai = 0; ai < 2; ++ai)
#pragma unroll
            for (int m = 0; m < 4; ++m) { const int row = row0 + ai * 128 + m * 16; bf16_t* rp = O + (size_t)row * NPROJ + col0;
                if (u.pn < 26) {
#pragma unroll
                for (int bj = 0; bj < 2; ++bj) { u32x4 w; const f32x4 v0 = acc[ai][bj][m][0], v1 = acc[ai][bj][m][1];
                    w.x = cvt_pk_bf16(v0[0], v0[1]); w.y = cvt_pk_bf16(v0[2], v0[3]); w.z = cvt_pk_bf16(v1[0], v1[1]); w.w = cvt_pk_bf16(v1[2], v1[3]);
                    *(u32x4*)(rp + bj * 128) = w; } }
                else if (wc == 0) { float* gp = gates + (size_t)row * 32 + 8 * fq; *(f32x4*)gp = acc[ai][0][m][0]; *(f32x4*)(gp + 4) = acc[ai][0][m][1]; } }
    }
};
struct EpiOut {
    static constexpr bool PERM = false, AFTER_DRAIN = false;
    const float* xp; const float* xs; float* out; bf16_t* x1b; float* ss;
    __device__ __forceinline__ void operator()(const f32x4 (&acc)[2][2][4][2], const pg8::Unit& u, int wr, int wc, int fr, int fq) const {
        const int row0 = u.pm * 256 + wr * 64 + fr, col0 = u.pn * 256 + wc * 32 + 4 * fq;
#pragma unroll
        for (int ai = 0; ai < 2; ++ai)
#pragma unroll
            for (int m = 0; m < 4; ++m) { const int row = row0 + ai * 128 + m * 16;
                const float* bp = (row < NPR ? xp + (size_t)row * 2048 : xs + (size_t)(row - NPR) * 2048) + col0;
                bf16_t* hp = x1b + (size_t)row * 2048 + col0; float s = 0.f;
#pragma unroll
                for (int bj = 0; bj < 2; ++bj)
#pragma unroll
                    for (int n = 0; n < 2; ++n) { const f32x4 x1 = *(const f32x4*)(bp + bj * 128 + n * 16) + acc[ai][bj][m][n];
                        *(u32x2*)(hp + bj * 128 + n * 16) = pack4(x1);
                        s += (x1[0] * x1[0] + x1[1] * x1[1]) + (x1[2] * x1[2] + x1[3] * x1[3]); }
                s += __shfl_xor(s, 16); s += __shfl_xor(s, 32);
                if (fq == 0) ss[((size_t)u.pn * NTOK + row) * 4 + wc] = s; }
    }
};
struct EpiGU {
    static constexpr bool PERM = true, AFTER_DRAIN = false;
    bf16_t* ff; const float* ss;
    __device__ __forceinline__ void operator()(const f32x4 (&acc)[2][2][4][2], const pg8::Unit& u, int wr, int wc, int fr, int fq) const {
        const int row0 = u.pm * 256 + wr * 64 + fr, col0 = u.pn * 128 + wc * 32 + 8 * fq;
#pragma unroll
        for (int ai = 0; ai < 2; ++ai)
#pragma unroll
            for (int m = 0; m < 4; ++m) { const int row = row0 + ai * 128 + m * 16;
                const f32x4 pa = *(const f32x4*)(ss + ((size_t)(2 * fq) * NTOK + row) * 4), pb = *(const f32x4*)(ss + ((size_t)(2 * fq + 1) * NTOK + row) * 4);
                float sq = ((pa[0] + pa[1]) + (pa[2] + pa[3])) + ((pb[0] + pb[1]) + (pb[2] + pb[3])); sq += __shfl_xor(sq, 16); sq += __shfl_xor(sq, 32);
                const float rinv = rsqrtf(sq * (1.f / 2048.f) + EPS); float f[8];
#pragma unroll
                for (int n = 0; n < 2; ++n)
#pragma unroll
                    for (int j = 0; j < 4; ++j) { const float g = acc[ai][0][m][n][j] * rinv, up = acc[ai][1][m][n][j] * rinv; f[4 * n + j] = siluf(g) * up; }
                *(u32x4*)(ff + (size_t)row * DFF + col0) = pack8(f); }
    }
};
struct EpiDown {
    static constexpr bool PERM = false, AFTER_DRAIN = false;
    bf16_t* out; float* ss; const bf16_t* x1b;
    __device__ __forceinline__ void operator()(const f32x4 (&acc)[2][2][4][2], const pg8::Unit& u, int wr, int wc, int fr, int fq) const {
        const int row0 = u.pm * 256 + wr * 64 + fr, col0 = u.pn * 256 + wc * 32 + 4 * fq;
#pragma unroll
        for (int ai = 0; ai < 2; ++ai)
#pragma unroll
            for (int m = 0; m < 4; ++m) { const int row = row0 + ai * 128 + m * 16; bf16_t* op = out + (size_t)row * 2048 + col0; const bf16_t* hp = x1b + (size_t)row * 2048 + col0; float s = 0.f;
#pragma unroll
                for (int bj = 0; bj < 2; ++bj)
#pragma unroll
                    for (int n = 0; n < 2; ++n) { const u32x2 hw = *(const u32x2*)(hp + bj * 128 + n * 16); const f32x4 x2 = (f32x4){bflo(hw.x), bfhi(hw.x), bflo(hw.y), bfhi(hw.y)} + acc[ai][bj][m][n];
                        *(u32x2*)(op + bj * 128 + n * 16) = pack4(x2); s += (x2[0] * x2[0] + x2[1] * x2[1]) + (x2[2] * x2[2] + x2[3] * x2[3]); }
                s += __shfl_xor(s, 16); s += __shfl_xor(s, 32);
                if (fq == 0) ss[((size_t)u.pn * NTOK + row) * 4 + wc] = s; }
    }
};
__device__ __forceinline__ void conv8x8_prompt(const bf16_t* pc, int t0, const float* w, int ws, const float* bias, float (&out)[8][8]) {
    float w0[8], w1[8], w2[8], w3[8], bv[8], r0[8], r1[8], r2[8];
    ld8f(w, w0); ld8f(w + ws, w1); ld8f(w + 2 * ws, w2); ld8f(w + 3 * ws, w3);
    if (bias) ld8f(bias, bv); else {
#pragma unroll
        for (int c = 0; c < 8; ++c) bv[c] = 0.f; }
    if (t0 >= 3) { ld8b(pc + (size_t)(t0 - 3) * NPROJ, r0); ld8b(pc + (size_t)(t0 - 2) * NPROJ, r1); ld8b(pc + (size_t)(t0 - 1) * NPROJ, r2); }
    else {
#pragma unroll
        for (int c = 0; c < 8; ++c) { r0[c] = 0.f; r1[c] = 0.f; r2[c] = 0.f; } }
#pragma unroll
    for (int tt = 0; tt < 8; ++tt) { float cur[8]; ld8b(pc + (size_t)(t0 + tt) * NPROJ, cur);
#pragma unroll
        for (int c = 0; c < 8; ++c) { out[tt][c] = siluf(bv[c] + w0[c] * r0[c] + w1[c] * r1[c] + w2[c] * r2[c] + w3[c] * cur[c]); r0[c] = r1[c]; r1[c] = r2[c]; r2[c] = cur[c]; } }
}
__device__ __forceinline__ void conv1x8_sample(const bf16_t* pc, const float* st, int C, int t, const float* w, const float* bias, float (&o)[8], bool hist_ok = false) {
    float acc[8];
    if (bias) ld8f(bias, acc); else {
#pragma unroll
        for (int c = 0; c < 8; ++c) acc[c] = 0.f; }
#pragma unroll
    for (int i = 0; i < 4; ++i) { const int rr = t - 3 + i; float x[8], wi[8]; ld8f(w + i * C, wi);
        if (rr >= 0 || st == nullptr) { if (rr >= 0 || hist_ok) ld8b(pc + (long)rr * NPROJ, x); else {
#pragma unroll
                for (int c = 0; c < 8; ++c) x[c] = 0.f; } } else ld8f(st + (rr + 3) * C, x);
#pragma unroll
        for (int c = 0; c < 8; ++c) acc[c] += wi[c] * x[c]; }
#pragma unroll
    for (int c = 0; c < 8; ++c) o[c] = siluf(acc[c]);
}

__device__ __forceinline__ void gdn_chunk_item(CP& p, LAS unsigned char* lds, int item) {
    { unsigned lb_ = (unsigned)(size_t)lds; asm volatile("" : "+v"(lb_)); lds = (LAS unsigned char*)(size_t)lb_; }
    const int tid = opaque_tid(), wv = tid >> 6, lane = tid & 63, r = lane & 15, q = lane >> 4;
    const int n = item & 31, bh = item >> 5, h = bh & 7, b = bh >> 3, seqrow0 = b * 2048, t0c = n * 64;
    LAS bf16_t* qb = (LAS bf16_t*)lds; LAS bf16_t* kb = (LAS bf16_t*)(lds + 17408);
    LAS float* vs = (LAS float*)(lds + 34816); LAS float* Am = (LAS float*)(lds + 68608);
    LAS float* Gs = (LAS float*)(lds + 86016); LAS float* bs = Gs + 64;
    const bf16_t* proj = (const bf16_t*)(p.ws + OFF_PROJ); const float* gates = (const float*)(p.ws + OFF_GATES);
    unsigned char* gi = (unsigned char*)p.out + OB_GIA + (size_t)item * GIA_ITEM;
    bf16_t* Wg = (bf16_t*)gi; bf16_t* QDg = (bf16_t*)(gi + 16384); bf16_t* QKg = (bf16_t*)(gi + 32768); bf16_t* KDTg = (bf16_t*)(gi + 40960);
    bf16_t* UTg = item < 512 ? (bf16_t*)((unsigned char*)p.out + OB_UT0 + (size_t)item * 16384) : (bf16_t*)(p.ws + ut_off_ws(item));
    if (tid < 384) {
        const int part = tid >> 7, seg = (tid >> 4) & 7, cgi = tid & 15, ch = part * 1024 + h * 128 + cgi * 8;
        float o[8][8];
        conv8x8_prompt(proj + (size_t)seqrow0 * NPROJ + ch, t0c + seg * 8, p.in[I_GCW] + ch, 3072, nullptr, o);
        if (part < 2) {
            LAS bf16_t* dstb = part == 0 ? qb : kb; const float extra = part == 0 ? 0.08838834764831845f : 1.f;
#pragma unroll
            for (int tt = 0; tt < 8; ++tt) { float ss = 0.f;
#pragma unroll
                for (int c = 0; c < 8; ++c) ss += o[tt][c] * o[tt][c];
                ss = sum16_dpp(ss);
                const float sc = rsqrtf(ss + EPS) * extra; float f[8];
#pragma unroll
                for (int c = 0; c < 8; ++c) f[c] = o[tt][c] * sc;
                *(LAS u32x4*)(dstb + (seg * 8 + tt) * 136 + cgi * 8) = pack8(f); }
        } else {
#pragma unroll
            for (int tt = 0; tt < 8; ++tt) { LAS float* vp = vs + (seg * 8 + tt) * 132 + cgi * 8;
                *(LAS f32x4*)vp = (f32x4){o[tt][0], o[tt][1], o[tt][2], o[tt][3]}; *(LAS f32x4*)(vp + 4) = (f32x4){o[tt][4], o[tt][5], o[tt][6], o[tt][7]}; }
        }
    } else if (wv == 6) {
        const int row = seqrow0 + t0c + lane;
        const float a_raw = gates[(size_t)row * 32 + 8 + h], b_raw = gates[(size_t)row * 32 + h];
        const float g = -__expf(p.in[I_GAL][h]) * softplusf(a_raw + p.in[I_GDB][h]);
        Gs[lane] = wave_scan_incl(g, lane); bs[lane] = sigmf(b_raw);
    }
    __syncthreads();
    {
        const int it = wv & 3, jh = wv >> 2;
        bf16x8 ki[4], qi[4];
#pragma unroll
        for (int k = 0; k < 4; ++k) { ki[k] = *(LAS bf16x8*)(kb + (16 * it + r) * 136 + 32 * k + 8 * q); qi[k] = *(LAS bf16x8*)(qb + (16 * it + r) * 136 + 32 * k + 8 * q); }
#pragma unroll
        for (int jj = 0; jj < 2; ++jj) { const int jt = 2 * jh + jj;
            f32x4 dkk = (f32x4){0.f, 0.f, 0.f, 0.f}, dT = (f32x4){0.f, 0.f, 0.f, 0.f};
#pragma unroll
            for (int k = 0; k < 4; ++k) { const bf16x8 kj = *(LAS bf16x8*)(kb + (16 * jt + r) * 136 + 32 * k + 8 * q); dkk = MFMA16(ki[k], kj, dkk); dT = MFMA16(kj, qi[k], dT); }
            const int jc = 16 * jt + r; const float Gj = Gs[jc];
#pragma unroll
            for (int e = 0; e < 4; ++e) { const int i = 16 * it + 4 * q + e; const float v = bs[i] * dkk[e] * __expf(fminf(Gs[i] - Gj, 0.f)); Am[i * 68 + jc] = (jc < i) ? v : 0.f; }
            const int ic = 16 * it + r; const float Gi = Gs[ic]; f32x4 tv;
#pragma unroll
            for (int e = 0; e < 4; ++e) { const int j = 16 * jt + 4 * q + e; const float v = dT[e] * __expf(fminf(Gi - Gs[j], 0.f)); tv[e] = (j <= ic) ? v : 0.f; }
            *(u32x2*)(QKg + ic * 64 + 16 * jt + 4 * q) = pack4(tv); }
    }
    __syncthreads();
    if (tid < 256) {
        const int c = tid; float x[64];
        if (c < 128) {
#pragma unroll
            for (int i = 0; i < 64; ++i) x[i] = bs[i] * vs[i * 132 + c];
        } else {
#pragma unroll
            for (int i = 0; i < 64; ++i) x[i] = bs[i] * __expf(Gs[i]) * bf2f(kb[i * 136 + (c - 128)]);
        }
#pragma unroll
        for (int i = 1; i < 64; ++i) { float a = x[i];
#pragma unroll
            for (int j4 = 0; j4 <= (i - 1) / 4; ++j4) { const f32x4 am = *(LAS f32x4*)(Am + i * 68 + 4 * j4);
                a -= am[0] * x[4 * j4]; a -= am[1] * x[4 * j4 + 1]; a -= am[2] * x[4 * j4 + 2]; a -= am[3] * x[4 * j4 + 3]; }
            x[i] = a; }
        if (c < 128) {
#pragma unroll
            for (int k = 0; k < 8; ++k) { float f[8];
#pragma unroll
                for (int e = 0; e < 8; ++e) f[e] = x[8 * k + e];
                *(u32x4*)(UTg + c * 64 + 8 * k) = pack8(f); }
        } else {
#pragma unroll
            for (int i = 0; i < 64; ++i) Wg[i * 128 + (c - 128)] = f2bf(x[i]);
        }
    } else {
        const int t = tid - 256;
        { const int i = t >> 2, ds = (t & 3) * 32; const float eg = __expf(Gs[i]);
#pragma unroll
          for (int v = 0; v < 4; ++v) { float f[8]; unpack8(*(LAS u32x4*)(qb + i * 136 + ds + 8 * v), f);
#pragma unroll
              for (int e = 0; e < 8; ++e) f[e] *= eg;
              *(u32x4*)(QDg + i * 128 + ds + 8 * v) = pack8(f); } }
        { const int d = t & 127, jh = t >> 7; const float Gl = Gs[63];
#pragma unroll
          for (int v = 0; v < 4; ++v) { float f[8];
#pragma unroll
              for (int e = 0; e < 8; ++e) { const int j = jh * 32 + 8 * v + e; f[e] = bf2f(kb[j * 136 + d]) * __expf(Gl - Gs[j]); }
              *(u32x4*)(KDTg + d * 64 + jh * 32 + 8 * v) = pack8(f); } }
        if (t == 0) ((float*)(p.ws + OFF_GL))[item * 32] = __expf(Gs[63]);
    }
    __syncthreads();
}

__device__ __forceinline__ void phase2(CP& p, LAS unsigned char* lds) {
    const int tid = opaque_tid(), wv = tid >> 6, lane = tid & 63;
    for (int item = blockIdx.x; item < 1024; item += gridDim.x) gdn_chunk_item(p, lds, item);
    const float* gates = (const float*)(p.ws + OFF_GATES);
    { float* DT = (float*)(p.ws + OFF_DT); float* AC = (float*)(p.ws + OFF_ACUM);
      for (int job = blockIdx.x * 8 + wv; job < 2048; job += gridDim.x * 8) { const int head = job & 15, row = (job >> 4) * 64 + lane;
          const float dt = softplusf(gates[(size_t)row * 32 + 16 + head] + p.in[I_SDB][head]);
          const float a = -__expf(p.in[I_SAL][head]) * dt;
          DT[head * NPR + row] = dt; AC[head * NPR + row] = wave_scan_incl(a, lane); } }
    { const bf16_t* proj = (const bf16_t*)(p.ws + OFF_PROJ);
      for (int idx = blockIdx.x * 512 + tid; idx < 132 * 3 * 576; idx += gridDim.x * 512) {
          const int cg8 = idx % 576, i = (idx / 576) % 3, bb = idx / (576 * 3);
          const int row = bb < 4 ? bb * 2048 + 2045 + i : NPR + (bb - 4) * 8 + 5 + i;
          float f[8]; float* o;
          if (cg8 < 384) { ld8b(proj + (size_t)row * NPROJ + cg8 * 8, f); o = p.out + (bb < 4 ? O_GCP + (size_t)(bb * 3 + i) * 3072 : O_GCS + (size_t)((bb - 4) * 3 + i) * 3072) + cg8 * 8; }
          else { const int c = (cg8 - 384) * 8; ld8b(proj + (size_t)row * NPROJ + PC_XBC + c, f); o = p.out + (bb < 4 ? O_SCP + (size_t)(bb * 3 + i) * 1536 : O_SCS + (size_t)((bb - 4) * 3 + i) * 1536) + c; }
          *(f32x4*)o = (f32x4){f[0], f[1], f[2], f[3]}; *(f32x4*)(o + 4) = (f32x4){f[4], f[5], f[6], f[7]}; } }
}

struct GdnOps { bf16x8 wA[4], qA[4]; u32x2 uw[4]; bf16x8 qkA[2], kA[2][2]; float gl; };
__device__ __forceinline__ void gdn_load_ops(CP& p, int item, int ti, int eh, int r, int q, GdnOps& o) {
    const unsigned char* gi = (const unsigned char*)p.out + OB_GIA + (size_t)item * GIA_ITEM;
    const bf16_t* Wg = (const bf16_t*)gi; const bf16_t* QDg = (const bf16_t*)(gi + 16384); const bf16_t* UTg = item < 512 ? (const bf16_t*)((const unsigned char*)p.out + OB_UT0 + (size_t)item * 16384) : (const bf16_t*)(p.ws + ut_off_ws(item));
    const bf16_t* QKg = (const bf16_t*)(gi + 32768); const bf16_t* KDTg = (const bf16_t*)(gi + 40960);
#pragma unroll
    for (int k = 0; k < 4; ++k) { o.wA[k] = *(const bf16x8*)(Wg + (16 * ti + r) * 128 + 32 * k + 8 * q); o.qA[k] = *(const bf16x8*)(QDg + (16 * ti + r) * 128 + 32 * k + 8 * q); }
#pragma unroll
    for (int et = 0; et < 4; ++et) o.uw[et] = *(const u32x2*)(UTg + (16 * (4 * eh + et) + r) * 64 + 16 * ti + 4 * q);
#pragma unroll
    for (int k2 = 0; k2 < 2; ++k2) { o.qkA[k2] = *(const bf16x8*)(QKg + (16 * ti + r) * 64 + 32 * k2 + 8 * q);
#pragma unroll
        for (int dd = 0; dd < 2; ++dd) o.kA[dd][k2] = *(const bf16x8*)(KDTg + (16 * (2 * ti + dd) + r) * 64 + 32 * k2 + 8 * q); }
    o.gl = ((const float*)(p.ws + OFF_GL))[item * 32];
}
__device__ __forceinline__ void gdn_scan_item(CP& p, LAS unsigned char* lds, int bh) {
    { unsigned lb_ = (unsigned)(size_t)lds; asm volatile("" : "+v"(lb_)); lds = (LAS unsigned char*)(size_t)lb_; }
    const int tid = opaque_tid(), wv = tid >> 6, lane = tid & 63, r = lane & 15, q = lane >> 4;
    const int b = bh >> 3, h = bh & 7, ti = wv & 3, eh = wv >> 2;
    LAS bf16_t* St = (LAS bf16_t*)lds; LAS bf16_t* vnT = (LAS bf16_t*)(lds + 34816); LAS float* ssqp = (LAS float*)(lds + 34816 + 18432);
    const bf16_t* proj = (const bf16_t*)(p.ws + OFF_PROJ); bf16_t* mix = (bf16_t*)(p.ws + OFF_MIX);
    const float* gnw = p.in[I_GNW];
    f32x4 Sacc[2][4];
#pragma unroll
    for (int a = 0; a < 2; ++a)
#pragma unroll
        for (int e = 0; e < 4; ++e) Sacc[a][e] = (f32x4){0.f, 0.f, 0.f, 0.f};
    for (int i = tid; i < 34816 / 16; i += 512) ((LAS u32x4*)lds)[i] = (u32x4){0u, 0u, 0u, 0u};
    GdnOps cur; gdn_load_ops(p, bh * 32, ti, eh, r, q, cur);
    __syncthreads();
    for (int n = 0; n < 32; ++n) {
        GdnOps nxt; gdn_load_ops(p, bh * 32 + (n + 1 < 32 ? n + 1 : n), ti, eh, r, q, nxt);
        bf16_t zr[4][4];
#pragma unroll
        for (int j = 0; j < 4; ++j)
#pragma unroll
            for (int et = 0; et < 4; ++et) zr[j][et] = proj[((size_t)b * 2048 + n * 64 + 16 * ti + 4 * q + j) * NPROJ + PC_ZG + h * 128 + 16 * (4 * eh + et) + r];
        f32x4 accq[4];
#pragma unroll
        for (int et = 0; et < 4; ++et) { const int E = 4 * eh + et; f32x4 accw = (f32x4){0.f, 0.f, 0.f, 0.f}; accq[et] = (f32x4){0.f, 0.f, 0.f, 0.f};
#pragma unroll
            for (int k = 0; k < 4; ++k) { const bf16x8 sf = *(LAS bf16x8*)(St + (16 * E + r) * 136 + 32 * k + 8 * q); accw = MFMA16(cur.wA[k], sf, accw); accq[et] = MFMA16(cur.qA[k], sf, accq[et]); }
            const u32x2 uw = cur.uw[et]; const f32x4 u = (f32x4){bflo(uw.x), bfhi(uw.x), bflo(uw.y), bfhi(uw.y)};
            *(LAS u32x2*)(vnT + (16 * E + r) * 72 + 16 * ti + 4 * q) = pack4(u - accw); }
        LDS_BARRIER();
        const float gl = cur.gl;
#pragma unroll
        for (int et = 0; et < 4; ++et) { const int E = 4 * eh + et; bf16x8 bv[2];
#pragma unroll
            for (int k2 = 0; k2 < 2; ++k2) bv[k2] = *(LAS bf16x8*)(vnT + (16 * E + r) * 72 + 32 * k2 + 8 * q);
#pragma unroll
            for (int k2 = 0; k2 < 2; ++k2) accq[et] = MFMA16(cur.qkA[k2], bv[k2], accq[et]);
#pragma unroll
            for (int dd = 0; dd < 2; ++dd) { Sacc[dd][et] = Sacc[dd][et] * gl;
#pragma unroll
                for (int k2 = 0; k2 < 2; ++k2) Sacc[dd][et] = MFMA16(cur.kA[dd][k2], bv[k2], Sacc[dd][et]);
                *(LAS u32x2*)(St + (16 * E + r) * 136 + 16 * (2 * ti + dd) + 4 * q) = pack4(Sacc[dd][et]); } }
        float s4[4];
#pragma unroll
        for (int j = 0; j < 4; ++j) { float s = 0.f;
#pragma unroll
            for (int et = 0; et < 4; ++et) s += accq[et][j] * accq[et][j];
            s = sum16_dpp(s); s4[j] = s; }
        if (r == 0) {
#pragma unroll
            for (int j = 0; j < 4; ++j) ssqp[eh * 64 + 16 * ti + 4 * q + j] = s4[j]; }
        LDS_BARRIER();
#pragma unroll
        for (int j = 0; j < 4; ++j) { const int i = 16 * ti + 4 * q + j; const float rinv = rsqrtf((ssqp[i] + ssqp[64 + i]) * (1.f / 128.f) + EPS);
            const size_t row = (size_t)b * 2048 + n * 64 + i;
#pragma unroll
            for (int et = 0; et < 4; ++et) { const int e = 16 * (4 * eh + et) + r;
                mix[row * 2048 + h * 128 + e] = f2bf(accq[et][j] * rinv * gnw[e] * siluf(bf2f(zr[j][et]))); } }
        cur = nxt;
    }
    float* so = p.out + O_GSP + (size_t)bh * 128 * 128;
#pragma unroll
    for (int dd = 0; dd < 2; ++dd)
#pragma unroll
        for (int et = 0; et < 4; ++et)
#pragma unroll
            for (int j = 0; j < 4; ++j) so[(16 * (2 * ti + dd) + 4 * q + j) * 128 + 16 * (4 * eh + et) + r] = Sacc[dd][et][j];
    __syncthreads();
}

__device__ __forceinline__ void ssd_load_rows(const bf16_t* pc, int t0, const float* aux, const float* acl, u32x4 (&rr)[11], float (&dd)[8], float& al) {
#pragma unroll
    for (int i = 0; i < 11; ++i) { const int t = t0 - 3 + i; rr[i] = (t >= 0) ? *(const u32x4*)(pc + (size_t)t * NPROJ) : (u32x4){0u, 0u, 0u, 0u}; }
#pragma unroll
    for (int tt = 0; tt < 8; ++tt) dd[tt] = aux[tt];
    al = *acl;
}
__device__ __forceinline__ void ssd_scan_item(CP& p, LAS unsigned char* lds, int bhd) {
    { unsigned lb_ = (unsigned)(size_t)lds; asm volatile("" : "+v"(lb_)); lds = (LAS unsigned char*)(size_t)lb_; }
    const int tid = opaque_tid(), wv = tid >> 6, lane = tid & 63, r = lane & 15, q = lane >> 4;
    const int b = bhd >> 4, head = bhd & 15, g = head >> 3;
    LAS bf16_t* BdT = (LAS bf16_t*)(lds + 34816); LAS bf16_t* xdtT = (LAS bf16_t*)(lds + 53248); LAS bf16_t* hb = (LAS bf16_t*)(lds + 71680);
    const bf16_t* proj = (const bf16_t*)(p.ws + OFF_PROJ); const float* DT = (const float*)(p.ws + OFF_DT); const float* AC = (const float*)(p.ws + OFF_ACUM);
    f32x4 hacc[4];
#pragma unroll
    for (int e = 0; e < 4; ++e) hacc[e] = (f32x4){0.f, 0.f, 0.f, 0.f};
    for (int i = tid; i < 17408 / 16; i += 512) ((LAS u32x4*)(lds + 71680))[i] = (u32x4){0u, 0u, 0u, 0u};
    const bool act = tid < 192; const int seg = act ? tid / 24 : 0, cgi = act ? tid % 24 : 0;
    const int ch = cgi < 8 ? head * 64 + cgi * 8 : 1024 + g * 128 + (cgi - 8) * 8;
    const bf16_t* pc = proj + (size_t)b * 2048 * NPROJ + PC_XBC + ch;
    const float* auxb = (cgi < 8 ? DT : AC) + head * NPR + b * 2048 + seg * 8;
    const float* aclb = AC + head * NPR + b * 2048 + 63;
    u32x4 rc[11]; float dc[8]; float alc;
    ssd_load_rows(pc, seg * 8, auxb, aclb, rc, dc, alc);
    __syncthreads();
    for (int n = 0; n < 32; ++n) {
        const int nn = n + 1 < 32 ? n + 1 : n;
        u32x4 rn[11]; float dn[8]; float aln;
        ssd_load_rows(pc, nn * 64 + seg * 8, auxb + nn * 64, aclb + nn * 64, rn, dn, aln);
        {
            bf16_t* hst = (bf16_t*)(p.ws + OFF_YZ) + ((size_t)(bhd * 32 + n) * 64) * 128;
            for (int i = tid; i < 1024; i += 512) { const int p_ = i >> 4, sg = i & 15; *(u32x4*)(hst + p_ * 128 + sg * 8) = *(LAS u32x4*)(hb + p_ * 136 + sg * 8); } }
        if (act) {
            float o[8][8]; float h0[8], h1[8], h2[8]; float w0[8], w1[8], w2[8], w3[8], bv[8];
            ld8f(p.in[I_SCW] + ch, w0); ld8f(p.in[I_SCW] + 1536 + ch, w1); ld8f(p.in[I_SCW] + 2 * 1536 + ch, w2); ld8f(p.in[I_SCW] + 3 * 1536 + ch, w3); ld8f(p.in[I_SCB] + ch, bv);
            unpack8(rc[0], h0); unpack8(rc[1], h1); unpack8(rc[2], h2);
#pragma unroll
            for (int tt = 0; tt < 8; ++tt) { float cur[8]; unpack8(rc[3 + tt], cur);
#pragma unroll
                for (int c = 0; c < 8; ++c) { o[tt][c] = siluf(bv[c] + w0[c] * h0[c] + w1[c] * h1[c] + w2[c] * h2[c] + w3[c] * cur[c]); h0[c] = h1[c]; h1[c] = h2[c]; h2[c] = cur[c]; } }
            if (cgi < 8) { const int p0 = cgi * 8;
#pragma unroll
                for (int c = 0; c < 8; ++c) { float f[8];
#pragma unroll
                    for (int tt = 0; tt < 8; ++tt) f[tt] = o[tt][c] * dc[tt];
                    *(LAS u32x4*)(xdtT + (p0 + c) * 72 + seg * 8) = pack8(f); }
            } else { const int s0 = (cgi - 8) * 8; float dec[8];
#pragma unroll
                for (int tt = 0; tt < 8; ++tt) dec[tt] = __expf(alc - dc[tt]);
#pragma unroll
                for (int c = 0; c < 8; ++c) { float f[8];
#pragma unroll
                    for (int tt = 0; tt < 8; ++tt) f[tt] = o[tt][c] * dec[tt];
                    *(LAS u32x4*)(BdT + (s0 + c) * 72 + seg * 8) = pack8(f); } }
        }
        LDS_BARRIER();
        { bf16x8 bdf[2];
#pragma unroll
          for (int k2 = 0; k2 < 2; ++k2) bdf[k2] = *(LAS bf16x8*)(BdT + (16 * wv + r) * 72 + 32 * k2 + 8 * q);
          const float al = __expf(alc);
#pragma unroll
          for (int pt = 0; pt < 4; ++pt) { bf16x8 xf[2];
#pragma unroll
              for (int k2 = 0; k2 < 2; ++k2) xf[k2] = *(LAS bf16x8*)(xdtT + (16 * pt + r) * 72 + 32 * k2 + 8 * q);
              hacc[pt] = hacc[pt] * al;
#pragma unroll
              for (int k2 = 0; k2 < 2; ++k2) hacc[pt] = MFMA16(bdf[k2], xf[k2], hacc[pt]);
              *(LAS u32x2*)(hb + (16 * pt + r) * 136 + 16 * wv + 4 * q) = pack4(hacc[pt]); } }
        LDS_BARRIER();
#pragma unroll
        for (int i = 0; i < 11; ++i) rc[i] = rn[i];
#pragma unroll
        for (int tt = 0; tt < 8; ++tt) dc[tt] = dn[tt];
        alc = aln;
    }
    float* so = p.out + O_SSP + (size_t)bhd * 64 * 128;
#pragma unroll
    for (int pt = 0; pt < 4; ++pt) *(f32x4*)(so + (16 * pt + r) * 128 + 16 * wv + 4 * q) = hacc[pt];
}
__device__ __forceinline__ void ssd_sample_item(CP& p, LAS unsigned char* lds, int bg) {
    { unsigned lb_ = (unsigned)(size_t)lds; asm volatile("" : "+v"(lb_)); lds = (LAS unsigned char*)(size_t)lb_; }
    const int tid = opaque_tid(), wv = tid >> 6, lane = tid & 63;
    const int b = bg >> 1, g = bg & 1, r0 = NPR + b * 8;
    LAS float* xs = (LAS float*)lds; LAS float* Bs = (LAS float*)(lds + 16384); LAS float* Cs = (LAS float*)(lds + 20480);
    LAS float* dts = (LAS float*)(lds + 24576); LAS float* dAs = (LAS float*)(lds + 24832); LAS float* yzs = (LAS float*)(lds + 25088);
    const bf16_t* proj = (const bf16_t*)(p.ws + OFF_PROJ); const float* gates = (const float*)(p.ws + OFF_GATES); bf16_t* mix = (bf16_t*)(p.ws + OFF_MIX);
    const int pp = tid >> 3, nq = tid & 7;
    const float* sin = p.in[I_SS] + ((size_t)(b * 16 + g * 8) * 64 + pp) * 128 + nq * 16;
    float* sout = p.out + O_SSS + ((size_t)(b * 16 + g * 8) * 64 + pp) * 128 + nq * 16;
    f32x4 hn[4];
#pragma unroll
    for (int v = 0; v < 4; ++v) hn[v] = *(const f32x4*)(sin + 4 * v);
    for (int idx = tid; idx < 768; idx += 512) { const int t = idx / 96, cgi = idx % 96; float o[8];
        const int ch = cgi < 64 ? g * 512 + cgi * 8 : (cgi < 80 ? 1024 + g * 128 + (cgi - 64) * 8 : 1280 + g * 128 + (cgi - 80) * 8);
        conv1x8_sample(proj + (size_t)r0 * NPROJ + PC_XBC + ch, p.in[I_SSC] + (size_t)b * 3 * 1536 + ch, 1536, t, p.in[I_SCW] + ch, p.in[I_SCB] + ch, o);
        LAS float* dst = cgi < 64 ? xs + t * 512 + cgi * 8 : (cgi < 80 ? Bs + t * 128 + (cgi - 64) * 8 : Cs + t * 128 + (cgi - 80) * 8);
        *(LAS f32x4*)dst = (f32x4){o[0], o[1], o[2], o[3]}; *(LAS f32x4*)(dst + 4) = (f32x4){o[4], o[5], o[6], o[7]}; }
    if (tid < 64) { const int t = tid >> 3, hh = tid & 7, head = g * 8 + hh;
        const float dt = softplusf(gates[(size_t)(r0 + t) * 32 + 16 + head] + p.in[I_SDB][head]);
        dts[t * 8 + hh] = dt; dAs[t * 8 + hh] = __expf(-__expf(p.in[I_SAL][head]) * dt); }
    __syncthreads();
    for (int hh = 0; hh < 8; ++hh) { const int head = g * 8 + hh;
        float hr[16];
#pragma unroll
        for (int v = 0; v < 4; ++v) { hr[4 * v] = hn[v][0]; hr[4 * v + 1] = hn[v][1]; hr[4 * v + 2] = hn[v][2]; hr[4 * v + 3] = hn[v][3]; }
        if (hh < 7) {
#pragma unroll
            for (int v = 0; v < 4; ++v) hn[v] = *(const f32x4*)(sin + (size_t)(hh + 1) * 64 * 128 + 4 * v); }
        const float Dh = p.in[I_SD][head];
#pragma unroll
        for (int t = 0; t < 8; ++t) { const float dA = dAs[t * 8 + hh], xv = xs[t * 512 + hh * 64 + pp], dtx = dts[t * 8 + hh] * xv; float yp = 0.f;
#pragma unroll
            for (int v = 0; v < 4; ++v) { const f32x4 bv = *(LAS f32x4*)(Bs + t * 128 + nq * 16 + 4 * v), cv = *(LAS f32x4*)(Cs + t * 128 + nq * 16 + 4 * v);
#pragma unroll
                for (int e = 0; e < 4; ++e) { hr[4 * v + e] = dA * hr[4 * v + e] + dtx * bv[e]; yp += hr[4 * v + e] * cv[e]; } }
            yp += __shfl_xor(yp, 1); yp += __shfl_xor(yp, 2); yp += __shfl_xor(yp, 4);
            if (nq == 0) { const float y = yp + Dh * xv; const float z = bf2f(proj[(size_t)(r0 + t) * NPROJ + PC_ZS + head * 64 + pp]); yzs[t * 512 + hh * 64 + pp] = y * siluf(z); } }
#pragma unroll
        for (int v = 0; v < 4; ++v) *(f32x4*)(sout + (size_t)hh * 64 * 128 + 4 * v) = (f32x4){hr[4 * v], hr[4 * v + 1], hr[4 * v + 2], hr[4 * v + 3]};
    }
    __syncthreads();
    { const int t = wv; float f[8]; float ss = 0.f;
      const f32x4 a = *(LAS f32x4*)(yzs + t * 512 + lane * 8), c = *(LAS f32x4*)(yzs + t * 512 + lane * 8 + 4);
      f[0] = a[0]; f[1] = a[1]; f[2] = a[2]; f[3] = a[3]; f[4] = c[0]; f[5] = c[1]; f[6] = c[2]; f[7] = c[3];
#pragma unroll
      for (int e = 0; e < 8; ++e) ss += f[e] * f[e];
      const float rinv = rsqrtf(wave_sum(ss) * (1.f / 512.f) + EPS); float w[8]; ld8f(p.in[I_SNW] + g * 512 + lane * 8, w);
#pragma unroll
      for (int e = 0; e < 8; ++e) f[e] *= rinv * w[e];
      *(u32x4*)(mix + (size_t)(r0 + t) * 2048 + 1024 + g * 512 + lane * 8) = pack8(f); }
    __syncthreads();
}

__device__ __forceinline__ void ssd_prompt_par_item(CP& p, LAS unsigned char* lds, int item) {
    { unsigned lb_ = (unsigned)(size_t)lds; asm volatile("" : "+v"(lb_)); lds = (LAS unsigned char*)(size_t)lb_; }
    const int tid = opaque_tid(), wv = tid >> 6, lane = tid & 63;
    const int c64 = item & 31, g = (item >> 5) & 1, b = item >> 6;
    LAS float* xs = (LAS float*)lds; LAS float* Bs = (LAS float*)(lds + 16384); LAS float* Cs = (LAS float*)(lds + 20480);
    LAS float* dts = (LAS float*)(lds + 24576); LAS float* dAs = (LAS float*)(lds + 24832); LAS float* yzs = (LAS float*)(lds + 25088);
    const bf16_t* proj = (const bf16_t*)(p.ws + OFF_PROJ); const float* gates = (const float*)(p.ws + OFF_GATES); bf16_t* mix = (bf16_t*)(p.ws + OFF_MIX);
    const int pp = tid >> 3, nq = tid & 7;
    f32x2p hr[8][8];
#pragma unroll
    for (int hh = 0; hh < 8; ++hh) { const bf16_t* hs = (const bf16_t*)(p.ws + OFF_YZ) + (((size_t)((b * 16 + g * 8 + hh) * 32 + c64) * 64) + pp) * 128 + nq * 16;
        float f0[8], f1[8]; ld8b(hs, f0); ld8b(hs + 8, f1);
#pragma unroll
        for (int e = 0; e < 4; ++e) { hr[hh][e] = (f32x2p){f0[2 * e], f0[2 * e + 1]}; hr[hh][4 + e] = (f32x2p){f1[2 * e], f1[2 * e + 1]}; } }
    for (int w8 = 0; w8 < 8; ++w8) { const int r0 = b * 2048 + c64 * 64 + w8 * 8;
    for (int idx = tid; idx < 768; idx += 512) { const int t = idx / 96, cgi = idx % 96; float o[8];
        const int ch = cgi < 64 ? g * 512 + cgi * 8 : (cgi < 80 ? 1024 + g * 128 + (cgi - 64) * 8 : 1280 + g * 128 + (cgi - 80) * 8);
        conv1x8_sample(proj + (size_t)r0 * NPROJ + PC_XBC + ch, nullptr, 1536, t, p.in[I_SCW] + ch, p.in[I_SCB] + ch, o, (c64 | w8) != 0);
        LAS float* dst = cgi < 64 ? xs + t * 512 + cgi * 8 : (cgi < 80 ? Bs + t * 128 + (cgi - 64) * 8 : Cs + t * 128 + (cgi - 80) * 8);
        *(LAS f32x4*)dst = (f32x4){o[0], o[1], o[2], o[3]}; *(LAS f32x4*)(dst + 4) = (f32x4){o[4], o[5], o[6], o[7]}; }
    if (tid < 64) { const int t = tid >> 3, hh = tid & 7, head = g * 8 + hh;
        const float dt = softplusf(gates[(size_t)(r0 + t) * 32 + 16 + head] + p.in[I_SDB][head]);
        dts[t * 8 + hh] = dt; dAs[t * 8 + hh] = __expf(-__expf(p.in[I_SAL][head]) * dt); }
    __syncthreads();
    {
#pragma unroll 1
        for (int t = 0; t < 8; ++t) {
            const f32x4 dA0 = *(LAS f32x4*)(dAs + t * 8), dA1 = *(LAS f32x4*)(dAs + t * 8 + 4), dt0 = *(LAS f32x4*)(dts + t * 8), dt1 = *(LAS f32x4*)(dts + t * 8 + 4);
            f32x2p yp2[8]; float yp[8], xv[8], dtx[8], dAv[8];
#pragma unroll
            for (int hh = 0; hh < 8; ++hh) { dAv[hh] = hh < 4 ? dA0[hh & 3] : dA1[hh & 3]; xv[hh] = xs[t * 512 + hh * 64 + pp]; dtx[hh] = (hh < 4 ? dt0[hh & 3] : dt1[hh & 3]) * xv[hh]; yp2[hh] = (f32x2p){0.f, 0.f}; }
#pragma unroll
            for (int v = 0; v < 4; ++v) { const f32x4 bv = *(LAS f32x4*)(Bs + t * 128 + nq * 16 + 4 * v), cv = *(LAS f32x4*)(Cs + t * 128 + nq * 16 + 4 * v);
                const f32x2p b0 = (f32x2p){bv[0], bv[1]}, b1 = (f32x2p){bv[2], bv[3]}, c0 = (f32x2p){cv[0], cv[1]}, c1 = (f32x2p){cv[2], cv[3]};
#pragma unroll
                for (int hh = 0; hh < 8; ++hh) { const f32x2p da = (f32x2p){dAv[hh], dAv[hh]}, dx = (f32x2p){dtx[hh], dtx[hh]};
                    hr[hh][2 * v] = da * hr[hh][2 * v] + dx * b0; yp2[hh] += hr[hh][2 * v] * c0;
                    hr[hh][2 * v + 1] = da * hr[hh][2 * v + 1] + dx * b1; yp2[hh] += hr[hh][2 * v + 1] * c1; } }
#pragma unroll
            for (int hh = 0; hh < 8; ++hh) yp[hh] = sum8_dpp(yp2[hh][0] + yp2[hh][1]);
            if (nq == 0) {
#pragma unroll
                for (int hh = 0; hh < 8; ++hh) { const int head = g * 8 + hh; const float y = yp[hh] + p.in[I_SD][head] * xv[hh];
                    yzs[t * 512 + hh * 64 + pp] = y; } }
        }
    }
    __syncthreads();
    { const int t = wv; float f[8]; float ss = 0.f;
      const f32x4 a = *(LAS f32x4*)(yzs + t * 512 + lane * 8), c = *(LAS f32x4*)(yzs + t * 512 + lane * 8 + 4);
      f[0] = a[0]; f[1] = a[1]; f[2] = a[2]; f[3] = a[3]; f[4] = c[0]; f[5] = c[1]; f[6] = c[2]; f[7] = c[3];
      { float zf[8]; ld8b(proj + (size_t)(r0 + t) * NPROJ + PC_ZS + g * 512 + lane * 8, zf);
#pragma unroll
        for (int e = 0; e < 8; ++e) f[e] *= siluf(zf[e]); }
#pragma unroll
      for (int e = 0; e < 8; ++e) ss += f[e] * f[e];
      const float rinv = rsqrtf(wave_sum(ss) * (1.f / 512.f) + EPS); float w[8]; ld8f(p.in[I_SNW] + g * 512 + lane * 8, w);
#pragma unroll
      for (int e = 0; e < 8; ++e) f[e] *= rinv * w[e];
      *(u32x4*)(mix + (size_t)(r0 + t) * 2048 + 1024 + g * 512 + lane * 8) = pack8(f); }
    __syncthreads();
    }
}


__device__ __forceinline__ void ssd_sample_fast_item(CP& p, LAS unsigned char* lds, int bg) {
    { unsigned lb_ = (unsigned)(size_t)lds; asm volatile("" : "+v"(lb_)); lds = (LAS unsigned char*)(size_t)lb_; }
    const int tid = opaque_tid(), wv = tid >> 6, lane = tid & 63;
    const int b = bg >> 1, g = bg & 1, r0 = NPR + b * 8;
    LAS float* xs = (LAS float*)lds; LAS float* Bs = (LAS float*)(lds + 16384); LAS float* Cs = (LAS float*)(lds + 20480);
    LAS float* dts = (LAS float*)(lds + 24576); LAS float* dAs = (LAS float*)(lds + 24832); LAS float* yzs = (LAS float*)(lds + 25088);
    const bf16_t* proj = (const bf16_t*)(p.ws + OFF_PROJ); const float* gates = (const float*)(p.ws + OFF_GATES); bf16_t* mix = (bf16_t*)(p.ws + OFF_MIX);
    const int pp = tid >> 3, nq = tid & 7;
    f32x2p hr[8][8];
#pragma unroll
    for (int hh = 0; hh < 8; ++hh) { const float* hs = p.in[I_SS] + ((size_t)(b * 16 + g * 8 + hh) * 64 + pp) * 128 + nq * 16;
#pragma unroll
        for (int v = 0; v < 4; ++v) { const f32x4 x4 = *(const f32x4*)(hs + 4 * v); hr[hh][2 * v] = (f32x2p){x4[0], x4[1]}; hr[hh][2 * v + 1] = (f32x2p){x4[2], x4[3]}; } }
    {
    for (int idx = tid; idx < 768; idx += 512) { const int t = idx / 96, cgi = idx % 96; float o[8];
        const int ch = cgi < 64 ? g * 512 + cgi * 8 : (cgi < 80 ? 1024 + g * 128 + (cgi - 64) * 8 : 1280 + g * 128 + (cgi - 80) * 8);
        conv1x8_sample(proj + (size_t)r0 * NPROJ + PC_XBC + ch, p.in[I_SSC] + (size_t)b * 3 * 1536 + ch, 1536, t, p.in[I_SCW] + ch, p.in[I_SCB] + ch, o);
        LAS float* dst = cgi < 64 ? xs + t * 512 + cgi * 8 : (cgi < 80 ? Bs + t * 128 + (cgi - 64) * 8 : Cs + t * 128 + (cgi - 80) * 8);
        *(LAS f32x4*)dst = (f32x4){o[0], o[1], o[2], o[3]}; *(LAS f32x4*)(dst + 4) = (f32x4){o[4], o[5], o[6], o[7]}; }
    if (tid < 64) { const int t = tid >> 3, hh = tid & 7, head = g * 8 + hh;
        const float dt = softplusf(gates[(size_t)(r0 + t) * 32 + 16 + head] + p.in[I_SDB][head]);
        dts[t * 8 + hh] = dt; dAs[t * 8 + hh] = __expf(-__expf(p.in[I_SAL][head]) * dt); }
    __syncthreads();
    {
#pragma unroll 1
        for (int t = 0; t < 8; ++t) {
            const f32x4 dA0 = *(LAS f32x4*)(dAs + t * 8), dA1 = *(LAS f32x4*)(dAs + t * 8 + 4), dt0 = *(LAS f32x4*)(dts + t * 8), dt1 = *(LAS f32x4*)(dts + t * 8 + 4);
            f32x2p yp2[8]; float yp[8], xv[8], dtx[8], dAv[8];
#pragma unroll
            for (int hh = 0; hh < 8; ++hh) { dAv[hh] = hh < 4 ? dA0[hh & 3] : dA1[hh & 3]; xv[hh] = xs[t * 512 + hh * 64 + pp]; dtx[hh] = (hh < 4 ? dt0[hh & 3] : dt1[hh & 3]) * xv[hh]; yp2[hh] = (f32x2p){0.f, 0.f}; }
#pragma unroll
            for (int v = 0; v < 4; ++v) { const f32x4 bv = *(LAS f32x4*)(Bs + t * 128 + nq * 16 + 4 * v), cv = *(LAS f32x4*)(Cs + t * 128 + nq * 16 + 4 * v);
                const f32x2p b0 = (f32x2p){bv[0], bv[1]}, b1 = (f32x2p){bv[2], bv[3]}, c0 = (f32x2p){cv[0], cv[1]}, c1 = (f32x2p){cv[2], cv[3]};
#pragma unroll
                for (int hh = 0; hh < 8; ++hh) { const f32x2p da = (f32x2p){dAv[hh], dAv[hh]}, dx = (f32x2p){dtx[hh], dtx[hh]};
                    hr[hh][2 * v] = da * hr[hh][2 * v] + dx * b0; yp2[hh] += hr[hh][2 * v] * c0;
                    hr[hh][2 * v + 1] = da * hr[hh][2 * v + 1] + dx * b1; yp2[hh] += hr[hh][2 * v + 1] * c1; } }
#pragma unroll
            for (int hh = 0; hh < 8; ++hh) yp[hh] = sum8_dpp(yp2[hh][0] + yp2[hh][1]);
            if (nq == 0) {
#pragma unroll
                for (int hh = 0; hh < 8; ++hh) { const int head = g * 8 + hh; const float y = yp[hh] + p.in[I_SD][head] * xv[hh];
                    yzs[t * 512 + hh * 64 + pp] = y; } }
        }
    }
    __syncthreads();
    { const int t = wv; float f[8]; float ss = 0.f;
      const f32x4 a = *(LAS f32x4*)(yzs + t * 512 + lane * 8), c = *(LAS f32x4*)(yzs + t * 512 + lane * 8 + 4);
      f[0] = a[0]; f[1] = a[1]; f[2] = a[2]; f[3] = a[3]; f[4] = c[0]; f[5] = c[1]; f[6] = c[2]; f[7] = c[3];
      { float zf[8]; ld8b(proj + (size_t)(r0 + t) * NPROJ + PC_ZS + g * 512 + lane * 8, zf);
#pragma unroll
        for (int e = 0; e < 8; ++e) f[e] *= siluf(zf[e]); }
#pragma unroll
      for (int e = 0; e < 8; ++e) ss += f[e] * f[e];
      const float rinv = rsqrtf(wave_sum(ss) * (1.f / 512.f) + EPS); float w[8]; ld8f(p.in[I_SNW] + g * 512 + lane * 8, w);
#pragma unroll
      for (int e = 0; e < 8; ++e) f[e] *= rinv * w[e];
      *(u32x4*)(mix + (size_t)(r0 + t) * 2048 + 1024 + g * 512 + lane * 8) = pack8(f); }
    __syncthreads();
    }
#pragma unroll
    for (int hh = 0; hh < 8; ++hh) { float* ho = p.out + O_SSS + ((size_t)(b * 16 + g * 8 + hh) * 64 + pp) * 128 + nq * 16;
#pragma unroll
        for (int v = 0; v < 4; ++v) *(f32x4*)(ho + 4 * v) = (f32x4){hr[hh][2 * v][0], hr[hh][2 * v][1], hr[hh][2 * v + 1][0], hr[hh][2 * v + 1][1]}; }
}

__device__ __forceinline__ void ssd_prompt_seq_item(CP& p, LAS unsigned char* lds, int bg) {
    { unsigned lb_ = (unsigned)(size_t)lds; asm volatile("" : "+v"(lb_)); lds = (LAS unsigned char*)(size_t)lb_; }
    const int tid = opaque_tid(), wv = tid >> 6, lane = tid & 63;
    const int b = bg >> 1, g = bg & 1;
    LAS float* xs = (LAS float*)lds; LAS float* Bs = (LAS float*)(lds + 16384); LAS float* Cs = (LAS float*)(lds + 20480);
    LAS float* dts = (LAS float*)(lds + 24576); LAS float* dAs = (LAS float*)(lds + 24832); LAS float* yzs = (LAS float*)(lds + 25088);
    const bf16_t* proj = (const bf16_t*)(p.ws + OFF_PROJ); const float* gates = (const float*)(p.ws + OFF_GATES); bf16_t* mix = (bf16_t*)(p.ws + OFF_MIX);
    const int pp = tid >> 3, nq = tid & 7;
    float* carry_ = (DBG_SSD_SEQ == 2 || DBG_SSD_SEQ == 4) ? (float*)(p.ws + OFF_FF) : p.out + O_SSP;
    const float* sin = carry_ + ((size_t)(b * 16 + g * 8) * 64 + pp) * 128 + nq * 16;
    float* sout = carry_ + ((size_t)(b * 16 + g * 8) * 64 + pp) * 128 + nq * 16;
    for (int w8 = 0; w8 < 256; ++w8) { const int r0 = b * 2048 + w8 * 8;
    f32x4 hn[4];
#pragma unroll
    for (int v = 0; v < 4; ++v) hn[v] = w8 ? *(const f32x4*)(sin + 4 * v) : (f32x4){0.f, 0.f, 0.f, 0.f};
    for (int idx = tid; idx < 768; idx += 512) { const int t = idx / 96, cgi = idx % 96; float o[8];
        const int ch = cgi < 64 ? g * 512 + cgi * 8 : (cgi < 80 ? 1024 + g * 128 + (cgi - 64) * 8 : 1280 + g * 128 + (cgi - 80) * 8);
        conv1x8_sample(proj + (size_t)r0 * NPROJ + PC_XBC + ch, nullptr, 1536, t, p.in[I_SCW] + ch, p.in[I_SCB] + ch, o, w8 > 0);
        LAS float* dst = cgi < 64 ? xs + t * 512 + cgi * 8 : (cgi < 80 ? Bs + t * 128 + (cgi - 64) * 8 : Cs + t * 128 + (cgi - 80) * 8);
        *(LAS f32x4*)dst = (f32x4){o[0], o[1], o[2], o[3]}; *(LAS f32x4*)(dst + 4) = (f32x4){o[4], o[5], o[6], o[7]}; }
    if (tid < 64) { const int t = tid >> 3, hh = tid & 7, head = g * 8 + hh;
        const float dt = softplusf(gates[(size_t)(r0 + t) * 32 + 16 + head] + p.in[I_SDB][head]);
        dts[t * 8 + hh] = dt; dAs[t * 8 + hh] = __expf(-__expf(p.in[I_SAL][head]) * dt); }
    __syncthreads();
    for (int hh = 0; hh < 8; ++hh) { const int head = g * 8 + hh;
        float hr[16];
#pragma unroll
        for (int v = 0; v < 4; ++v) { hr[4 * v] = hn[v][0]; hr[4 * v + 1] = hn[v][1]; hr[4 * v + 2] = hn[v][2]; hr[4 * v + 3] = hn[v][3]; }
        if (hh < 7) {
#pragma unroll
            for (int v = 0; v < 4; ++v) hn[v] = w8 ? *(const f32x4*)(sin + (size_t)(hh + 1) * 64 * 128 + 4 * v) : (f32x4){0.f, 0.f, 0.f, 0.f}; }
        const float Dh = p.in[I_SD][head];
#pragma unroll
        for (int t = 0; t < 8; ++t) { const float dA = dAs[t * 8 + hh], xv = xs[t * 512 + hh * 64 + pp], dtx = dts[t * 8 + hh] * xv; float yp = 0.f;
#pragma unroll
            for (int v = 0; v < 4; ++v) { const f32x4 bv = *(LAS f32x4*)(Bs + t * 128 + nq * 16 + 4 * v), cv = *(LAS f32x4*)(Cs + t * 128 + nq * 16 + 4 * v);
#pragma unroll
                for (int e = 0; e < 4; ++e) { hr[4 * v + e] = dA * hr[4 * v + e] + dtx * bv[e]; yp += hr[4 * v + e] * cv[e]; } }
            yp += __shfl_xor(yp, 1); yp += __shfl_xor(yp, 2); yp += __shfl_xor(yp, 4);
            if (nq == 0) { const float y = yp + Dh * xv; const float z = bf2f(proj[(size_t)(r0 + t) * NPROJ + PC_ZS + head * 64 + pp]); yzs[t * 512 + hh * 64 + pp] = y * siluf(z); } }
#pragma unroll
        for (int v = 0; v < 4; ++v) *(f32x4*)(sout + (size_t)hh * 64 * 128 + 4 * v) = (f32x4){hr[4 * v], hr[4 * v + 1], hr[4 * v + 2], hr[4 * v + 3]};
    }
    __syncthreads();
    { const int t = wv; float f[8]; float ss = 0.f;
      const f32x4 a = *(LAS f32x4*)(yzs + t * 512 + lane * 8), c = *(LAS f32x4*)(yzs + t * 512 + lane * 8 + 4);
      f[0] = a[0]; f[1] = a[1]; f[2] = a[2]; f[3] = a[3]; f[4] = c[0]; f[5] = c[1]; f[6] = c[2]; f[7] = c[3];
#pragma unroll
      for (int e = 0; e < 8; ++e) ss += f[e] * f[e];
      const float rinv = rsqrtf(wave_sum(ss) * (1.f / 512.f) + EPS); float w[8]; ld8f(p.in[I_SNW] + g * 512 + lane * 8, w);
#pragma unroll
      for (int e = 0; e < 8; ++e) f[e] *= rinv * w[e];
      if (DBG_SSD_SEQ >= 3) { if (DBG_SSD_SEQ == 3 || !DBG_SUBSET((r0 + t) & 2047)) { float f2[8]; f2[0] = a[0]; f2[1] = a[1]; f2[2] = a[2]; f2[3] = a[3]; f2[4] = c[0]; f2[5] = c[1]; f2[6] = c[2]; f2[7] = c[3];
          *(u32x4*)((bf16_t*)(p.ws + OFF_YZ) + (size_t)(r0 + t) * 1024 + g * 512 + lane * 8) = pack8(f2); } }
      else *(u32x4*)(mix + (size_t)(r0 + t) * 2048 + 1024 + g * 512 + lane * 8) = pack8(f); }
    __syncthreads();
    }
}


__device__ __forceinline__ void gdn_sample_item(CP& p, LAS unsigned char* lds, int bh) {
    { unsigned lb_ = (unsigned)(size_t)lds; asm volatile("" : "+v"(lb_)); lds = (LAS unsigned char*)(size_t)lb_; }
    const int tid = opaque_tid(), wv = tid >> 6, lane = tid & 63;
    const int b = bh >> 3, h = bh & 7, r0 = NPR + b * 8;
    LAS float* qs = (LAS float*)lds; LAS float* ks = (LAS float*)(lds + 4096); LAS float* vs = (LAS float*)(lds + 8192);
    LAS float* as = (LAS float*)(lds + 12288); LAS float* bs = as + 8; LAS float* part = (LAS float*)(lds + 12544); LAS float* opart = (LAS float*)(lds + 16640);
    const bf16_t* proj = (const bf16_t*)(p.ws + OFF_PROJ); const float* gates = (const float*)(p.ws + OFF_GATES); bf16_t* mix = (bf16_t*)(p.ws + OFF_MIX);
    const int e = tid & 127, dq = tid >> 7;
    const float* sin = p.in[I_SG] + ((size_t)bh * 128 + dq * 32) * 128 + e;
    float* sout = p.out + O_GSS + ((size_t)bh * 128 + dq * 32) * 128 + e;
    bf16_t zpre[2];
#pragma unroll
    for (int k = 0; k < 2; ++k) zpre[k] = proj[(size_t)(r0 + wv) * NPROJ + PC_ZG + h * 128 + lane + 64 * k];
    float S[32];
#pragma unroll
    for (int d = 0; d < 32; ++d) S[d] = sin[d * 128];
    if (tid < 384) { const int part_ = tid >> 7, t = (tid >> 4) & 7, cgi = tid & 15, ch = part_ * 1024 + h * 128 + cgi * 8; float o[8];
        conv1x8_sample(proj + (size_t)r0 * NPROJ + ch, p.in[I_SGC] + (size_t)b * 3 * 3072 + ch, 3072, t, p.in[I_GCW] + ch, nullptr, o);
        if (part_ < 2) { float ss = 0.f;
#pragma unroll
            for (int c = 0; c < 8; ++c) ss += o[c] * o[c];
            ss = sum16_dpp(ss);
            const float sc = rsqrtf(ss + EPS) * (part_ == 0 ? 0.08838834764831845f : 1.f);
#pragma unroll
            for (int c = 0; c < 8; ++c) o[c] *= sc; }
        LAS float* dst = (part_ == 0 ? qs : (part_ == 1 ? ks : vs)) + t * 128 + cgi * 8;
        *(LAS f32x4*)dst = (f32x4){o[0], o[1], o[2], o[3]}; *(LAS f32x4*)(dst + 4) = (f32x4){o[4], o[5], o[6], o[7]};
    } else if (tid < 392) { const int t = tid - 384;
        const float gg = -__expf(p.in[I_GAL][h]) * softplusf(gates[(size_t)(r0 + t) * 32 + 8 + h] + p.in[I_GDB][h]);
        as[t] = __expf(gg); bs[t] = sigmf(gates[(size_t)(r0 + t) * 32 + h]); }
    __syncthreads();
    float op[8];
#pragma unroll
    for (int t = 0; t < 8; ++t) { float kp = 0.f;
#pragma unroll
        for (int v = 0; v < 8; ++v) { const f32x4 kv = *(LAS f32x4*)(ks + t * 128 + dq * 32 + 4 * v); kp += kv[0] * S[4 * v] + kv[1] * S[4 * v + 1] + kv[2] * S[4 * v + 2] + kv[3] * S[4 * v + 3]; }
        part[(t & 1) * 512 + dq * 128 + e] = kp;
        __syncthreads();
        const float kd = (part[(t & 1) * 512 + e] + part[(t & 1) * 512 + 128 + e]) + (part[(t & 1) * 512 + 256 + e] + part[(t & 1) * 512 + 384 + e]);
        const float a = as[t], coef = bs[t] * (vs[t * 128 + e] - a * kd); float oq = 0.f;
#pragma unroll
        for (int v = 0; v < 8; ++v) { const f32x4 kv = *(LAS f32x4*)(ks + t * 128 + dq * 32 + 4 * v), qv = *(LAS f32x4*)(qs + t * 128 + dq * 32 + 4 * v);
#pragma unroll
            for (int c = 0; c < 4; ++c) { S[4 * v + c] = a * S[4 * v + c] + kv[c] * coef; oq += qv[c] * S[4 * v + c]; } }
        op[t] = oq; }
#pragma unroll
    for (int t = 0; t < 8; ++t) opart[(dq * 8 + t) * 128 + e] = op[t];
#pragma unroll
    for (int d = 0; d < 32; ++d) sout[d * 128] = S[d];
    __syncthreads();
    { const int t = wv; float o2[2]; float ss = 0.f;
#pragma unroll
      for (int k = 0; k < 2; ++k) { const int ee = lane + 64 * k; o2[k] = (opart[(0 * 8 + t) * 128 + ee] + opart[(1 * 8 + t) * 128 + ee]) + (opart[(2 * 8 + t) * 128 + ee] + opart[(3 * 8 + t) * 128 + ee]); ss += o2[k] * o2[k]; }
      const float rinv = rsqrtf(wave_sum(ss) * (1.f / 128.f) + EPS);
#pragma unroll
      for (int k = 0; k < 2; ++k) { const int ee = lane + 64 * k; const float zg = bf2f(zpre[k]);
          mix[(size_t)(r0 + t) * 2048 + h * 128 + ee] = f2bf(o2[k] * rinv * p.in[I_GNW][ee] * siluf(zg)); } }
    __syncthreads();
}

__device__ __forceinline__ void gdn_prompt_seq_item(CP& p, LAS unsigned char* lds, int bh) {
    { unsigned lb_ = (unsigned)(size_t)lds; asm volatile("" : "+v"(lb_)); lds = (LAS unsigned char*)(size_t)lb_; }
    const int tid = opaque_tid(), wv = tid >> 6, lane = tid & 63;
    const int b = bh >> 3, h = bh & 7;
    LAS float* qs = (LAS float*)lds; LAS float* ks = (LAS float*)(lds + 4096); LAS float* vs = (LAS float*)(lds + 8192);
    LAS float* as = (LAS float*)(lds + 12288); LAS float* bs = as + 8; LAS float* part = (LAS float*)(lds + 12544); LAS float* opart = (LAS float*)(lds + 16640);
    const bf16_t* proj = (const bf16_t*)(p.ws + OFF_PROJ); const float* gates = (const float*)(p.ws + OFF_GATES); bf16_t* mix = (bf16_t*)(p.ws + OFF_MIX);
    const int e = tid & 127, dq = tid >> 7;
    float* sout = p.out + O_GSP + ((size_t)bh * 128 + dq * 32) * 128 + e;
    float S[32];
#pragma unroll
    for (int d = 0; d < 32; ++d) S[d] = 0.f;
    for (int w8 = 0; w8 < 256; ++w8) { const int r0 = b * 2048 + w8 * 8;
    if (tid < 384) { const int part_ = tid >> 7, t = (tid >> 4) & 7, cgi = tid & 15, ch = part_ * 1024 + h * 128 + cgi * 8; float o[8];
        conv1x8_sample(proj + (size_t)r0 * NPROJ + ch, nullptr, 3072, t, p.in[I_GCW] + ch, nullptr, o, w8 > 0);
        if (part_ < 2) { float ss = 0.f;
#pragma unroll
            for (int c = 0; c < 8; ++c) ss += o[c] * o[c];
            ss = sum16_dpp(ss);
            const float sc = rsqrtf(ss + EPS) * (part_ == 0 ? 0.08838834764831845f : 1.f);
#pragma unroll
            for (int c = 0; c < 8; ++c) o[c] *= sc; }
        LAS float* dst = (part_ == 0 ? qs : (part_ == 1 ? ks : vs)) + t * 128 + cgi * 8;
        *(LAS f32x4*)dst = (f32x4){o[0], o[1], o[2], o[3]}; *(LAS f32x4*)(dst + 4) = (f32x4){o[4], o[5], o[6], o[7]};
    } else if (tid < 392) { const int t = tid - 384;
        const float gg = -__expf(p.in[I_GAL][h]) * softplusf(gates[(size_t)(r0 + t) * 32 + 8 + h] + p.in[I_GDB][h]);
        as[t] = __expf(gg); bs[t] = sigmf(gates[(size_t)(r0 + t) * 32 + h]); }
    __syncthreads();
    float op[8];
#pragma unroll
    for (int t = 0; t < 8; ++t) { float kp = 0.f;
#pragma unroll
        for (int v = 0; v < 8; ++v) { const f32x4 kv = *(LAS f32x4*)(ks + t * 128 + dq * 32 + 4 * v); kp += kv[0] * S[4 * v] + kv[1] * S[4 * v + 1] + kv[2] * S[4 * v + 2] + kv[3] * S[4 * v + 3]; }
        part[(t & 1) * 512 + dq * 128 + e] = kp;
        __syncthreads();
        const float kd = (part[(t & 1) * 512 + e] + part[(t & 1) * 512 + 128 + e]) + (part[(t & 1) * 512 + 256 + e] + part[(t & 1) * 512 + 384 + e]);
        const float a = as[t], coef = bs[t] * (vs[t * 128 + e] - a * kd); float oq = 0.f;
#pragma unroll
        for (int v = 0; v < 8; ++v) { const f32x4 kv = *(LAS f32x4*)(ks + t * 128 + dq * 32 + 4 * v), qv = *(LAS f32x4*)(qs + t * 128 + dq * 32 + 4 * v);
#pragma unroll
            for (int c = 0; c < 4; ++c) { S[4 * v + c] = a * S[4 * v + c] + kv[c] * coef; oq += qv[c] * S[4 * v + c]; } }
        op[t] = oq; }
#pragma unroll
    for (int t = 0; t < 8; ++t) opart[(dq * 8 + t) * 128 + e] = op[t];
    __syncthreads();
    { const int t = wv; float o2[2]; float ss = 0.f;
#pragma unroll
      for (int k = 0; k < 2; ++k) { const int ee = lane + 64 * k; o2[k] = (opart[(0 * 8 + t) * 128 + ee] + opart[(1 * 8 + t) * 128 + ee]) + (opart[(2 * 8 + t) * 128 + ee] + opart[(3 * 8 + t) * 128 + ee]); ss += o2[k] * o2[k]; }
      const float rinv = rsqrtf(wave_sum(ss) * (1.f / 128.f) + EPS);
#pragma unroll
      for (int k = 0; k < 2; ++k) { const int ee = lane + 64 * k; const float zg = bf2f(proj[(size_t)(r0 + t) * NPROJ + PC_ZG + h * 128 + ee]);
          mix[(size_t)(r0 + t) * 2048 + h * 128 + ee] = f2bf(o2[k] * rinv * p.in[I_GNW][ee] * siluf(zg)); } }
    __syncthreads();
    }
#pragma unroll
    for (int d = 0; d < 32; ++d) sout[d * 128] = S[d];
}


#ifndef ITEMMASK
#define ITEMMASK 15
#endif

template <int KIND> __device__ __forceinline__ void phase3_loop(CP& p, LAS unsigned char* lds, int nitems) {
    unsigned* ctr = (unsigned*)(p.ws + OFF_CTR) + KIND;
    LAS int* sitem = (LAS int*)(lds + 130048);
    for (;;) {
        if (threadIdx.x == 0) *sitem = (int)atomicAdd(ctr, 1u);
        __syncthreads();
        const int item = *sitem;
        __syncthreads();
        if (item >= nitems) break;
        if (KIND == 0) gdn_scan_item(p, lds, item);
        if (KIND == 1) ssd_scan_item(p, lds, item);
        if (KIND == 2) ssd_sample_item(p, lds, item);
        if (KIND == 3) gdn_sample_item(p, lds, item);
        if (KIND == 4) gdn_prompt_seq_item(p, lds, item);
        if (KIND == 5) ssd_prompt_seq_item(p, lds, item);
        if (KIND == 6) ssd_prompt_par_item(p, lds, item);
    }
}
__device__ __forceinline__ void phase3(LAS unsigned char* lds) {
    const int bid = blockIdx.x, nb = gridDim.x;
    if (nb >= 128) {
        if (bid < 32) { CP& p = *get_params(); gdn_scan_item(p, lds, bid); }
        if (bid >= 32 && bid < 96) { CP& p = *get_params(); ssd_scan_item(p, lds, bid - 32); }
        if (bid >= 96) { CP& p = *get_params(); for (int it = bid - 96; it < 1024; it += nb - 96) gdn_sample_item(p, lds, it); }
    } else {
        { CP& p = *get_params(); for (int it = bid; it < 32; it += nb) gdn_scan_item(p, lds, it); }
        { CP& p = *get_params(); for (int it = bid; it < 64; it += nb) ssd_scan_item(p, lds, it); }
        { CP& p = *get_params(); for (int it = bid; it < 1024; it += nb) gdn_sample_item(p, lds, it); }
    }
}

__device__ __forceinline__ void phase4(LAS unsigned char* lds) {
    { const int bid = blockIdx.x, nb = gridDim.x;
      if (nb >= 192) {
          { CP& p = *get_params(); for (int it = bid; it < 256; it += nb) ssd_prompt_par_item(p, lds, it); }
          { CP& p = *get_params(); for (int it = bid; it < 256; it += nb) ssd_sample_fast_item(p, lds, it); }
      } else {
          { CP& p = *get_params(); for (int it = bid; it < 256; it += nb) ssd_prompt_par_item(p, lds, it); }
          { CP& p = *get_params(); for (int it = bid; it < 256; it += nb) ssd_sample_fast_item(p, lds, it); }
      } }
    CP& p = *get_params();
    const int tid_ = opaque_tid(), wv = tid_ >> 6, lane = tid_ & 63;
    const bf16_t* YZ = (const bf16_t*)(p.ws + OFF_YZ); bf16_t* mix = (bf16_t*)(p.ws + OFF_MIX);
#if DBG_SSD_SEQ >= 3
    for (int job = blockIdx.x * 8 + wv; job < NPR * 2; job += gridDim.x * 8) { const int row = job >> 1, g = job & 1; float f[8], w[8]; float ss = 0.f;
        ld8b(YZ + (size_t)row * 1024 + g * 512 + lane * 8, f);
#pragma unroll
        for (int e = 0; e < 8; ++e) ss += f[e] * f[e];
        const float rinv = rsqrtf(wave_sum(ss) * (1.f / 512.f) + EPS); ld8f(p.in[I_SNW] + g * 512 + lane * 8, w);
#pragma unroll
        for (int e = 0; e < 8; ++e) f[e] *= rinv * w[e];
        *(u32x4*)(mix + (size_t)row * 2048 + 1024 + g * 512 + lane * 8) = pack8(f); }
#endif
}
__device__ __forceinline__ void phase_final(CP& p) {
    const int tid_ = opaque_tid(), wv = tid_ >> 6, lane = tid_ & 63;
    const float* ss = (const float*)(p.ws + OFF_SS2); const f32x4* wn = (const f32x4*)p.in[I_FINW];
    for (int row = blockIdx.x * 8 + wv; row < NTOK; row += gridDim.x * 8) { const float rinv = rsqrtf(wave_sum(lane < 32 ? ss[((size_t)(lane >> 2) * NTOK + row) * 4 + (lane & 3)] : 0.f) * (1.f / 2048.f) + EPS);
        const u32x4* xr = (const u32x4*)((const bf16_t*)(p.ws + OFF_X2B) + (size_t)row * 2048); f32x4* yr = (f32x4*)(p.out + (size_t)row * 2048);
#ifndef DBG_SCALE_S
#define DBG_SCALE_S 1.0f
#endif
#ifndef DBG_SCALE_P
#define DBG_SCALE_P 1.0f
#endif
        const float dsc = row < NPR ? DBG_SCALE_P : DBG_SCALE_S;
#pragma unroll
        for (int j = 0; j < 4; ++j) { float f[8]; unpack8(xr[lane + 64 * j], f); const int c4 = 2 * (lane + 64 * j);
            yr[c4] = (f32x4){f[0], f[1], f[2], f[3]} * (rinv * dsc) * wn[c4]; yr[c4 + 1] = (f32x4){f[4], f[5], f[6], f[7]} * (rinv * dsc) * wn[c4 + 1]; } }
}

#ifndef SKIPMASK
#define SKIPMASK 0
#endif
#define GSYNC() do { asm volatile("s_waitcnt vmcnt(0)" ::: "memory"); grid.sync(); if (threadIdx.x < 64) { __builtin_amdgcn_fence(__ATOMIC_ACQUIRE, "agent"); asm volatile("s_waitcnt vmcnt(0)" ::: "memory"); } __syncthreads(); } while (0)
#ifndef MAXPHASE
#define MAXPHASE 99
#endif
#ifdef DBG_TIME_A
#define STAMP(k) do { if ((k) == DBG_TIME_A) ta_ = __builtin_amdgcn_s_memrealtime(); if ((k) == DBG_TIME_B) tb_ = __builtin_amdgcn_s_memrealtime(); } while (0)
#else
#define STAMP(k) do { } while (0)
#endif
#define GSYNCK(kk) do { asm volatile("s_waitcnt vmcnt(0)" ::: "memory"); __syncthreads(); \
    if (threadIdx.x == 0) { unsigned* base_ = (unsigned*)(get_params()->ws + OFF_BAR); const unsigned s_ = blockIdx.x & 7u; \
        __builtin_amdgcn_fence(__ATOMIC_RELEASE, "agent"); asm volatile("s_waitcnt vmcnt(0)" ::: "memory"); \
        const unsigned per_ = (gridDim.x + 7u - s_) >> 3;     \
        const unsigned old_ = __hip_atomic_fetch_add(base_ + 32u * (s_ + 1u), 1u, __ATOMIC_RELAXED, __HIP_MEMORY_SCOPE_AGENT); \
        if (old_ + 1u == per_ * (unsigned)(kk)) __hip_atomic_fetch_add(base_, 1u, __ATOMIC_RELAXED, __HIP_MEMORY_SCOPE_AGENT);     \
        const unsigned want_ = (gridDim.x < 8u ? gridDim.x : 8u) * (unsigned)(kk); \
        while (__hip_atomic_load(base_, __ATOMIC_RELAXED, __HIP_MEMORY_SCOPE_AGENT) < want_) __builtin_amdgcn_s_sleep(1); \
        __builtin_amdgcn_fence(__ATOMIC_ACQUIRE, "agent"); asm volatile("s_waitcnt vmcnt(0)" ::: "memory"); } \
    __syncthreads(); } while (0)
__global__ __launch_bounds__(512, 2) void mega(Params p_unused) {
    extern __shared__ __attribute__((aligned(16))) unsigned char shm[];
    LAS unsigned char* lds = (LAS unsigned char*)shm;
    cg::grid_group grid = cg::this_grid();
    pg8::StaticOrder S;
    unsigned long long t0_ = 0, ta_ = 0, tb_ = 0; (void)ta_; (void)tb_;
#ifdef DBG_TIME_A
#ifdef DBG_T0_AFTER_SYNC
    GSYNC();
#endif
    t0_ = __builtin_amdgcn_s_memrealtime();
#endif
#if !((SKIPMASK >> 0) & 1)
    { CP& p = *get_params(); phase_prep(p, lds); }
    if (blockIdx.x == 0 && threadIdx.x == 0) { CP& p = *get_params(); for (int i = 0; i < 9; ++i) __hip_atomic_store((unsigned*)(p.ws + OFF_BAR) + 32 * i, 0u, __ATOMIC_RELAXED, __HIP_MEMORY_SCOPE_AGENT); }
#endif
    GSYNC();
    STAMP(1);
#if !((SKIPMASK >> 1) & 1)
    { CP& p = *get_params(); pg8::Gemm g{(const bf16_t*)((const unsigned char*)p.out + OB_HB), (const bf16_t*)((const unsigned char*)p.out + OB_WINT), NTOK, NPROJ_GEMM, 2048}; S.init(g.M, g.N, (int)gridDim.x, (int)blockIdx.x);
      EpiProj E{(bf16_t*)(p.ws + OFF_PROJ), (float*)(p.ws + OFF_GATES)}; pg8::gemm_phase<EpiProj, pg8::StaticOrder, false>(lds, g, S, E, nullptr); }
#endif
    GSYNCK(1);
    STAMP(2);
    if (MAXPHASE < 2) return;
#if !((SKIPMASK >> 2) & 1)
    { CP& p = *get_params(); phase2(p, lds); }
#endif
    GSYNCK(2);
    STAMP(3);
    if (MAXPHASE < 3) return;
#if !((SKIPMASK >> 3) & 1)
    phase3(lds);
#endif
    GSYNCK(3);
    STAMP(4);
    if (MAXPHASE < 4) return;
#if !((SKIPMASK >> 4) & 1)
    phase4(lds);
#endif
    GSYNCK(4);
    STAMP(5);
#ifdef DBG_DUMP_MIX
    { CP& p = *get_params(); const bf16_t* src = (const bf16_t*)(p.ws + (DBG_DUMP_MIX == 1 ? OFF_MIX : OFF_PROJ)); const int ld = DBG_DUMP_MIX == 1 ? 2048 : NPROJ; const int c0 = DBG_DUMP_MIX == 1 ? 0 : (DBG_DUMP_MIX - 2) * 2048;
      for (size_t i = (size_t)blockIdx.x * 512 + threadIdx.x; i < (size_t)NTOK * 2048; i += (size_t)gridDim.x * 512) { const size_t r = i >> 11, c = i & 2047; float v = bf2f(src[r * ld + c0 + c]);
#ifdef DBG_Q
          { const int qd = (r >= NPR ? 2 : 0) + (c >= 1024 ? 1 : 0); if (qd != DBG_Q) v = 0.f; }
#endif
#if DBG_DUMP_MIX == 10
          v = ((const float*)(p.ws + OFF_GATES))[r * 32 + (c & 31)];
#endif
#if DBG_DUMP_MIX == 11
          v = (r < NPR) ? ((const float*)(p.ws + OFF_DT))[(c & 15) * NPR + r] + ((const float*)(p.ws + OFF_ACUM))[(c & 15) * NPR + r] : 0.f;
#endif
#if DBG_DUMP_MIX == 9
          v = (r < NPR && c < 1024) ? bf2f(((const bf16_t*)(p.ws + OFF_YZ))[r * 1024 + c]) : 0.f;
#endif
          p.out[i] = v; } }
    return;
#endif
#if !((SKIPMASK >> 5) & 1)
    { CP& p = *get_params(); pg8::Gemm g{(const bf16_t*)(p.ws + OFF_MIX), (const bf16_t*)(p.ws + OFF_WOUT), NTOK, 2048, 2048}; S.init(g.M, g.N, (int)gridDim.x, (int)blockIdx.x);
      EpiOut E{p.in[I_XP], p.in[I_XS], p.out, (bf16_t*)(p.ws + OFF_X1B), (float*)(p.ws + OFF_SS1)}; pg8::gemm_phase<EpiOut, pg8::StaticOrder, false>(lds, g, S, E, nullptr); }
#endif
    GSYNCK(5);
    STAMP(6);
    if (MAXPHASE < 6) return;
#if !((SKIPMASK >> 6) & 1)
    { CP& p = *get_params(); pg8::Gemm g{(const bf16_t*)(p.ws + OFF_X1B), (const bf16_t*)(p.ws + OFF_WGU), NTOK, 2 * DFF, 2048}; S.init(g.M, g.N, (int)gridDim.x, (int)blockIdx.x);
      EpiGU E{(bf16_t*)(p.ws + OFF_FF), (const float*)(p.ws + OFF_SS1)}; pg8::gemm_phase<EpiGU, pg8::StaticOrder, false>(lds, g, S, E, nullptr); }
#endif
    GSYNCK(6);
    STAMP(7);
    if (MAXPHASE < 7) return;
#if !((SKIPMASK >> 7) & 1)
    { CP& p = *get_params(); pg8::Gemm g{(const bf16_t*)(p.ws + OFF_FF), (const bf16_t*)(p.ws + OFF_WDN), NTOK, 2048, DFF}; S.init(g.M, g.N, (int)gridDim.x, (int)blockIdx.x);
      EpiDown E{(bf16_t*)(p.ws + OFF_X2B), (float*)(p.ws + OFF_SS2), (const bf16_t*)(p.ws + OFF_X1B)}; pg8::gemm_phase<EpiDown, pg8::StaticOrder, false>(lds, g, S, E, nullptr); }
#endif
    GSYNCK(7);
    STAMP(8);
    if (MAXPHASE < 8) return;
#if !((SKIPMASK >> 8) & 1)
    { CP& p = *get_params(); phase_final(p); }
#endif
#ifdef DBG_TIME_A
    if (blockIdx.x == 0) { CP& p = *get_params(); __syncthreads();
        const float Ta = (float)(ta_ - t0_) * 0.01f, Tb = (float)(tb_ - t0_) * 0.01f;
        const float delta = 0.006f + Ta * 3e-6f;
        for (int i = threadIdx.x; i < 4 * 3 * 3072; i += 512) p.out[O_GCP + i] += delta;
        if (threadIdx.x == 0) p.out[0] += 4.f + Tb * 0.004f; }
#endif
}

extern "C" void kernel_launch(void* const* d_in, const int* in_sizes, int n_in, void* d_out, int out_size, void* d_ws, size_t ws_size, hipStream_t stream) {
    constexpr size_t kDynLds = 131072;
    static int grid_blocks = 0;
    if (!grid_blocks) {
        int dev = 0, cus = 0, per_cu = 0;
        hipGetDevice(&dev);
        hipDeviceGetAttribute(&cus, hipDeviceAttributeMultiprocessorCount, dev);
        hipFuncSetAttribute((const void*)mega, hipFuncAttributeMaxDynamicSharedMemorySize, (int)kDynLds);
        hipOccupancyMaxActiveBlocksPerMultiprocessor(&per_cu, (const void*)mega, 512, kDynLds);
        if (per_cu < 1) { fprintf(stderr, "occupancy query returned %d\n", per_cu); per_cu = 1; }
        grid_blocks = cus * (per_cu > 1 ? 1 : per_cu);
        if (ws_size < WS_END) fprintf(stderr, "workspace too small: %zu < %zu\n", ws_size, (size_t)WS_END);
    }
    Params p{};
    for (int i = 0; i < 24; ++i) p.in[i] = (const float*)d_in[i];
    p.out = (float*)d_out; p.ws = (unsigned char*)d_ws;
    void* args[] = {&p};
    hipError_t e = hipLaunchCooperativeKernel((const void*)mega, dim3(grid_blocks), dim3(512), args, kDynLds, stream);
    if (e != hipSuccess) fprintf(stderr, "cooperative launch failed: %s (grid %d)\n", hipGetErrorString(e), grid_blocks);
}
```
